# Optimizing an MI355X kernel written in HIP

```python
import math, functools
import jax, jax.numpy as jnp
from jax import lax
import numpy as np

D_MODEL = 2048
BATCH = 2
SEQ = 8192
DEPTH = 4

GRID_W = 64
CTX_LEN = 256
HEAD_DIM = 128
RET_HEADS = 4
DN_HEADS = 4
ATT_HEADS = 8
ATT_KV_HEADS = 2
RET_W = RET_HEADS * HEAD_DIM
DN_W = DN_HEADS * HEAD_DIM
ATT_W = ATT_HEADS * HEAD_DIM
ATT_KV_W = ATT_KV_HEADS * HEAD_DIM
MIX_W = RET_W + DN_W + ATT_W
RET_CHUNK = 128
DN_CHUNK = 64
DN_CONV_K = 5
Q_BLOCK = 128
ROPE_THETA = 10000.0
D_FF = ((8 * D_MODEL + 3 * 256 - 1) // (3 * 256)) * 256
DEEPNORM_ALPHA = (2 * DEPTH) ** 0.25
DEEPNORM_BETA = (8 * DEPTH) ** -0.25
EPS = 1e-6
SPLIT_SIZES = (RET_W, RET_W, RET_W, RET_W, 3 * DN_W, DN_W, 2 * DN_HEADS, 2 * DN_HEADS, ATT_W, ATT_KV_W, ATT_KV_W)
PROJ_W = sum(SPLIT_SIZES)
SPLIT_POINTS = tuple(np.cumsum(SPLIT_SIZES)[:-1].tolist())

kernel_name = "hybrid_ret_gdn_gqa_diffusion_block"


def layer_norm(x, w, b):
    xf = x.astype(jnp.float32)
    mu = jnp.mean(xf, -1, keepdims=True)
    var = jnp.mean(jnp.square(xf - mu), -1, keepdims=True)
    return (xf - mu) * lax.rsqrt(var + EPS) * w + b


def rms_norm(x, w=None):
    xf = x.astype(jnp.float32)
    y = xf * lax.rsqrt(jnp.mean(xf * xf, -1, keepdims=True) + EPS)
    if w is not None:
        y = y * w
    return y.astype(x.dtype)


def l2_normalize(x):
    return x * lax.rsqrt(jnp.sum(x * x, -1, keepdims=True) + EPS)


def split_heads(a, n_heads):
    return a.reshape(a.shape[:-1] + (n_heads, HEAD_DIM))


def modulate(h, shift, scale):
    return h * (1.0 + scale) + shift


def post_norm(x, y, w, b):
    return layer_norm(DEEPNORM_ALPHA * x + y, w, b).astype(x.dtype)


def axial_rope(n_tokens):
    rows = n_tokens // GRID_W
    row = jnp.repeat(jnp.arange(rows, dtype=jnp.float32), GRID_W)
    col = jnp.tile(jnp.arange(GRID_W, dtype=jnp.float32), rows)
    n_freq = HEAD_DIM // 4
    inv = ROPE_THETA ** (-jnp.arange(n_freq, dtype=jnp.float32) / n_freq)
    ang = jnp.concatenate([row[:, None] * inv, col[:, None] * inv], -1)
    return jnp.cos(ang), jnp.sin(ang)


def apply_rope(x, cos, sin):
    xf = x.astype(jnp.float32)
    x1, x2 = jnp.split(xf, 2, -1)
    c = cos[None, :, None, :]
    s = sin[None, :, None, :]
    return jnp.concatenate([x1 * c - x2 * s, x1 * s + x2 * c], -1).astype(x.dtype)


def bidirectional(scan_f, scan_b, ctx_f, lat_f, ctx_b, lat_b, s0):
    flip = lambda seq: tuple(jnp.flip(a, axis=1) for a in seq)
    o_cf, s_cf = scan_f(*ctx_f, s0)
    o_lf, _ = scan_f(*lat_f, s_cf)
    o_cb, s_cb = scan_b(*flip(ctx_b), s0)
    o_lb, _ = scan_b(*flip(lat_b), s_cb)
    return o_cf + jnp.flip(o_cb, 1), o_lf + jnp.flip(o_lb, 1)


def retention_scan(q, k, v, s0, log_gamma):
    b, l, h, d = q.shape
    n = l // RET_CHUNK
    qc = q.reshape(b, n, RET_CHUNK, h, d)
    kc = k.reshape(b, n, RET_CHUNK, h, d)
    vc = v.reshape(b, n, RET_CHUNK, h, d)
    pos = jnp.arange(RET_CHUNK, dtype=jnp.float32)
    rel = pos[:, None] - pos[None, :]
    decay = jnp.where(rel >= 0, jnp.exp(jnp.maximum(rel, 0.0)[None] * log_gamma[:, None, None]), 0.0)
    intra = jnp.einsum('bnihd,bnjhd->bnhij', qc, kc) * decay
    o_intra = jnp.einsum('bnhij,bnjhd->bnihd', intra, vc)
    q_decay = jnp.exp((pos + 1.0)[:, None] * log_gamma[None, :])
    k_decay = jnp.exp((RET_CHUNK - 1.0 - pos)[:, None] * log_gamma[None, :])
    chunk_kv = jnp.einsum('bnjhd,jh,bnjhe->nbhde', kc, k_decay, vc)
    chunk_decay = jnp.exp(RET_CHUNK * log_gamma)[None, :, None, None]

    def step(s, u):
        return s * chunk_decay + u, s

    s_fin, s_prev = lax.scan(step, s0, chunk_kv)
    o_inter = jnp.einsum('bnihd,ih,nbhde->bnihe', qc, q_decay, s_prev)
    return (o_intra + o_inter).reshape(b, l, h, d), s_fin


def to_chunks(a, c):
    b, l = a.shape[:2]
    return jnp.swapaxes(a.reshape((b, l // c, c) + a.shape[2:]), 2, 3)


def gated_delta_scan(q, k, v, g, beta, s0):
    b, l, h, _ = q.shape
    c = DN_CHUNK
    qc, kc, vc = to_chunks(q, c), to_chunks(k, c), to_chunks(v, c)
    gc, bc = to_chunks(g, c), to_chunks(beta, c)
    g_cum = jnp.cumsum(gc, -1)
    tri = jnp.tril(jnp.ones((c, c), bool))
    strict = jnp.tril(jnp.ones((c, c), bool), -1)
    diff = g_cum[..., :, None] - g_cum[..., None, :]
    decay = jnp.where(tri, jnp.exp(jnp.where(tri, diff, 0.0)), 0.0)
    k_beta = kc * bc[..., None]
    v_beta = vc * bc[..., None]
    a = jnp.where(strict, jnp.einsum('bnhid,bnhjd->bnhij', k_beta, kc) * decay, 0.0)
    eye = jnp.eye(c, dtype=a.dtype)
    t = lax.linalg.triangular_solve(eye + a, jnp.broadcast_to(eye, a.shape), left_side=True,
                                    lower=True, unit_diagonal=True)
    w_val = jnp.einsum('bnhij,bnhjd->bnhid', t, v_beta)
    k_cum = jnp.einsum('bnhij,bnhjd->bnhid', t, k_beta * jnp.exp(g_cum)[..., None])
    qk = jnp.einsum('bnhid,bnhjd->bnhij', qc, kc) * decay
    q_g = qc * jnp.exp(g_cum)[..., None]
    k_g = kc * jnp.exp(g_cum[..., -1:] - g_cum)[..., None]
    g_last = jnp.exp(g_cum[..., -1])
    xs = tuple(jnp.moveaxis(z, 1, 0) for z in (w_val, k_cum, qk, q_g, k_g, g_last))

    def step(s, inp):
        w_i, kc_i, qk_i, qg_i, kg_i, gl_i = inp
        v_new = w_i - jnp.einsum('bhcd,bhde->bhce', kc_i, s)
        o = jnp.einsum('bhcd,bhde->bhce', qg_i, s) + jnp.einsum('bhij,bhje->bhie', qk_i, v_new)
        s = s * gl_i[..., None, None] + jnp.einsum('bhcd,bhce->bhde', kg_i, v_new)
        return s, o

    s_fin, o = lax.scan(step, s0, xs)
    return o.transpose(1, 0, 3, 2, 4).reshape(b, l, h, -1), s_fin


def short_conv(x, w):
    pad = DN_CONV_K // 2
    return lax.conv_general_dilated(x, w[:, None, :], window_strides=(1,), padding=[(pad, pad)],
                                    dimension_numbers=('NWC', 'WIO', 'NWC'),
                                    feature_group_count=x.shape[-1])


def block_attention(q, k, v):
    b, lq, h, d = q.shape
    kvh = k.shape[2]
    qb = q.reshape(b, lq // Q_BLOCK, Q_BLOCK, kvh, h // kvh, d).swapaxes(0, 1)

    def one_block(qi):
        s = jnp.einsum('bqhgd,bkhd->bhgqk', qi, k).astype(jnp.float32) * d ** -0.5
        p = jax.nn.softmax(s, axis=-1).astype(v.dtype)
        return jnp.einsum('bhgqk,bkhd->bqhgd', p, v)

    o = lax.map(one_block, qb)
    return o.swapaxes(0, 1).reshape(b, lq, h * d)


def retention_group(pc, pl, decay_logit, cos, sin):
    log_gamma = jax.nn.log_sigmoid(decay_logit.astype(jnp.float32))

    def qkv(p, rotate):
        q, k, v = (split_heads(a, RET_HEADS).astype(jnp.float32) for a in p[:3])
        if rotate:
            q, k = apply_rope(q, cos, sin), apply_rope(k, cos, sin)
        return q, k * HEAD_DIM ** -0.5, v

    ctx_seq = qkv(pc, False)
    lat_seq = qkv(pl, True)
    s0 = jnp.zeros((pc[0].shape[0], RET_HEADS, HEAD_DIM, HEAD_DIM), jnp.float32)
    o_c, o_l = bidirectional(functools.partial(retention_scan, log_gamma=log_gamma[0]),
                             functools.partial(retention_scan, log_gamma=log_gamma[1]),
                             ctx_seq, lat_seq, ctx_seq, lat_seq, s0)

    def out(o, g):
        y = rms_norm(o) * jax.nn.silu(split_heads(g, RET_HEADS).astype(jnp.float32))
        return y.reshape(y.shape[:2] + (RET_W,)).astype(g.dtype)

    return out(o_c, pc[3]), out(o_l, pl[3])


def deltanet_group(pc, pl, conv_w, a_log, dt_bias, norm_w):
    neg_a = -jnp.exp(a_log.astype(jnp.float32))
    dt_b = dt_bias.astype(jnp.float32)

    def prep(p):
        qkv, _, a, bb = p
        qkv = jax.nn.silu(short_conv(qkv, conv_w.astype(qkv.dtype)))
        q, k, v = (split_heads(t, DN_HEADS).astype(jnp.float32) for t in jnp.split(qkv, 3, -1))
        q = l2_normalize(q) * HEAD_DIM ** -0.5
        k = l2_normalize(k)
        bsz, n = a.shape[:2]
        g = neg_a * jax.nn.softplus(a.astype(jnp.float32).reshape(bsz, n, 2, DN_HEADS) + dt_b)
        beta = jax.nn.sigmoid(bb.astype(jnp.float32).reshape(bsz, n, 2, DN_HEADS))
        return (q, k, v, g[:, :, 0], beta[:, :, 0]), (q, k, v, g[:, :, 1], beta[:, :, 1])

    cf, cb = prep(pc)
    lf, lb = prep(pl)
    s0 = jnp.zeros((pc[0].shape[0], DN_HEADS, HEAD_DIM, HEAD_DIM), jnp.float32)
    o_c, o_l = bidirectional(gated_delta_scan, gated_delta_scan, cf, lf, cb, lb, s0)

    def out(o, z):
        y = rms_norm(o, norm_w) * jax.nn.silu(split_heads(z, DN_HEADS).astype(jnp.float32))
        return y.reshape(y.shape[:2] + (DN_W,)).astype(z.dtype)

    return out(o_c, pc[1]), out(o_l, pl[1])


def attention_group(pc, pl, qn_w, kn_w, cos, sin, keep_ctx):
    def qkv(p):
        q = rms_norm(split_heads(p[0], ATT_HEADS), qn_w)
        k = rms_norm(split_heads(p[1], ATT_KV_HEADS), kn_w)
        return q, k, split_heads(p[2], ATT_KV_HEADS)

    qc, kc, vc = qkv(pc)
    ql, kl, vl = qkv(pl)
    ql, kl = apply_rope(ql, cos, sin), apply_rope(kl, cos, sin)
    y_l = block_attention(ql, jnp.concatenate([kc, kl], 1), jnp.concatenate([vc, vl], 1))
    y_c = block_attention(qc, kc, vc) if keep_ctx else None
    return y_c, y_l


def hybrid_mixer(h_ctx, h_lat, w_in, ret_decay_logit, dn_conv_w, dn_a_log, dn_dt_bias, dn_norm_w,
                 att_qn_w, att_kn_w, cos, sin, keep_ctx):
    pc = jnp.split(h_ctx @ w_in, SPLIT_POINTS, axis=-1)
    pl = jnp.split(h_lat @ w_in, SPLIT_POINTS, axis=-1)
    rc, rl = retention_group(pc[0:4], pl[0:4], ret_decay_logit, cos, sin)
    dc, dl = deltanet_group(pc[4:8], pl[4:8], dn_conv_w, dn_a_log, dn_dt_bias, dn_norm_w)
    ac, al = attention_group(pc[8:11], pl[8:11], att_qn_w, att_kn_w, cos, sin, keep_ctx)
    y_lat = jnp.concatenate([rl, dl, al], -1)
    y_ctx = jnp.concatenate([rc, dc, ac], -1) if keep_ctx else None
    return y_ctx, y_lat


def swiglu(h, w_in, w_out):
    gate, up = jnp.split(h @ w_in, 2, -1)
    return (jax.nn.silu(gate) * up) @ w_out


def setup_inputs(seed: int = 0) -> dict:
    key = jax.random.key(seed)
    ks = jax.random.split(key, 24)
    f32 = jnp.float32

    def nrm(k, shape, scale):
        return jax.random.normal(k, shape, f32) * scale

    base_logit = jnp.log(2.0 ** (5.0 + jnp.arange(RET_HEADS, dtype=f32)) - 1.0)
    dt = jnp.exp(jax.random.uniform(ks[10], (DEPTH, 2, DN_HEADS), f32, math.log(1e-3), math.log(1e-1)))
    return {
        "x": nrm(ks[0], (BATCH, SEQ, D_MODEL), 1.0),
        "c": nrm(ks[1], (BATCH, D_MODEL), 1.0),
        "ctx": nrm(ks[2], (BATCH, CTX_LEN, D_MODEL), 1.0),
        "c_ctx": nrm(ks[3], (D_MODEL,), 1.0),
        "w_ada": nrm(ks[4], (DEPTH, D_MODEL, 6 * D_MODEL), 0.5 * D_MODEL ** -0.5),
        "b_ada": nrm(ks[5], (DEPTH, 6 * D_MODEL), 0.02),
        "w_in": nrm(ks[6], (DEPTH, D_MODEL, PROJ_W), D_MODEL ** -0.5),
        "ret_decay_logit": base_logit + nrm(ks[7], (DEPTH, 2, RET_HEADS), 0.1),
        "dn_conv_w": nrm(ks[8], (DEPTH, DN_CONV_K, 3 * DN_W), DN_CONV_K ** -0.5),
        "dn_a_log": jnp.log(jax.random.uniform(ks[9], (DEPTH, 2, DN_HEADS), f32, 1.0, 16.0)),
        "dn_dt_bias": dt + jnp.log(-jnp.expm1(-dt)),
        "dn_norm_w": 1.0 + nrm(ks[11], (DEPTH, HEAD_DIM), 0.02),
        "att_qn_w": 1.0 + nrm(ks[12], (DEPTH, HEAD_DIM), 0.02),
        "att_kn_w": 1.0 + nrm(ks[13], (DEPTH, HEAD_DIM), 0.02),
        "w_o": nrm(ks[14], (DEPTH, MIX_W, D_MODEL), MIX_W ** -0.5 * DEEPNORM_BETA),
        "ln1_w": 1.0 + nrm(ks[15], (DEPTH, D_MODEL), 0.02),
        "ln1_b": nrm(ks[16], (DEPTH, D_MODEL), 0.02),
        "w_ffn_in": nrm(ks[17], (DEPTH, D_MODEL, 2 * D_FF), D_MODEL ** -0.5),
        "w_ffn_out": nrm(ks[18], (DEPTH, D_FF, D_MODEL), D_FF ** -0.5 * DEEPNORM_BETA),
        "ln2_w": 1.0 + nrm(ks[19], (DEPTH, D_MODEL), 0.02),
        "ln2_b": nrm(ks[20], (DEPTH, D_MODEL), 0.02),
    }


def reference(x, c, ctx, c_ctx, w_ada, b_ada, w_in, ret_decay_logit, dn_conv_w, dn_a_log, dn_dt_bias,
              dn_norm_w, att_qn_w, att_kn_w, w_o, ln1_w, ln1_b, w_ffn_in, w_ffn_out, ln2_w, ln2_b):
    cos, sin = axial_rope(x.shape[1])
    cond_lat = jax.nn.silu(c)
    cond_ctx = jax.nn.silu(c_ctx)
    for i in range(DEPTH):
        keep_ctx = i < DEPTH - 1
        m_l = jnp.split((cond_lat @ w_ada[i] + b_ada[i])[:, None, :], 6, -1)
        m_c = jnp.split((cond_ctx @ w_ada[i] + b_ada[i])[None, None, :], 6, -1)
        y_c, y_l = hybrid_mixer(modulate(ctx, m_c[0], m_c[1]), modulate(x, m_l[0], m_l[1]), w_in[i],
                                ret_decay_logit[i], dn_conv_w[i], dn_a_log[i], dn_dt_bias[i], dn_norm_w[i],
                                att_qn_w[i], att_kn_w[i], cos, sin, keep_ctx)
        x = post_norm(x, m_l[2] * (y_l @ w_o[i]), ln1_w[i], ln1_b[i])
        x = post_norm(x, m_l[5] * swiglu(modulate(x, m_l[3], m_l[4]), w_ffn_in[i], w_ffn_out[i]),
                      ln2_w[i], ln2_b[i])
        if keep_ctx:
            ctx = post_norm(ctx, m_c[2] * (y_c @ w_o[i]), ln1_w[i], ln1_b[i])
            ctx = post_norm(ctx, m_c[5] * swiglu(modulate(ctx, m_c[3], m_c[4]), w_ffn_in[i], w_ffn_out[i]),
                            ln2_w[i], ln2_b[i])
    return x
```

```cpp
#include <hip/hip_runtime.h>
#include <hip/hip_bf16.h>
#include <cstdio>
#include <cstdint>

#ifndef MK_ONE_LAUNCH
#define MK_ONE_LAUNCH 0
#endif

constexpr int DM = 2048, NBATCH = 2, SEQ = 8192, CTXL = 256, TOK = CTXL + SEQ  , MROWS = NBATCH * TOK  , DEPTH = 4;
constexpr int HD = 128, DFF = 5632, PW = 5632  , PWPAD = 5888, PROJ_SRC = 5648;
constexpr int C_RQ = 0, C_RK = 512, C_RV = 1024, C_RG = 1536, C_DQKV = 2048, C_DZ = 3584, C_AQ = 4096, C_AK = 5120, C_AV = 5376;
constexpr int YW = 2048;
constexpr float ALPHA = 1.6817928305074292f;
constexpr float EPS = 1e-6f;
constexpr int DN_NCH = TOK / 64  , RET_NCH = TOK / 128  ;
constexpr int DN_PU = NBATCH * DN_NCH * 4 * 2  , RET_PU = NBATCH * RET_NCH * 4 * 2  ;

constexpr size_t MiB = 1u << 20;
constexpr size_t WS_CTL = 0, CTL_ZERO_BYTES = 1 * MiB;
constexpr size_t WS_MOD = 1 * MiB;
constexpr size_t WS_WIN = 2 * MiB;
constexpr size_t WS_WO = 94 * MiB;
constexpr size_t WS_WFI = 126 * MiB;
constexpr size_t WS_WFO = 302 * MiB;
constexpr size_t WS_X = 390 * MiB;
constexpr size_t WS_H = 522 * MiB;
constexpr size_t WS_P = 588 * MiB;
constexpr size_t WS_AB = 770 * MiB;
constexpr size_t WS_Y = 772 * MiB;
constexpr size_t WS_DQ = 838 * MiB;
constexpr size_t WS_DNW = 888 * MiB, WS_DNKC = 921 * MiB, WS_DNQG = 954 * MiB, WS_DNKGT = 987 * MiB;
constexpr size_t WS_DNQK = 1020 * MiB;
constexpr size_t WS_DNGL = 1037 * MiB;
constexpr size_t WS_ODN = 1038 * MiB;
constexpr size_t WS_ORET = 1104 * MiB;
constexpr size_t WS_RQKD = 1170 * MiB, WS_RKDT = 1203 * MiB;
constexpr size_t WS_END = 1236 * MiB;
static_assert(WS_WIN + (size_t)DEPTH * PWPAD * DM * 2 <= WS_WO && WS_WO + (size_t)DEPTH * DM * DM * 2 <= WS_WFI && WS_WFI + (size_t)DEPTH * 2 * DFF * DM * 2 <= WS_WFO && WS_WFO + (size_t)DEPTH * DM * DFF * 2 <= WS_X, "ws map (weights)");
static_assert(WS_X + (size_t)MROWS * DM * 4 <= WS_H && WS_H + (size_t)MROWS * DM * 2 <= WS_P && WS_P + (size_t)MROWS * PW * 2 <= WS_AB && WS_AB + (size_t)MROWS * 64 <= WS_Y && WS_Y + (size_t)MROWS * YW * 2 <= WS_DQ && WS_DQ + (size_t)MROWS * 1536 * 2 <= WS_DNW, "ws map (activations)");
static_assert(WS_DNW + (size_t)DN_PU * 16384 <= WS_DNKC && WS_DNQK + (size_t)DN_PU * 8192 <= WS_DNGL && WS_ODN + (size_t)2 * MROWS * 512 * 4 <= WS_ORET && WS_ORET + (size_t)2 * MROWS * 512 * 4 <= WS_RQKD && WS_RQKD + (size_t)RET_PU * 32768 <= WS_RKDT && WS_RKDT + (size_t)RET_PU * 32768 <= WS_END, "ws map (mixers)");
constexpr int CW_BAR = 4096;
constexpr int CW_ATTQ = 16384;

constexpr int RING_BYTES = 131072;
constexpr int MISC_OFF = RING_BYTES + 320;
constexpr int LDS_BYTES = 147456;
constexpr int NWAVES = 8;

#define GAS __attribute__((address_space(1)))
#define LAS __attribute__((address_space(3)))
typedef unsigned short bf16_t;
typedef short bf16x8 __attribute__((ext_vector_type(8)));
typedef short s16x4 __attribute__((ext_vector_type(4)));
typedef float f32x4 __attribute__((ext_vector_type(4)));
typedef float f32x2 __attribute__((ext_vector_type(2)));
typedef unsigned u32x4 __attribute__((ext_vector_type(4)));
typedef unsigned u32x2 __attribute__((ext_vector_type(2)));
#define LDS_WAIT() asm volatile("s_waitcnt lgkmcnt(0)" ::: "memory")
#define VM_WAIT() asm volatile("s_waitcnt vmcnt(0)" ::: "memory")
__device__ __forceinline__ unsigned f2bf(float f) { unsigned u = __builtin_bit_cast(unsigned, f); return (u + 0x7fffu + ((u >> 16) & 1u)) >> 16; }
__device__ __forceinline__ unsigned pk2(float lo, float hi) { return f2bf(lo) | (f2bf(hi) << 16); }
__device__ __forceinline__ float bf2f(unsigned short b) { return __builtin_bit_cast(float, ((unsigned)b) << 16); }
__device__ __forceinline__ float bflo(unsigned w) { return __builtin_bit_cast(float, w << 16); }
__device__ __forceinline__ float bfhi(unsigned w) { return __builtin_bit_cast(float, w & 0xffff0000u); }
__device__ __forceinline__ int opaque_tid() { int t = (int)threadIdx.x; asm volatile("" : "+v"(t)); return t; }
__device__ __forceinline__ unsigned char* opaque_ptr(unsigned char* p) { asm volatile("" : "+s"(p)); return p; }
__device__ __forceinline__ float wave_sum(float v) {
#pragma unroll
    for (int o = 1; o < 64; o <<= 1) v += __shfl_xor(v, o);
    return v;
}
__device__ __forceinline__ float sum16(float v) { v += __shfl_xor(v, 1); v += __shfl_xor(v, 2); v += __shfl_xor(v, 4); v += __shfl_xor(v, 8); return v; }
__device__ __forceinline__ float silu_f(float x) { return x / (1.f + __expf(-x)); }
__device__ __forceinline__ f32x4 mfma16(bf16x8 a, bf16x8 b, f32x4 c) { return __builtin_amdgcn_mfma_f32_16x16x32_bf16(a, b, c, 0, 0, 0); }
__device__ __forceinline__ bf16x8 ldsfrag(const LAS unsigned char* p) { return *(const LAS bf16x8*)p; }

#define XB_TMO      128
#define XB_XCNT(j)  (256  + 64 * (j))
#define XB_XSUB(j)  (1280 + 64 * (j))
#define XB_XGEN(j)  (2304 + 64 * (j))
#define XB_TOP      3328
#define XB_TOPGEN   3392
#define XCD_BAR_WORDS 3456
#define XB_SPIN_CAP (1u << 18)
__device__ __forceinline__ unsigned xb_ld(unsigned* p)              { return __hip_atomic_load(p, __ATOMIC_RELAXED, __HIP_MEMORY_SCOPE_AGENT); }
__device__ __forceinline__ unsigned xb_add(unsigned* p, unsigned v) { return __hip_atomic_fetch_add(p, v, __ATOMIC_RELAXED, __HIP_MEMORY_SCOPE_AGENT); }
__device__ __forceinline__ unsigned xb_xcc_id() { return (unsigned)__builtin_amdgcn_s_getreg((3 << 11) | 20) & 0xFu; }
#define XB_SPIN(cond, bar) do { unsigned _sp = 0; while (cond) { __builtin_amdgcn_s_sleep(1); \
    if ((++_sp & 255u) == 0u) { if (xb_ld(&(bar)[XB_TMO])) break; if (_sp > XB_SPIN_CAP) { atomicAdd(&(bar)[XB_TMO], 1u); break; } } } } while (0)
struct XcdBarrier { unsigned* bar; unsigned x; volatile LAS unsigned* st; };
__device__ __forceinline__ XcdBarrier xcd_barrier_post(unsigned* bar, volatile LAS unsigned* st) {
    XcdBarrier b; b.bar = bar; b.x = xb_xcc_id(); b.st = st;
    if (threadIdx.x == 0) (void)xb_add(&bar[XB_XCNT(b.x)], 1u);
    return b;
}
__device__ __forceinline__ void xcd_barrier_complete(unsigned* bar, unsigned x, unsigned& nloc, unsigned& nx) {
    const unsigned G = gridDim.x * gridDim.y * gridDim.z;
    unsigned sum, cnt, mine, sp = 0u;
    for (;;) {
        sum = 0u; cnt = 0u; mine = 0u;
#pragma unroll
        for (unsigned j = 0; j < 16; ++j) { const unsigned c = xb_ld(&bar[XB_XCNT(j)]); sum += c; cnt += (c > 0u) ? 1u : 0u; mine = (j == x) ? c : mine; }
        if (sum == G) break;
        __builtin_amdgcn_s_sleep(1);
        if ((++sp & 255u) == 0u) { if (xb_ld(&bar[XB_TMO])) break; if (sp > XB_SPIN_CAP) { atomicAdd(&bar[XB_TMO], 1u); break; } }
    }
    nloc = mine > 0u ? mine : 1u; nx = cnt > 0u ? cnt : 1u;
}
__device__ __forceinline__ void xcd_barrier(const XcdBarrier& b) {
    asm volatile("s_waitcnt vmcnt(0)" ::: "memory");
    __syncthreads();
    if (threadIdx.x == 0) {
        unsigned* bar = b.bar;
        __builtin_amdgcn_s_waitcnt(0);
        unsigned nloc = b.st[0], nx = b.st[1];
        if (nloc == 0u) { xcd_barrier_complete(bar, b.x, nloc, nx); b.st[0] = nloc; b.st[1] = nx; }
        const unsigned old = xb_add(&bar[XB_XSUB(b.x)], 1u);
        const unsigned gen = old / nloc;
        if (old + 1u == (gen + 1u) * nloc) {
            __builtin_amdgcn_fence(__ATOMIC_RELEASE, "agent");
            asm volatile("s_waitcnt vmcnt(0)" ::: "memory");
            const unsigned og = xb_add(&bar[XB_TOP], 1u);
            const unsigned tg = og / nx;
            if (og + 1u == (tg + 1u) * nx) xb_add(&bar[XB_TOPGEN], 1u);
            else XB_SPIN(xb_ld(&bar[XB_TOPGEN]) == tg, bar);
            __builtin_amdgcn_fence(__ATOMIC_ACQUIRE, "agent");
            xb_add(&bar[XB_XGEN(b.x)], 1u);
            asm volatile("s_waitcnt vmcnt(0)" ::: "memory");
        } else {
            XB_SPIN(xb_ld(&bar[XB_XGEN(b.x)]) == gen, bar);
            __builtin_amdgcn_fence(__ATOMIC_ACQUIRE, "agent");
            asm volatile("s_waitcnt vmcnt(0)" ::: "memory");
        }
    }
    __syncthreads();
}
namespace pg8 {
#define PG8_LAS __attribute__((address_space(3)))
typedef unsigned short bf16_t;
typedef short bf16x8 __attribute__((ext_vector_type(8)));
typedef float f32x4 __attribute__((ext_vector_type(4)));
typedef unsigned u32x4 __attribute__((ext_vector_type(4)));
constexpr int BM = 256, BK = 64, HALF = 128, HTB = HALF * BK * 2  , STAGE_BYTES = 8 * HTB, NXCD = 8, WGM = 8;

__host__ __device__ __forceinline__ int lds_byte(int r, int c) { const int st = (r >> 4) * 2 + (c >> 5), rr = r & 15, cc = c & 31, ob = rr * 64 + cc * 2; return st * 1024 + (ob ^ (((ob >> 9) & 1) << 5)); }
__host__ __device__ __forceinline__ void stage_rc(int b, int& R, int& C) { const int st = b / 1024, sb = b % 1024, swz = sb ^ (((sb >> 9) & 1) << 5); R = (st >> 1) * 16 + swz / 64; C = (st & 1) * 32 + (swz % 64) / 2; }
__host__ __device__ __forceinline__ int perm32(int rho) { const int n = rho >> 4, i = rho & 15; return 8 * (i >> 2) + 4 * n + (i & 3); }

struct Unit { int pm, pn; };
struct Gemm { const bf16_t* A; const bf16_t* Bt; int M, N, K; };

struct StaticOrder {
    int nM, nN, nwg, G, c;
    __host__ __device__ void init(int M, int N, int G_, int c_) { nM = M / BM; nN = N / BM; nwg = nM * nN; G = G_; c = c_; }
    __host__ __device__ bool next(int i, Unit& u) const {
        const long L = (long)i * G + c; if (L >= nwg) return false;
        int wgid = (int)L; { const int q = nwg / NXCD, r = nwg % NXCD, xcd = wgid % NXCD, off = wgid / NXCD; wgid = (xcd < r ? xcd * (q + 1) : r * (q + 1) + (xcd - r) * q) + off; }
        const int nig = WGM * nN, gid = wgid / nig, fm = gid * WGM, gsz = (nM - fm) < WGM ? (nM - fm) : WGM;
        u.pm = fm + ((wgid % nig) % gsz); u.pn = (wgid % nig) / gsz; return true;
    }
    __device__ __forceinline__ void a_ready(const Unit&) const {}
    __device__ __forceinline__ void done(const Unit&) const {}
};

__device__ __forceinline__ unsigned cvt_pk_bf16(float lo, float hi) { unsigned r; asm volatile("v_cvt_pk_bf16_f32 %0, %1, %2" : "=v"(r) : "v"(lo), "v"(hi)); return r; }
typedef float f32x2 __attribute__((ext_vector_type(2)));
struct RowOrder {
    int nM, nN, nwg, G, c, skip;
    __device__ __forceinline__ void init(int nN_, int G_, int c_, int skip_) { skip = skip_; nM = skip_ ? 64 : 66; nN = nN_; nwg = nM * nN; G = G_; c = c_; }
    __device__ __forceinline__ bool next(int i, Unit& u) const {
        const long L = (long)i * G + c; if (L >= nwg) return false;
        int wgid = (int)L; { const int q = nwg / NXCD, r = nwg % NXCD, xcd = wgid % NXCD, off = wgid / NXCD; wgid = (xcd < r ? xcd * (q + 1) : r * (q + 1) + (xcd - r) * q) + off; }
        const int nig = WGM * nN, gid = wgid / nig, fm = gid * WGM, gsz = (nM - fm) < WGM ? (nM - fm) : WGM;
        int pm = fm + ((wgid % nig) % gsz); u.pn = (wgid % nig) / gsz;
        if (skip) pm = pm + 1 + (pm >= 32 ? 1 : 0);
        u.pm = pm; return true;
    }
    __device__ __forceinline__ void a_ready(const Unit&) const {}
    __device__ __forceinline__ void done(const Unit&) const {}
};
struct EpiProj {
    static constexpr bool PERM = true, AFTER_DRAIN = false;
    bf16_t* P; float* AB;
    __device__ __forceinline__ void operator()(const f32x4 (&acc)[2][2][4][2], const Unit& u, int wr, int wc, int fr, int fq) const {
        const int row0 = u.pm * BM + wr * 64 + fr;
        if (u.pn < 22) {
            const int col0 = u.pn * BM + wc * 32 + 8 * fq;
#pragma unroll
            for (int ai = 0; ai < 2; ++ai)
#pragma unroll
                for (int m = 0; m < 4; ++m) { bf16_t* rowp = P + (size_t)(row0 + ai * HALF + m * 16) * 5632 + col0;
#pragma unroll
                    for (int bj = 0; bj < 2; ++bj) { const f32x4 v0 = acc[ai][bj][m][0], v1 = acc[ai][bj][m][1];
                        u32x4 w; w.x = cvt_pk_bf16(v0[0], v0[1]); w.y = cvt_pk_bf16(v0[2], v0[3]); w.z = cvt_pk_bf16(v1[0], v1[1]); w.w = cvt_pk_bf16(v1[2], v1[3]);
                        *(u32x4*)(rowp + bj * HALF) = w; } }
        } else if (wc == 0 && fq < 2) {
#pragma unroll
            for (int ai = 0; ai < 2; ++ai)
#pragma unroll
                for (int m = 0; m < 4; ++m) { float* rp = AB + (size_t)(row0 + ai * HALF + m * 16) * 16 + 8 * fq;
                    *(f32x4*)rp = acc[ai][0][m][0]; *(f32x4*)(rp + 4) = acc[ai][0][m][1]; }
        }
    }
};
struct EpiResid {
    static constexpr bool PERM = false, AFTER_DRAIN = false;
    float* X; const float* gate; float alpha;
    __device__ __forceinline__ void operator()(const f32x4 (&acc)[2][2][4][2], const Unit& u, int wr, int wc, int fr, int fq) const {
        const int s = (u.pm % 33 == 0) ? 2 : u.pm / 33; const float* g = gate + (size_t)s * 12288;
        const int row0 = u.pm * BM + wr * 64 + fr, col0 = u.pn * BM + wc * 32 + 4 * fq;
        f32x4 gv[2][2];
#pragma unroll
        for (int bj = 0; bj < 2; ++bj)
#pragma unroll
            for (int n = 0; n < 2; ++n) gv[bj][n] = *(const f32x4*)(g + col0 + bj * HALF + n * 16);
#pragma unroll
        for (int ai = 0; ai < 2; ++ai)
#pragma unroll
            for (int m = 0; m < 4; ++m) { float* rowp = X + (size_t)(row0 + ai * HALF + m * 16) * 2048 + col0;
#pragma unroll
                for (int bj = 0; bj < 2; ++bj)
#pragma unroll
                    for (int n = 0; n < 2; ++n) { f32x4 x = *(const f32x4*)(rowp + bj * HALF + n * 16); x = x * alpha + gv[bj][n] * acc[ai][bj][m][n]; *(f32x4*)(rowp + bj * HALF + n * 16) = x; } }
    }
};
__device__ __forceinline__ float silu_mul(float g, float u) { return g * u * __builtin_amdgcn_rcpf(1.f + __expf(-g)); }
struct EpiSwiglu {
    static constexpr bool PERM = true, AFTER_DRAIN = false;
    bf16_t* G;
    __device__ __forceinline__ void operator()(const f32x4 (&acc)[2][2][4][2], const Unit& u, int wr, int wc, int fr, int fq) const {
        const int row0 = u.pm * BM + wr * 64 + fr, col0 = u.pn * HALF + wc * 32 + 8 * fq;
#pragma unroll
        for (int ai = 0; ai < 2; ++ai)
#pragma unroll
            for (int m = 0; m < 4; ++m) { bf16_t* rowp = G + (size_t)(row0 + ai * HALF + m * 16) * 5632 + col0;
                const f32x4 g0 = acc[ai][0][m][0], g1 = acc[ai][0][m][1], u0 = acc[ai][1][m][0], u1 = acc[ai][1][m][1];
                u32x4 w; w.x = cvt_pk_bf16(silu_mul(g0[0], u0[0]), silu_mul(g0[1], u0[1])); w.y = cvt_pk_bf16(silu_mul(g0[2], u0[2]), silu_mul(g0[3], u0[3]));
                w.z = cvt_pk_bf16(silu_mul(g1[0], u1[0]), silu_mul(g1[1], u1[1])); w.w = cvt_pk_bf16(silu_mul(g1[2], u1[2]), silu_mul(g1[3], u1[3]));
                *(u32x4*)rowp = w; }
    }
};
template <class Epi, class Sched, bool ALIGN_EPI = false, bool SP2 = false>
__device__ __forceinline__ void gemm_phase(PG8_LAS unsigned char* lds, const Gemm g, const Sched& S, const Epi& E) {
    const int tid = opaque_tid(), wid = __builtin_amdgcn_readfirstlane(tid >> 6), lane = tid & 63, wr = wid >> 2, wc = wid & 3, fr = lane & 15, fq = lane >> 4;
    const int K = g.K, nt = K / BK;
    unsigned voffA[2], voffB[2];
#pragma unroll
    for (int i = 0; i < 2; ++i) { int R, C; stage_rc(tid * 16 + i * 8192, R, C); const int Rb = Epi::PERM ? ((R & ~31) + perm32(R & 31)) : R;
        voffA[i] = (unsigned)(R * K + C) * 2u; voffB[i] = (unsigned)(Rb * K + C) * 2u; }
    const size_t kstep = (size_t)(BK * 2);
    const size_t hstep = (size_t)HALF * K * 2;
    const size_t tstep = 2 * hstep;
    const unsigned ldsw = (unsigned)wid * 1024u;
    const int aoff = lds_byte(wr * 64 + fr, fq * 8), boff = lds_byte(wc * 32 + fr, fq * 8);
#define PG8_SA(b, h) (((b) * 2 + (h)) * HTB)
#define PG8_SB(b, h) ((4 + (b) * 2 + (h)) * HTB)
#define PG8_STAGE(bufoff, gbase, voff) do { _Pragma("unroll") for (int _i = 0; _i < 2; ++_i) \
        __builtin_amdgcn_global_load_lds((const unsigned*)((const char*)(gbase) + (voff)[_i]), (PG8_LAS unsigned*)(lds + (bufoff) + ldsw + _i * 8192), 16, 0, 0); } while (0)
#define PG8_LDA(dst, b, h) do { _Pragma("unroll") for (int m = 0; m < 4; ++m) _Pragma("unroll") for (int k = 0; k < 2; ++k) dst[m][k] = *(const PG8_LAS bf16x8*)(lds + PG8_SA(b, h) + aoff + m * 2048 + k * 1024); } while (0)
#define PG8_LDB(dst, b, h) do { _Pragma("unroll") for (int n = 0; n < 2; ++n) _Pragma("unroll") for (int k = 0; k < 2; ++k) dst[n][k] = *(const PG8_LAS bf16x8*)(lds + PG8_SB(b, h) + boff + n * 2048 + k * 1024); } while (0)
#define PG8_MMA(ai, bj, At, Bt) do { __builtin_amdgcn_s_setprio(1); _Pragma("unroll") for (int m = 0; m < 4; ++m) _Pragma("unroll") for (int n = 0; n < 2; ++n) _Pragma("unroll") for (int k = 0; k < 2; ++k) \
        acc[ai][bj][m][n] = __builtin_amdgcn_mfma_f32_16x16x32_bf16(Bt[n][k], At[m][k], acc[ai][bj][m][n], 0, 0, 0); __builtin_amdgcn_s_setprio(0); } while (0)
#define PG8_WAIT_V(n) asm volatile("s_waitcnt vmcnt(" #n ")" ::: "memory")
#define PG8_WAIT_L(n) asm volatile("s_waitcnt lgkmcnt(" #n ")" ::: "memory")
#define PG8_BAR __builtin_amdgcn_s_barrier()
#define PG8_SCHED __builtin_amdgcn_sched_barrier(0)
    Unit cur, nxt; int ui = 0;
    if (!S.next(0, cur)) return;
    f32x4 acc[2][2][4][2];
#pragma unroll
    for (int a = 0; a < 2; ++a)
#pragma unroll
        for (int b = 0; b < 2; ++b)
#pragma unroll
            for (int m = 0; m < 4; ++m)
#pragma unroll
                for (int n = 0; n < 2; ++n) acc[a][b][m][n] = (f32x4){0.f, 0.f, 0.f, 0.f};
    bf16x8 At[4][2], B0[2][2], B1[2][2];
    const char* cA = (const char*)g.A + (size_t)cur.pm * tstep; const char* cB = (const char*)g.Bt + (size_t)cur.pn * tstep;
    S.a_ready(cur);
    if constexpr (SP2) {
        PG8_STAGE(PG8_SB(0, 0), cB, voffB); PG8_STAGE(PG8_SB(0, 1), cB + hstep, voffB); PG8_STAGE(PG8_SA(0, 0), cA, voffA); PG8_STAGE(PG8_SA(0, 1), cA + hstep, voffA);
        if (wr == 1) PG8_BAR;
        PG8_WAIT_V(2); PG8_BAR;
        PG8_STAGE(PG8_SB(1, 0), cB + kstep, voffB); PG8_STAGE(PG8_SA(1, 0), cA + kstep, voffA); PG8_STAGE(PG8_SB(1, 1), cB + hstep + kstep, voffB);
        PG8_WAIT_V(6); PG8_BAR;
    } else {
        PG8_STAGE(PG8_SB(0, 0), cB, voffB); PG8_STAGE(PG8_SA(0, 0), cA, voffA); PG8_STAGE(PG8_SB(0, 1), cB + hstep, voffB); PG8_STAGE(PG8_SA(0, 1), cA + hstep, voffA);
        if (wr == 1) PG8_BAR;
        PG8_WAIT_V(4); PG8_BAR;
        PG8_STAGE(PG8_SB(1, 0), cB + kstep, voffB); PG8_STAGE(PG8_SA(1, 0), cA + kstep, voffA); PG8_STAGE(PG8_SB(1, 1), cB + hstep + kstep, voffB);
        PG8_WAIT_V(6); PG8_BAR;
    }
    for (;;) {
        const bool has_next = S.next(ui + 1, nxt);
        const char* nA = has_next ? (const char*)g.A + (size_t)nxt.pm * tstep : cA; const char* nB = has_next ? (const char*)g.Bt + (size_t)nxt.pn * tstep : cB;
        for (int t = 0; t < nt; t += 2) {
            const bool last = (t == nt - 2);
            const char* a1 = cA + (size_t)(t + 1) * kstep;
            const char* a2 = last ? nA : cA + (size_t)(t + 2) * kstep; const char* b2 = last ? nB : cB + (size_t)(t + 2) * kstep;
            const char* a3 = a2 + kstep; const char* b3 = b2 + kstep;
            if (last && has_next) S.a_ready(nxt);
            if constexpr (SP2) {
            PG8_LDB(B0, 0, 0); PG8_LDB(B1, 0, 1); PG8_SCHED; PG8_LDA(At, 0, 0); PG8_STAGE(PG8_SA(1, 1), a1 + hstep, voffA);
            PG8_WAIT_V(8); PG8_WAIT_L(0); PG8_BAR; PG8_MMA(0, 0, At, B0); PG8_MMA(0, 1, At, B1); PG8_BAR; PG8_SCHED;
            PG8_LDA(At, 0, 1); PG8_STAGE(PG8_SB(0, 0), b2, voffB); PG8_STAGE(PG8_SB(0, 1), b2 + hstep, voffB); PG8_STAGE(PG8_SA(0, 0), a2, voffA);
            PG8_WAIT_V(8); PG8_WAIT_L(0); PG8_BAR; PG8_MMA(1, 0, At, B0); PG8_MMA(1, 1, At, B1); PG8_BAR; PG8_SCHED;
            PG8_LDB(B0, 1, 0); PG8_LDB(B1, 1, 1); PG8_SCHED; PG8_LDA(At, 1, 0); PG8_STAGE(PG8_SA(0, 1), a2 + hstep, voffA);
            PG8_WAIT_V(8); PG8_WAIT_L(0); PG8_BAR; PG8_MMA(0, 0, At, B0); PG8_MMA(0, 1, At, B1); PG8_BAR; PG8_SCHED;
            PG8_LDA(At, 1, 1); PG8_STAGE(PG8_SB(1, 0), b3, voffB); PG8_STAGE(PG8_SB(1, 1), b3 + hstep, voffB); PG8_STAGE(PG8_SA(1, 0), a3, voffA);
            PG8_WAIT_V(8); PG8_WAIT_L(0); PG8_BAR; PG8_MMA(1, 0, At, B0); PG8_MMA(1, 1, At, B1); PG8_BAR; PG8_SCHED;
            } else {
            PG8_LDB(B0, 0, 0); PG8_SCHED; PG8_LDA(At, 0, 0); PG8_STAGE(PG8_SA(1, 1), a1 + hstep, voffA);
            PG8_WAIT_L(8); PG8_BAR; PG8_WAIT_L(0); PG8_MMA(0, 0, At, B0); PG8_BAR; PG8_SCHED;
            PG8_LDB(B1, 0, 1); PG8_STAGE(PG8_SB(0, 0), b2, voffB);
            PG8_BAR; PG8_WAIT_L(0); PG8_MMA(0, 1, At, B1); PG8_BAR;
            PG8_LDA(At, 0, 1); PG8_STAGE(PG8_SA(0, 0), a2, voffA);
            PG8_BAR; PG8_WAIT_L(0); PG8_MMA(1, 0, At, B0); PG8_BAR; PG8_SCHED;
            PG8_STAGE(PG8_SB(0, 1), b2 + hstep, voffB);
            PG8_WAIT_V(6); PG8_BAR; PG8_MMA(1, 1, At, B1); PG8_BAR;
            PG8_LDB(B0, 1, 0); PG8_SCHED; PG8_LDA(At, 1, 0); PG8_STAGE(PG8_SA(0, 1), a2 + hstep, voffA);
            PG8_WAIT_L(8); PG8_BAR; PG8_WAIT_L(0); PG8_MMA(0, 0, At, B0); PG8_BAR; PG8_SCHED;
            PG8_LDB(B1, 1, 1); PG8_STAGE(PG8_SB(1, 0), b3, voffB);
            PG8_BAR; PG8_WAIT_L(0); PG8_MMA(0, 1, At, B1); PG8_BAR;
            PG8_LDA(At, 1, 1); PG8_STAGE(PG8_SA(1, 0), a3, voffA);
            PG8_BAR; PG8_WAIT_L(0); PG8_MMA(1, 0, At, B0); PG8_BAR; PG8_SCHED;
            PG8_STAGE(PG8_SB(1, 1), b3 + hstep, voffB);
            PG8_WAIT_V(6); PG8_BAR; PG8_MMA(1, 1, At, B1); PG8_BAR;
            }
        }
        if constexpr (ALIGN_EPI) { if (wr == 0) PG8_BAR; }
        if constexpr (!Epi::AFTER_DRAIN) { E(acc, cur, wr, wc, fr, fq); S.done(cur); }
        if (!has_next) break;
#pragma unroll
        for (int a = 0; a < 2; ++a)
#pragma unroll
            for (int b = 0; b < 2; ++b)
#pragma unroll
                for (int m = 0; m < 4; ++m)
#pragma unroll
                    for (int n = 0; n < 2; ++n) acc[a][b][m][n] = (f32x4){0.f, 0.f, 0.f, 0.f};
        cur = nxt; cA = nA; cB = nB; ++ui;
        if constexpr (ALIGN_EPI) { if (wr == 1) PG8_BAR; }
    }
    PG8_WAIT_V(0);
    if constexpr (!ALIGN_EPI) { if (wr == 0) PG8_BAR; }
    PG8_BAR;
    if constexpr (Epi::AFTER_DRAIN) { E.fused(acc, cur, wr, wc, fr, fq, lds, wid, lane); S.done(cur); }
#undef PG8_SA
#undef PG8_SB
#undef PG8_STAGE
#undef PG8_LDA
#undef PG8_LDB
#undef PG8_MMA
#undef PG8_WAIT_V
#undef PG8_WAIT_L
#undef PG8_BAR
#undef PG8_SCHED
}
}
namespace att {
using bf16 = __hip_bfloat16;
constexpr int D = 128, NW = 8, QBLK = 32, KVBLK = 64;
constexpr float SCALE = 0.088388347648318440f;
constexpr float THR = 8.f;
constexpr int SDEPTH = 2;
constexpr int LDQ = PW, LDK = PW, LDO = YW;
constexpr size_t SHM_V = KVBLK * D * 2, SHM_K = KVBLK * D * 2, SHM_ATTN = 2 * SHM_V + 2 * SHM_K + NW * 64 * 4;
using bf16x8 = __attribute__((ext_vector_type(8))) short;
using s16x4  = __attribute__((ext_vector_type(4))) short;
using f32x16 = __attribute__((ext_vector_type(16))) float;
using f32x8  = __attribute__((ext_vector_type(8))) float;
using u32x4  = __attribute__((ext_vector_type(4))) unsigned;
#define KSWZ(row, colB) ((row) * 256 + ((colB) ^ (((row) & 7) << 4)))
#define SBAR() __builtin_amdgcn_sched_barrier(0)
__device__ __forceinline__ int crow(int r, int hi) { return (r & 3) + 8 * (r >> 2) + 4 * hi; }
__device__ __forceinline__ unsigned cvtpk(float lo, float hi) {
  unsigned r; asm volatile("v_cvt_pk_bf16_f32 %0, %1, %2" : "=v"(r) : "v"(lo), "v"(hi)); return r;
}
template <typename TIn> struct Stage;
template <> struct Stage<bf16>  { using T = bf16x8;
  __device__ static __forceinline__ T ld8(const bf16* p) { return *reinterpret_cast<const bf16x8*>(p); }
  __device__ static __forceinline__ bf16x8 tobf(T x) { return x; } };
template <> struct Stage<float> { using T = f32x8;
  __device__ static __forceinline__ T ld8(const float* p) { return *reinterpret_cast<const f32x8*>(p); }
  __device__ static __forceinline__ bf16x8 tobf(T x) {
    u32x4 w = {cvtpk(x[0], x[1]), cvtpk(x[2], x[3]), cvtpk(x[4], x[5]), cvtpk(x[6], x[7])}; return *reinterpret_cast<bf16x8*>(&w); } };

__device__ __forceinline__ void partialSM(f32x16& p0, f32x16& p1, float& m_reg, float& mn, float& alpha) {
  constexpr float C = SCALE * 1.4426950408889634f;
  float pmax = p0[0]; for (int r = 1; r < 16; ++r) pmax = fmaxf(pmax, p0[r]); for (int r = 0; r < 16; ++r) pmax = fmaxf(pmax, p1[r]);
  { auto rr = __builtin_amdgcn_permlane32_swap(__float_as_uint(pmax), __float_as_uint(pmax), false, false);
    pmax = fmaxf(__uint_as_float(rr[0]), __uint_as_float(rr[1])); }
  if (__builtin_expect(__all(pmax - m_reg <= THR / SCALE), 1)) { mn = m_reg; alpha = 1.f; }
  else { mn = fmaxf(m_reg, pmax); alpha = __builtin_amdgcn_exp2f((m_reg - mn) * C); m_reg = mn; }
  float mnC = -mn * C;
  for (int r = 0; r < 16; ++r) p0[r] = fmaf(p0[r], C, mnC); for (int r = 0; r < 16; ++r) p1[r] = fmaf(p1[r], C, mnC);
  for (int r = 0; r < 16; ++r) p0[r] = __builtin_amdgcn_exp2f(p0[r]);
}
__device__ __forceinline__ void finishSM(f32x16& p0, f32x16& p1, float alpha, float& l_reg, bf16x8& pa0, bf16x8& pa1, bf16x8& pa2, bf16x8& pa3) {
  for (int r = 0; r < 16; ++r) p1[r] = __builtin_amdgcn_exp2f(p1[r]);
  float ps = 0; for (int r = 0; r < 16; ++r) ps += p0[r]; for (int r = 0; r < 16; ++r) ps += p1[r];
  { auto rr = __builtin_amdgcn_permlane32_swap(__float_as_uint(ps), __float_as_uint(ps), false, false);
    ps = __uint_as_float(rr[0]) + __uint_as_float(rr[1]); }
  l_reg = l_reg * alpha + ps;
#define PK4(P, BASE, OUT) do { unsigned a0 = cvtpk(P[BASE + 0], P[BASE + 1]), a1 = cvtpk(P[BASE + 2], P[BASE + 3]);   \
    unsigned b0 = cvtpk(P[BASE + 4], P[BASE + 5]), b1 = cvtpk(P[BASE + 6], P[BASE + 7]);                              \
    auto r0 = __builtin_amdgcn_permlane32_swap(a0, b0, false, false); auto r1 = __builtin_amdgcn_permlane32_swap(a1, b1, false, false); \
    u32x4 w = {r0[0], r1[0], r0[1], r1[1]}; OUT = *reinterpret_cast<bf16x8*>(&w); } while (0)
  PK4(p0, 0, pa0); PK4(p0, 8, pa1); PK4(p1, 0, pa2); PK4(p1, 8, pa3);
#undef PK4
}
__device__ __forceinline__ void qkt(f32x16& p0, f32x16& p1, const bf16* Ks, const bf16x8* qr, int r32, int hi) {
  p0 = f32x16{}; p1 = f32x16{};
  for (int d0 = 0; d0 < 8; ++d0) { int cb = (d0 * 16 + hi * 8) * 2;
    bf16x8 b0 = *reinterpret_cast<const bf16x8*>((const char*)Ks + KSWZ(r32, cb));
    bf16x8 b1 = *reinterpret_cast<const bf16x8*>((const char*)Ks + KSWZ(32 + r32, cb));
    p0 = __builtin_amdgcn_mfma_f32_32x32x16_bf16(b0, qr[d0], p0, 0, 0, 0);
    p1 = __builtin_amdgcn_mfma_f32_32x32x16_bf16(b1, qr[d0], p1, 0, 0, 0); }
}
__device__ __forceinline__ int v_st(int k, int c) { const int kk = (k & ~0xC) | ((k & 4) << 1) | ((k & 8) >> 1); return ((kk >> 3) * 4 + (c >> 5)) * 512 + ((kk & 7) * 32 + (c & 31)) * 2; }
__device__ __forceinline__ int v_rd_base(int lane) { return ((lane & 3) << 3) | (((lane >> 2) & 3) << 6) | (((lane >> 4) & 1) << 5) | (((lane >> 5) & 1) << 8); }
constexpr int v_rd_off(int d0, int ks, int half) { return d0 * 512 + ks * 4096 + half * 2048; }
template <int OFF> __device__ __forceinline__ s16x4 tr_read(int vb) {
  s16x4 r; asm volatile("ds_read_b64_tr_b16 %0, %1 offset:%2" : "=&v"(r) : "v"(vb), "i"(OFF) : "memory"); return r;
}
template <int D0> __device__ __forceinline__ void pv_one(f32x16& od, int vb, bf16x8 pa0, bf16x8 pa1, bf16x8 pa2, bf16x8 pa3) {
  const s16x4 l0 = tr_read<v_rd_off(D0, 0, 0)>(vb), h0 = tr_read<v_rd_off(D0, 0, 1)>(vb), l1 = tr_read<v_rd_off(D0, 1, 0)>(vb), h1 = tr_read<v_rd_off(D0, 1, 1)>(vb);
  const s16x4 l2 = tr_read<v_rd_off(D0, 2, 0)>(vb), h2 = tr_read<v_rd_off(D0, 2, 1)>(vb), l3 = tr_read<v_rd_off(D0, 3, 0)>(vb), h3 = tr_read<v_rd_off(D0, 3, 1)>(vb);
  asm volatile("s_waitcnt lgkmcnt(0)" ::: "memory"); SBAR();
#define PK(L, H) (bf16x8){L[0], L[1], L[2], L[3], H[0], H[1], H[2], H[3]}
  od = __builtin_amdgcn_mfma_f32_32x32x16_bf16(pa0, PK(l0, h0), od, 0, 0, 0);
  od = __builtin_amdgcn_mfma_f32_32x32x16_bf16(pa1, PK(l1, h1), od, 0, 0, 0);
  od = __builtin_amdgcn_mfma_f32_32x32x16_bf16(pa2, PK(l2, h2), od, 0, 0, 0);
  od = __builtin_amdgcn_mfma_f32_32x32x16_bf16(pa3, PK(l3, h3), od, 0, 0, 0);
#undef PK
}
__device__ __forceinline__ void pv_d0(f32x16* o, int vb, bf16x8 pa0, bf16x8 pa1, bf16x8 pa2, bf16x8 pa3) {
  pv_one<0>(o[0], vb, pa0, pa1, pa2, pa3); pv_one<1>(o[1], vb, pa0, pa1, pa2, pa3); pv_one<2>(o[2], vb, pa0, pa1, pa2, pa3); pv_one<3>(o[3], vb, pa0, pa1, pa2, pa3);
}

template <typename TQ>
__device__ __forceinline__ void attn_dense_body(const TQ* __restrict__ Qb, const bf16* __restrict__ Kh, const bf16* __restrict__ Vh,
                                                unsigned short* __restrict__ Ob, int seq, char* lds) {
  using St = Stage<bf16>; using SQ = Stage<TQ>;
  const int tid = opaque_tid(), wid = tid >> 6, lane = tid & 63, r32 = lane & 31, hi = lane >> 5;
  bf16* V_lds = (bf16*)lds; bf16* K_lds = (bf16*)(lds + 2 * SHM_V);
  float* ws = (float*)(lds + 2 * SHM_V + 2 * SHM_K) + wid * 64; float* li_l = ws; float* al_l = ws + 32;
  float m_reg = -1e30f, l_reg = 0; f32x16 o[4] = {}; bf16x8 qr[8];
  const TQ* Qw = Qb + (long)(wid * QBLK + r32) * LDQ + hi * 8;
#pragma unroll
  for (int d0 = 0; d0 < 8; ++d0) qr[d0] = SQ::tobf(SQ::ld8(Qw + d0 * 16));
  const int sr = tid >> 4, sc = (tid & 15) * 8, vst0 = v_st(sr, sc), vst1 = v_st(32 + sr, sc);
  const int vb0 = (int)(uintptr_t)V_lds + v_rd_base(lane);
  struct { typename St::T vs0, vs1, ks0, ks1; } sr_[SDEPTH];
#define SLOAD(i, k0) do { sr_[i].vs0 = St::ld8(&Vh[(long)((k0) + sr) * LDK + sc]); sr_[i].vs1 = St::ld8(&Vh[(long)((k0) + 32 + sr) * LDK + sc]); \
    sr_[i].ks0 = St::ld8(&Kh[(long)((k0) + sr) * LDK + sc]); sr_[i].ks1 = St::ld8(&Kh[(long)((k0) + 32 + sr) * LDK + sc]); } while (0)
#define SWRITE(b, i) do { *(bf16x8*)((char*)V_lds + (b) * SHM_V + vst0) = St::tobf(sr_[i].vs0);          \
    *(bf16x8*)((char*)V_lds + (b) * SHM_V + vst1) = St::tobf(sr_[i].vs1); int kc = sc * 2;               \
    *(bf16x8*)((char*)K_lds + (b) * SHM_K + KSWZ(sr, kc)) = St::tobf(sr_[i].ks0);                       \
    *(bf16x8*)((char*)K_lds + (b) * SHM_K + KSWZ(32 + sr, kc)) = St::tobf(sr_[i].ks1); } while (0)
#define SWAIT() do { if constexpr (SDEPTH == 2) asm volatile("s_waitcnt vmcnt(4)" ::: "memory"); else asm volatile("s_waitcnt vmcnt(0)" ::: "memory"); } while (0)
#define RESC(a) do { if (__any((a) < 1.f)) { if (hi == 0) al_l[r32] = (a); asm volatile("s_waitcnt lgkmcnt(0)" ::: "memory"); \
    for (int d = 0; d < 4; ++d) for (int r = 0; r < 16; ++r) o[d][r] *= al_l[crow(r, hi)]; } } while (0)
  f32x16 pA0, pA1, pB0, pB1; float mnA, mnB, alA, alB; bf16x8 pa0, pa1, pa2, pa3; const int NT = seq / KVBLK;
  constexpr int SE = 0, SO = SDEPTH - 1;
  SLOAD(SE, 0); asm volatile("s_waitcnt vmcnt(0)" ::: "memory"); SWRITE(0, SE); __syncthreads();
  qkt(pA0, pA1, K_lds, qr, r32, hi); partialSM(pA0, pA1, m_reg, mnA, alA);
  SLOAD(SO, KVBLK); if constexpr (SDEPTH == 2) { if (2 < NT) SLOAD(SE, 2 * KVBLK); }
  SWAIT(); SWRITE(1, SO); __syncthreads();
  for (int j = 1; j + 1 < NT; j += 2) {
    SBAR(); qkt(pB0, pB1, (bf16*)((char*)K_lds + SHM_K), qr, r32, hi);
    finishSM(pA0, pA1, alA, l_reg, pa0, pa1, pa2, pa3); SBAR();
    SLOAD(SO, (j + SDEPTH) * KVBLK); SBAR();
    pv_d0(o, vb0, pa0, pa1, pa2, pa3); partialSM(pB0, pB1, m_reg, mnB, alB);
    __syncthreads(); SWAIT(); SWRITE(0, SE);
    RESC(alB); __syncthreads();
    SBAR(); qkt(pA0, pA1, K_lds, qr, r32, hi);
    finishSM(pB0, pB1, alB, l_reg, pa0, pa1, pa2, pa3); SBAR();
    if (SDEPTH == 1 || j + 3 < NT) SLOAD(SE, (j + 1 + SDEPTH) * KVBLK); SBAR();
    pv_d0(o, vb0 + (int)SHM_V, pa0, pa1, pa2, pa3); partialSM(pA0, pA1, m_reg, mnA, alA);
    __syncthreads(); SWAIT(); SWRITE(1, SO);
    RESC(alA); __syncthreads();
  }
  SBAR(); qkt(pB0, pB1, (bf16*)((char*)K_lds + SHM_K), qr, r32, hi);
  finishSM(pA0, pA1, alA, l_reg, pa0, pa1, pa2, pa3); SBAR();
  pv_d0(o, vb0, pa0, pa1, pa2, pa3); partialSM(pB0, pB1, m_reg, mnB, alB);
  __syncthreads(); RESC(alB);
  finishSM(pB0, pB1, alB, l_reg, pa0, pa1, pa2, pa3); SBAR();
  pv_d0(o, vb0 + (int)SHM_V, pa0, pa1, pa2, pa3);
  if (hi == 0) li_l[r32] = l_reg; asm volatile("s_waitcnt lgkmcnt(0)" ::: "memory");
  float rli[16];
#pragma unroll
  for (int r = 0; r < 16; ++r) rli[r] = __builtin_amdgcn_rcpf(li_l[crow(r, hi)]);
  unsigned short* Ow = Ob + (long)(wid * QBLK) * LDO;
#pragma unroll
  for (int r = 0; r < 16; ++r) { int orow = crow(r, hi);
    for (int d0 = 0; d0 < 4; ++d0) Ow[(long)orow * LDO + d0 * 32 + r32] = (unsigned short)f2bf(o[d0][r] * rli[r]); }
#undef SLOAD
#undef SWRITE
#undef SWAIT
#undef RESC
}
}
struct Frame {
    LAS unsigned char* lds; unsigned char* ldsg;
    volatile LAS unsigned* MISC;
    unsigned* ctl; unsigned char* ws;
    int tid, lane, wave, G, vcu;
};
__device__ __forceinline__ const float* inp(const Frame& F, int k) {
    const unsigned lo = __builtin_amdgcn_readfirstlane(F.MISC[16 + 2 * k]), hi = __builtin_amdgcn_readfirstlane(F.MISC[17 + 2 * k]);
    return (const float*)(((unsigned long long)hi << 32) | (unsigned long long)lo);
}
enum { I_x = 0, I_c, I_ctx, I_c_ctx, I_w_ada, I_b_ada, I_w_in, I_ret_decay, I_dn_conv_w, I_dn_a_log, I_dn_dt_bias, I_dn_norm_w, I_att_qn_w, I_att_kn_w, I_w_o, I_ln1_w, I_ln1_b, I_w_ffi, I_w_ffo, I_ln2_w, I_ln2_b, I_out };

__device__ __forceinline__ void transpose_item(const float* W, int ldw, bf16_t* WT, int K, int dst_row0, int src_col0, int ncols, int k0, LAS float* scr, int lane) {
    const int cc = lane & 31;
#pragma unroll 8
    for (int i = 0; i < 32; ++i) { const int kk = 2 * i + (lane >> 5); scr[kk * 33 + cc] = (cc < ncols) ? W[(size_t)(k0 + kk) * ldw + src_col0 + cc] : 0.f; }
    LDS_WAIT();
    const int c8 = lane & 7;
#pragma unroll
    for (int j = 0; j < 4; ++j) { const int n = (lane >> 3) + 8 * j; const LAS float* s = scr + (8 * c8) * 33 + n;
        u32x4 o; o.x = pk2(s[0 * 33], s[1 * 33]); o.y = pk2(s[2 * 33], s[3 * 33]); o.z = pk2(s[4 * 33], s[5 * 33]); o.w = pk2(s[6 * 33], s[7 * 33]);
        if (n < ncols) *(u32x4*)(WT + (size_t)(dst_row0 + n) * K + k0 + 8 * c8) = o; }
    LDS_WAIT();
}
__device__ __forceinline__ void prologue_phase(Frame& F) {
    LAS float* scr = (LAS float*)(F.lds + F.wave * 8448);
    const int gw = F.vcu * NWAVES + F.wave, NGW = F.G * NWAVES, lane = F.lane;
    bf16_t* Win_t = (bf16_t*)(F.ws + WS_WIN); bf16_t* Wo_t = (bf16_t*)(F.ws + WS_WO); bf16_t* Wfi_t = (bf16_t*)(F.ws + WS_WFI); bf16_t* Wfo_t = (bf16_t*)(F.ws + WS_WFO);
    constexpr int I_IN = 32 * 177, I_O = 32 * 64, I_FI = 32 * 352, I_FO = 88 * 64, I_L = I_IN + I_O + I_FI + I_FO;
    for (int it = gw; it < DEPTH * I_L; it += NGW) {
        const int l = it / I_L; int r = it - l * I_L;
        if (r < I_IN) { const int kb = r / 177, nb = r - kb * 177; int dst = 32 * nb, src = 32 * nb, nc = 32;
            if (nb >= 128) src += 16; if (nb == 176) { dst = 5632; src = 4096; nc = 16; }
            transpose_item(inp(F, I_w_in) + (size_t)l * DM * PROJ_SRC, PROJ_SRC, Win_t + (size_t)l * PWPAD * DM, DM, dst, src, nc, 64 * kb, scr, lane); continue; }
        r -= I_IN;
        if (r < I_O) { const int kb = r >> 6, nb = r & 63;
            transpose_item(inp(F, I_w_o) + (size_t)l * DM * DM, DM, Wo_t + (size_t)l * DM * DM, DM, 32 * nb, 32 * nb, 32, 64 * kb, scr, lane); continue; }
        r -= I_O;
        if (r < I_FI) { const int kb = r / 352, nb = r - kb * 352, pn = nb >> 3, q = nb & 7; const int src = q < 4 ? 128 * pn + 32 * q : DFF + 128 * pn + 32 * (q - 4);
            transpose_item(inp(F, I_w_ffi) + (size_t)l * DM * 2 * DFF, 2 * DFF, Wfi_t + (size_t)l * 2 * DFF * DM, DM, 32 * nb, src, 32, 64 * kb, scr, lane); continue; }
        r -= I_FI;
        { const int kb = r >> 6, nb = r & 63;
            transpose_item(inp(F, I_w_ffo) + (size_t)l * DFF * DM, DM, Wfo_t + (size_t)l * DM * DFF, DFF, 32 * nb, 32 * nb, 32, 64 * kb, scr, lane); }
    }
    { constexpr int PER_L = (PWPAD - PROJ_SRC) * DM / 8;
      for (int i = (F.vcu * NWAVES * 64) + F.tid; i < DEPTH * PER_L; i += F.G * NWAVES * 64) { const int l = i / PER_L, j = i - l * PER_L;
          *(u32x4*)(Win_t + (size_t)l * PWPAD * DM + (size_t)PROJ_SRC * DM + (size_t)j * 8) = (u32x4){0u, 0u, 0u, 0u}; } }
    LAS float* cond = (LAS float*)(F.lds + 73728);
    LAS float* red = (LAS float*)(F.lds + 98304);
    __syncthreads();
    for (int i = F.tid; i < 3 * DM; i += NWAVES * 64) { const int s = i / DM, k = i - s * DM; const float v = s < 2 ? inp(F, I_c)[s * DM + k] : inp(F, I_c_ctx)[k]; cond[i] = v / (1.f + expf(-v)); }
    __syncthreads();
    float* MOD = (float*)(F.ws + WS_MOD);
    for (int item = F.vcu; item < DEPTH * 96; item += F.G) {
        const int l = item / 96, cb = item - l * 96;
        const float* W = inp(F, I_w_ada) + (size_t)l * DM * 12288 + cb * 128 + 2 * lane;
        float a00 = 0.f, a01 = 0.f, a10 = 0.f, a11 = 0.f, a20 = 0.f, a21 = 0.f;
        const int kbeg = F.wave * 256;
#pragma unroll 8
        for (int k = kbeg; k < kbeg + 256; ++k) { const f32x2 w = *(const f32x2*)(W + (size_t)k * 12288); const float c0 = cond[k], c1 = cond[DM + k], c2 = cond[2 * DM + k];
            a00 += c0 * w.x; a01 += c0 * w.y; a10 += c1 * w.x; a11 += c1 * w.y; a20 += c2 * w.x; a21 += c2 * w.y; }
        red[(F.wave * 3 + 0) * 128 + 2 * lane] = a00; red[(F.wave * 3 + 0) * 128 + 2 * lane + 1] = a01;
        red[(F.wave * 3 + 1) * 128 + 2 * lane] = a10; red[(F.wave * 3 + 1) * 128 + 2 * lane + 1] = a11;
        red[(F.wave * 3 + 2) * 128 + 2 * lane] = a20; red[(F.wave * 3 + 2) * 128 + 2 * lane + 1] = a21;
        __syncthreads();
        if (F.tid < 384) { const int s = F.tid >> 7, cc = F.tid & 127; float sum = inp(F, I_b_ada)[l * 12288 + cb * 128 + cc];
#pragma unroll
            for (int w = 0; w < 8; ++w) sum += red[(w * 3 + s) * 128 + cc];
            MOD[(size_t)(l * 3 + s) * 12288 + cb * 128 + cc] = sum; }
        __syncthreads();
    }
}

template <int MODE> __device__ __forceinline__ void ln_mod_phase(Frame& F, int l, bool skip_ctx) {
    float* X = (float*)(F.ws + WS_X); bf16_t* H = (bf16_t*)(F.ws + WS_H); const float* MOD = (const float*)(F.ws + WS_MOD);
    const int gw = F.vcu * NWAVES + F.wave, NGW = F.G * NWAVES, lane = F.lane;
    const float* lw = (MODE == 1 ? inp(F, I_ln1_w) : inp(F, I_ln2_w)) + l * DM; const float* lb = (MODE == 1 ? inp(F, I_ln1_b) : inp(F, I_ln2_b)) + l * DM;
    const int lm = MODE == 0 ? 0 : (MODE == 1 ? l : l + 1), ish = MODE == 1 ? 3 : 0, isc = MODE == 1 ? 4 : 1;
    for (int r = gw; r < MROWS; r += NGW) {
        const int b = r / TOK, tp = r - b * TOK; const bool is_ctx = tp < CTXL; const int s = is_ctx ? 2 : b;
        if ((skip_ctx || MODE == 3) && is_ctx) continue;
        const float* src = MODE == 0 ? (is_ctx ? inp(F, I_ctx) + (size_t)(b * CTXL + tp) * DM : inp(F, I_x) + (size_t)(b * SEQ + tp - CTXL) * DM) : X + (size_t)r * DM;
        f32x4 v[8];
#pragma unroll
        for (int j = 0; j < 8; ++j) v[j] = *(const f32x4*)(src + 4 * lane + 256 * j);
        if (MODE != 0) {
            float sm = 0.f;
#pragma unroll
            for (int j = 0; j < 8; ++j) sm += (v[j][0] + v[j][1]) + (v[j][2] + v[j][3]);
            const float mean = wave_sum(sm) * (1.f / DM); float sq = 0.f;
#pragma unroll
            for (int j = 0; j < 8; ++j) { v[j] = v[j] - mean; sq += (v[j][0] * v[j][0] + v[j][1] * v[j][1]) + (v[j][2] * v[j][2] + v[j][3] * v[j][3]); }
            const float rstd = rsqrtf(wave_sum(sq) * (1.f / DM) + EPS);
#pragma unroll
            for (int j = 0; j < 8; ++j) { const f32x4 w = *(const f32x4*)(lw + 4 * lane + 256 * j), bb = *(const f32x4*)(lb + 4 * lane + 256 * j); v[j] = v[j] * rstd * w + bb; }
        }
        if (MODE == 3) {
            float* o = (float*)inp(F, I_out) + (size_t)(b * SEQ + tp - CTXL) * DM;
#pragma unroll
            for (int j = 0; j < 8; ++j) *(f32x4*)(o + 4 * lane + 256 * j) = v[j];
        } else {
            const float* msh = MOD + (size_t)(lm * 3 + s) * 12288 + ish * DM; const float* msc = MOD + (size_t)(lm * 3 + s) * 12288 + isc * DM;
#pragma unroll
            for (int j = 0; j < 8; ++j) { *(f32x4*)(X + (size_t)r * DM + 4 * lane + 256 * j) = v[j];
                const f32x4 sh = *(const f32x4*)(msh + 4 * lane + 256 * j), sc = *(const f32x4*)(msc + 4 * lane + 256 * j); const f32x4 hh = v[j] * (sc + 1.f) + sh;
                u32x2 w; w.x = pk2(hh[0], hh[1]); w.y = pk2(hh[2], hh[3]); *(u32x2*)(H + (size_t)r * DM + 4 * lane + 256 * j) = w; }
        }
    }
}

__device__ __forceinline__ void rowprep_phase(Frame& F, int l) {
    bf16_t* P = (bf16_t*)(F.ws + WS_P); float* AB = (float*)(F.ws + WS_AB); bf16_t* DQ = (bf16_t*)(F.ws + WS_DQ);
    const int lane = F.lane, gw = F.vcu * NWAVES + F.wave, NGW = F.G * NWAVES;
    const float qw1 = inp(F, I_att_qn_w)[l * 128 + lane], qw2 = inp(F, I_att_qn_w)[l * 128 + 64 + lane], kw1 = inp(F, I_att_kn_w)[l * 128 + lane], kw2 = inp(F, I_att_kn_w)[l * 128 + 64 + lane];
    const float* cw = inp(F, I_dn_conv_w) + (size_t)l * 5 * 1536;
    const float inv = powf(10000.f, -(float)(lane & 31) * (1.f / 32.f));
    const float nega = lane < 8 ? -expf(inp(F, I_dn_a_log)[l * 8 + lane]) : 0.f, dtb = lane < 8 ? inp(F, I_dn_dt_bias)[l * 8 + lane] : 0.f;
    for (int r = gw; r < MROWS; r += NGW) {
        const int b = r / TOK, tp = r - b * TOK; const bool is_ctx = tp < CTXL;
        float cs = 1.f, sn = 0.f;
        if (!is_ctx) { const int t = tp - CTXL; const float pos = (lane < 32) ? (float)(t >> 6) : (float)(t & 63); sincosf(pos * inv, &sn, &cs); }
        bf16_t* p = P + (size_t)r * PW;
        for (int hh = 0; hh < 10; ++hh) {
            const int base = hh < 8 ? C_AQ + hh * 128 : C_AK + (hh - 8) * 128;
            float x1 = bf2f(p[base + lane]), x2 = bf2f(p[base + 64 + lane]);
            const float ri = rsqrtf(wave_sum(x1 * x1 + x2 * x2) * (1.f / 128.f) + EPS);
            x1 *= ri * (hh < 8 ? qw1 : kw1); x2 *= ri * (hh < 8 ? qw2 : kw2);
            p[base + lane] = (bf16_t)f2bf(x1 * cs - x2 * sn); p[base + 64 + lane] = (bf16_t)f2bf(x1 * sn + x2 * cs);
        }
        for (int hh = 0; hh < 8; ++hh) {
            const int base = hh < 4 ? C_RQ + hh * 128 : C_RK + (hh - 4) * 128; const float ks = hh < 4 ? 1.f : 0.088388347648318440f;
            const float x1 = bf2f(p[base + lane]), x2 = bf2f(p[base + 64 + lane]);
            p[base + lane] = (bf16_t)f2bf((x1 * cs - x2 * sn) * ks); p[base + 64 + lane] = (bf16_t)f2bf((x1 * sn + x2 * cs) * ks);
        }
#pragma unroll
        for (int j = 0; j < 3; ++j) {
            const int c0 = 8 * (lane + 64 * j); float a[8];
#pragma unroll
            for (int e = 0; e < 8; ++e) a[e] = 0.f;
#pragma unroll
            for (int k = 0; k < 5; ++k) { const int rr = tp + k - 2; const bool valid = is_ctx ? (rr >= 0 && rr < CTXL) : (rr >= CTXL && rr < TOK);
                if (valid) { const u32x4 xv = *(const u32x4*)(P + (size_t)(r + k - 2) * PW + C_DQKV + c0); const f32x4 w0 = *(const f32x4*)(cw + k * 1536 + c0), w1 = *(const f32x4*)(cw + k * 1536 + c0 + 4);
                    a[0] += w0[0] * bflo(xv.x); a[1] += w0[1] * bfhi(xv.x); a[2] += w0[2] * bflo(xv.y); a[3] += w0[3] * bfhi(xv.y);
                    a[4] += w1[0] * bflo(xv.z); a[5] += w1[1] * bfhi(xv.z); a[6] += w1[2] * bflo(xv.w); a[7] += w1[3] * bfhi(xv.w); } }
            float ss = 0.f;
#pragma unroll
            for (int e = 0; e < 8; ++e) { a[e] = a[e] / (1.f + __expf(-a[e])); ss += a[e] * a[e]; }
            if (j < 2) { const float sc = rsqrtf(sum16(ss) + EPS) * (j == 0 ? 0.088388347648318440f : 1.f);
#pragma unroll
                for (int e = 0; e < 8; ++e) a[e] *= sc; }
            u32x4 o; o.x = pk2(a[0], a[1]); o.y = pk2(a[2], a[3]); o.z = pk2(a[4], a[5]); o.w = pk2(a[6], a[7]);
            *(u32x4*)(DQ + (size_t)r * 1536 + c0) = o;
        }
        if (lane < 8) { const float av = AB[(size_t)r * 16 + lane], bv = AB[(size_t)r * 16 + 8 + lane]; const float xx = av + dtb; const float sp = xx > 20.f ? xx : log1pf(expf(xx));
            AB[(size_t)r * 16 + lane] = nega * sp; AB[(size_t)r * 16 + 8 + lane] = 1.f / (1.f + expf(-bv)); }
    }
}

constexpr int DP_QS = 0, DP_KS = 17408, DP_KT = 36864, DP_VT = 55296, DP_AS = 73728, DP_GC = 108544;
__device__ __forceinline__ void dnprep_unit(Frame& F, int unit) {
    const bf16_t* DQ = (const bf16_t*)(F.ws + WS_DQ); const float* GB = (const float*)(F.ws + WS_AB);
    bf16_t* DNW = (bf16_t*)(F.ws + WS_DNW); bf16_t* DNKC = (bf16_t*)(F.ws + WS_DNKC); bf16_t* DNQG = (bf16_t*)(F.ws + WS_DNQG); bf16_t* DNKGT = (bf16_t*)(F.ws + WS_DNKGT); bf16_t* DNQK = (bf16_t*)(F.ws + WS_DNQK); float* DNGL = (float*)(F.ws + WS_DNGL);
    LAS unsigned char* L = F.lds; LAS float* gcs = (LAS float*)(L + DP_GC); LAS float* bes = gcs + 128; LAS float* AS = (LAS float*)(L + DP_AS);
    const int tid = F.tid, lane = F.lane, wave = F.wave, rr = lane & 15, kg = lane >> 4;
    const int h = unit & 3, cg = (unit >> 2) % DN_NCH, b = (unit >> 2) / DN_NCH, rbase = b * TOK + 64 * cg;
    const size_t pu0 = (size_t)((b * DN_NCH + cg) * 4 + h) * 2;
    if (wave < 2) { const int dir = wave, tok = dir ? 63 - lane : lane; const size_t row = rbase + tok;
        float s = GB[row * 16 + dir * 4 + h]; const float be = GB[row * 16 + 8 + dir * 4 + h];
#pragma unroll
        for (int o = 1; o < 64; o <<= 1) { const float t = __shfl_up(s, o); if (lane >= o) s += t; }
        gcs[dir * 64 + lane] = s; bes[dir * 64 + lane] = be; }
    { const int row = tid >> 3, seg = tid & 7; const bf16_t* src = DQ + (size_t)(rbase + row) * 1536 + h * 128 + seg * 16;
      const u32x4 q0 = *(const u32x4*)src, q1 = *(const u32x4*)(src + 8), k0 = *(const u32x4*)(src + 512), k1 = *(const u32x4*)(src + 520), v0 = *(const u32x4*)(src + 1024), v1 = *(const u32x4*)(src + 1032);
      *(LAS u32x4*)(L + DP_QS + row * 272 + seg * 32) = q0; *(LAS u32x4*)(L + DP_QS + row * 272 + seg * 32 + 16) = q1;
      *(LAS u32x4*)(L + DP_KS + row * 272 + seg * 32) = k0; *(LAS u32x4*)(L + DP_KS + row * 272 + seg * 32 + 16) = k1;
      const unsigned kw[8] = {k0.x, k0.y, k0.z, k0.w, k1.x, k1.y, k1.z, k1.w}, vw[8] = {v0.x, v0.y, v0.z, v0.w, v1.x, v1.y, v1.z, v1.w};
#pragma unroll
      for (int e = 0; e < 8; ++e) { const int d = seg * 16 + 2 * e;
          *(LAS bf16_t*)(L + DP_KT + (d * 72 + row) * 2) = (bf16_t)(kw[e] & 0xffffu); *(LAS bf16_t*)(L + DP_KT + ((d + 1) * 72 + row) * 2) = (bf16_t)(kw[e] >> 16);
          *(LAS bf16_t*)(L + DP_VT + (d * 72 + row) * 2) = (bf16_t)(vw[e] & 0xffffu); *(LAS bf16_t*)(L + DP_VT + ((d + 1) * 72 + row) * 2) = (bf16_t)(vw[e] >> 16); } }
    __syncthreads();
#pragma unroll
    for (int jj = 0; jj < 2; ++jj) {
        const int it = wave >> 1, jt = 2 * (wave & 1) + jj; f32x4 kk = {0.f, 0.f, 0.f, 0.f}, qk = {0.f, 0.f, 0.f, 0.f};
#pragma unroll
        for (int ks = 0; ks < 4; ++ks) { const bf16x8 aK = ldsfrag(L + DP_KS + (16 * jt + rr) * 272 + (32 * ks + 8 * kg) * 2), bK = ldsfrag(L + DP_KS + (16 * it + rr) * 272 + (32 * ks + 8 * kg) * 2), bQ = ldsfrag(L + DP_QS + (16 * it + rr) * 272 + (32 * ks + 8 * kg) * 2);
            kk = mfma16(aK, bK, kk); qk = mfma16(aK, bQ, qk); }
        const int i = 16 * it + rr, jb = 16 * jt + 4 * kg;
        { const float gi = gcs[i], bi = bes[i]; float av[4], qv[4];
#pragma unroll
          for (int r = 0; r < 4; ++r) { const int j = jb + r; const float e = (j <= i) ? __expf(gi - gcs[j]) : 0.f; av[r] = (j < i) ? bi * kk[r] * e : 0.f; qv[r] = qk[r] * e; }
          *(LAS f32x4*)(AS + i * 68 + jb) = (f32x4){av[0], av[1], av[2], av[3]};
          u32x2 w; w.x = pk2(qv[0], qv[1]); w.y = pk2(qv[2], qv[3]); *(u32x2*)(DNQK + (pu0 + 0) * 4096 + i * 64 + jb) = w; }
        { const int i1 = 63 - i; const float gi = gcs[64 + i1], bi = bes[64 + i1]; float av[4], qv[4];
#pragma unroll
          for (int r = 0; r < 4; ++r) { const int j1 = 63 - (jb + r); const float e = (j1 <= i1) ? __expf(gi - gcs[64 + j1]) : 0.f; av[r] = (j1 < i1) ? bi * kk[r] * e : 0.f; qv[r] = qk[r] * e; }
          const int jl = 60 - jb;
          *(LAS f32x4*)(AS + 64 * 68 + i1 * 68 + jl) = (f32x4){av[3], av[2], av[1], av[0]};
          u32x2 w; w.x = pk2(qv[3], qv[2]); w.y = pk2(qv[1], qv[0]); *(u32x2*)(DNQK + (pu0 + 1) * 4096 + i1 * 64 + jl) = w; }
    }
    { const int row = tid >> 3, seg = tid & 7;
#pragma unroll
      for (int dir = 0; dir < 2; ++dir) { const int tok = dir ? 63 - row : row; const float e = __expf(gcs[dir * 64 + row]);
          const u32x4 a0 = *(const LAS u32x4*)(L + DP_QS + tok * 272 + seg * 32), a1 = *(const LAS u32x4*)(L + DP_QS + tok * 272 + seg * 32 + 16);
          u32x4 o0, o1; o0.x = pk2(bflo(a0.x) * e, bfhi(a0.x) * e); o0.y = pk2(bflo(a0.y) * e, bfhi(a0.y) * e); o0.z = pk2(bflo(a0.z) * e, bfhi(a0.z) * e); o0.w = pk2(bflo(a0.w) * e, bfhi(a0.w) * e);
          o1.x = pk2(bflo(a1.x) * e, bfhi(a1.x) * e); o1.y = pk2(bflo(a1.y) * e, bfhi(a1.y) * e); o1.z = pk2(bflo(a1.z) * e, bfhi(a1.z) * e); o1.w = pk2(bflo(a1.w) * e, bfhi(a1.w) * e);
          bf16_t* dst = DNQG + (pu0 + dir) * 8192 + row * 128 + seg * 16; *(u32x4*)dst = o0; *(u32x4*)(dst + 8) = o1; } }
    { const int d = tid >> 2, sg = tid & 3;
#pragma unroll
      for (int dir = 0; dir < 2; ++dir) { const float gl = gcs[dir * 64 + 63]; unsigned ow[8];
#pragma unroll
          for (int e = 0; e < 8; ++e) { const int i0 = 16 * sg + 2 * e, i1 = i0 + 1; const int t0 = dir ? 63 - i0 : i0, t1 = dir ? 63 - i1 : i1;
              const float v0 = bf2f(*(const LAS bf16_t*)(L + DP_KT + (d * 72 + t0) * 2)) * __expf(gl - gcs[dir * 64 + i0]), v1 = bf2f(*(const LAS bf16_t*)(L + DP_KT + (d * 72 + t1) * 2)) * __expf(gl - gcs[dir * 64 + i1]);
              ow[e] = pk2(v0, v1); }
          bf16_t* dst = DNKGT + (pu0 + dir) * 8192 + d * 64 + 16 * sg; *(u32x4*)dst = (u32x4){ow[0], ow[1], ow[2], ow[3]}; *(u32x4*)(dst + 8) = (u32x4){ow[4], ow[5], ow[6], ow[7]}; } }
    if (tid < 2) DNGL[pu0 + tid] = __expf(gcs[tid * 64 + 63]);
    __syncthreads();
    if (wave < 2) { const int dir = wave; const LAS float* A = AS + dir * 64 * 68; float t[64];
#pragma unroll
        for (int i = 0; i < 64; ++i) { float acc0 = (i == lane) ? 1.f : 0.f, acc1 = 0.f;
#pragma unroll
            for (int j4 = 0; j4 < (i + 3) / 4; ++j4) { const f32x4 a = *(const LAS f32x4*)(A + i * 68 + 4 * j4);
                if (4 * j4 + 0 < i) acc0 -= a[0] * t[4 * j4 + 0]; if (4 * j4 + 1 < i) acc1 -= a[1] * t[4 * j4 + 1];
                if (4 * j4 + 2 < i) acc0 -= a[2] * t[4 * j4 + 2]; if (4 * j4 + 3 < i) acc1 -= a[3] * t[4 * j4 + 3]; }
            t[i] = acc0 + acc1; }
        const float be = bes[dir * 64 + lane], bg = be * __expf(gcs[dir * 64 + lane]); const int tau = dir ? 63 - lane : lane;
        LAS bf16_t* TP = (LAS bf16_t*)(L + (dir * 2 + 0) * 9216); LAS bf16_t* TPP = (LAS bf16_t*)(L + (dir * 2 + 1) * 9216);
#pragma unroll
        for (int i = 0; i < 64; ++i) { TP[i * 72 + tau] = (bf16_t)f2bf(t[i] * be); TPP[i * 72 + tau] = (bf16_t)f2bf(t[i] * bg); } }
    __syncthreads();
#pragma unroll
    for (int mat = 0; mat < 2; ++mat) { const LAS unsigned char* As_ = L + (mat ? DP_KT : DP_VT); bf16x8 a[2];
#pragma unroll
        for (int ks = 0; ks < 2; ++ks) a[ks] = ldsfrag(As_ + (16 * wave + rr) * 144 + (32 * ks + 8 * kg) * 2);
#pragma unroll
        for (int dir = 0; dir < 2; ++dir) { const LAS unsigned char* Bs_ = L + (dir * 2 + mat) * 9216; bf16_t* OUT = (mat ? DNKC : DNW) + (pu0 + dir) * 8192;
#pragma unroll
            for (int it = 0; it < 4; ++it) { f32x4 c = {0.f, 0.f, 0.f, 0.f};
#pragma unroll
                for (int ks = 0; ks < 2; ++ks) c = mfma16(a[ks], ldsfrag(Bs_ + (16 * it + rr) * 144 + (32 * ks + 8 * kg) * 2), c);
                u32x2 w; w.x = pk2(c[0], c[1]); w.y = pk2(c[2], c[3]); *(u32x2*)(OUT + (16 * it + rr) * 128 + 16 * wave + 4 * kg) = w; } } }
    __syncthreads();
}

constexpr int DS_KC = 0, DS_QG = 17408, DS_KGT = 34816, DS_QK = 53248, DS_W = 62464, DS_SB = 67584, DS_VT = 76288;
__device__ __forceinline__ void dnscan_unit(Frame& F, int unit) {
    const bf16_t* DNW = (const bf16_t*)(F.ws + WS_DNW); const bf16_t* DNKC = (const bf16_t*)(F.ws + WS_DNKC); const bf16_t* DNQG = (const bf16_t*)(F.ws + WS_DNQG); const bf16_t* DNKGT = (const bf16_t*)(F.ws + WS_DNKGT); const bf16_t* DNQK = (const bf16_t*)(F.ws + WS_DNQK); const float* DNGL = (const float*)(F.ws + WS_DNGL);
    float* ODN = (float*)(F.ws + WS_ODN);
    LAS unsigned char* L = F.lds;
    const int tid = F.tid, lane = F.lane, wave = F.wave, rr = lane & 15, kg = lane >> 4;
    const int sl = unit & 3, dir = (unit >> 2) & 1, h = (unit >> 3) & 3, b = unit >> 5;
    const int mt = wave >> 1, nt = wave & 1, dt0 = 2 * (wave >> 1), dt1 = dt0 + 1;
    f32x4 s0 = {0.f, 0.f, 0.f, 0.f}, s1 = {0.f, 0.f, 0.f, 0.f};
    for (int i = tid; i < 8704 / 4; i += NWAVES * 64) ((LAS unsigned*)(L + DS_SB))[i] = 0u;
    u32x4 rKC[2], rQG[2], rKGT[2], rQK, rW = {0u, 0u, 0u, 0u}; float rGL;
#define DS_CG(t) (dir ? ((t) < 4 ? 3 - (t) : 135 - (t)) : (t))
#define DS_LOAD(t) do { const size_t pu_ = (size_t)((b * DN_NCH + DS_CG(t)) * 4 + h) * 2 + dir; \
        _Pragma("unroll") for (int q_ = 0; q_ < 2; ++q_) { const int id_ = tid + 512 * q_; \
            rKC[q_] = *(const u32x4*)(DNKC + pu_ * 8192 + (id_ >> 4) * 128 + (id_ & 15) * 8); rQG[q_] = *(const u32x4*)(DNQG + pu_ * 8192 + (id_ >> 4) * 128 + (id_ & 15) * 8); \
            rKGT[q_] = *(const u32x4*)(DNKGT + pu_ * 8192 + (id_ >> 3) * 64 + (id_ & 7) * 8); } \
        rQK = *(const u32x4*)(DNQK + pu_ * 4096 + (tid >> 3) * 64 + (tid & 7) * 8); \
        if (tid < 256) rW = *(const u32x4*)(DNW + pu_ * 8192 + (tid >> 2) * 128 + sl * 32 + (tid & 3) * 8); \
        rGL = DNGL[pu_]; } while (0)
#define DS_STORE() do { _Pragma("unroll") for (int q_ = 0; q_ < 2; ++q_) { const int id_ = tid + 512 * q_; \
            *(LAS u32x4*)(L + DS_KC + (id_ >> 4) * 272 + (id_ & 15) * 16) = rKC[q_]; *(LAS u32x4*)(L + DS_QG + (id_ >> 4) * 272 + (id_ & 15) * 16) = rQG[q_]; \
            *(LAS u32x4*)(L + DS_KGT + (id_ >> 3) * 144 + (id_ & 7) * 16) = rKGT[q_]; } \
        *(LAS u32x4*)(L + DS_QK + (tid >> 3) * 144 + (tid & 7) * 16) = rQK; \
        if (tid < 256) *(LAS u32x4*)(L + DS_W + (tid >> 2) * 80 + (tid & 3) * 16) = rW; } while (0)
    DS_LOAD(0); VM_WAIT(); DS_STORE(); float gl = rGL;
    __syncthreads();
    for (int t = 0; t < DN_NCH; ++t) {
        const int cg = DS_CG(t);
        if (t + 1 < DN_NCH) DS_LOAD(t + 1);
        bf16x8 bS[4]; f32x4 av = {0.f, 0.f, 0.f, 0.f};
#pragma unroll
        for (int ks = 0; ks < 4; ++ks) { bS[ks] = ldsfrag(L + DS_SB + (16 * nt + rr) * 272 + (32 * ks + 8 * kg) * 2); av = mfma16(ldsfrag(L + DS_KC + (16 * mt + rr) * 272 + (32 * ks + 8 * kg) * 2), bS[ks], av); }
        float vn[4];
#pragma unroll
        for (int r = 0; r < 4; ++r) vn[r] = bf2f(*(const LAS bf16_t*)(L + DS_W + (16 * mt + 4 * kg + r) * 80 + (16 * nt + rr) * 2)) - av[r];
        { u32x2 w; w.x = pk2(vn[0], vn[1]); w.y = pk2(vn[2], vn[3]); *(LAS u32x2*)(L + DS_VT + (16 * nt + rr) * 144 + (16 * mt + 4 * kg) * 2) = w; }
        __syncthreads();
        f32x4 ao = {0.f, 0.f, 0.f, 0.f};
#pragma unroll
        for (int ks = 0; ks < 4; ++ks) ao = mfma16(ldsfrag(L + DS_QG + (16 * mt + rr) * 272 + (32 * ks + 8 * kg) * 2), bS[ks], ao);
        bf16x8 bV[2];
#pragma unroll
        for (int ks = 0; ks < 2; ++ks) { bV[ks] = ldsfrag(L + DS_VT + (16 * nt + rr) * 144 + (32 * ks + 8 * kg) * 2); ao = mfma16(ldsfrag(L + DS_QK + (16 * mt + rr) * 144 + (32 * ks + 8 * kg) * 2), bV[ks], ao); }
#pragma unroll
        for (int r = 0; r < 4; ++r) { const int i = 16 * mt + 4 * kg + r, tok = dir ? 63 - i : i;
            ODN[((size_t)dir * MROWS + (size_t)(b * TOK + 64 * cg + tok)) * 512 + h * 128 + sl * 32 + 16 * nt + rr] = ao[r]; }
        s0 = s0 * gl; s1 = s1 * gl;
#pragma unroll
        for (int ks = 0; ks < 2; ++ks) { s0 = mfma16(ldsfrag(L + DS_KGT + (16 * dt0 + rr) * 144 + (32 * ks + 8 * kg) * 2), bV[ks], s0); s1 = mfma16(ldsfrag(L + DS_KGT + (16 * dt1 + rr) * 144 + (32 * ks + 8 * kg) * 2), bV[ks], s1); }
        __syncthreads();
        { u32x2 w; w.x = pk2(s0[0], s0[1]); w.y = pk2(s0[2], s0[3]); *(LAS u32x2*)(L + DS_SB + (16 * nt + rr) * 272 + (16 * dt0 + 4 * kg) * 2) = w;
          w.x = pk2(s1[0], s1[1]); w.y = pk2(s1[2], s1[3]); *(LAS u32x2*)(L + DS_SB + (16 * nt + rr) * 272 + (16 * dt1 + 4 * kg) * 2) = w; }
        if (t + 1 < DN_NCH) { VM_WAIT(); DS_STORE(); gl = rGL; }
        __syncthreads();
    }
#undef DS_CG
#undef DS_LOAD
#undef DS_STORE
}

__device__ __forceinline__ float log_sigmoid_f(float x) { return -log1pf(expf(-x)); }
constexpr int RP_QS = 0, RP_KS = 34816;
__device__ __forceinline__ void retprep_unit(Frame& F, int l, int unit) {
    const bf16_t* P = (const bf16_t*)(F.ws + WS_P); bf16_t* RQKD = (bf16_t*)(F.ws + WS_RQKD); bf16_t* RKDT = (bf16_t*)(F.ws + WS_RKDT);
    LAS unsigned char* L = F.lds;
    const int tid = F.tid, lane = F.lane, wave = F.wave, rr = lane & 15, kg = lane >> 4;
    const int h = unit & 3, c = (unit >> 2) % RET_NCH, b = (unit >> 2) / RET_NCH, rbase = b * TOK + 128 * c;
    const size_t pu0 = (size_t)((b * RET_NCH + c) * 4 + h) * 2;
    const float lg0 = log_sigmoid_f(inp(F, I_ret_decay)[l * 8 + h]), lg1 = log_sigmoid_f(inp(F, I_ret_decay)[l * 8 + 4 + h]);
    { const int row = tid >> 2, seg = tid & 3; const bf16_t* src = P + (size_t)(rbase + row) * PW + h * 128 + seg * 32;
#pragma unroll
      for (int q = 0; q < 4; ++q) { *(LAS u32x4*)(L + RP_QS + row * 272 + seg * 64 + q * 16) = *(const u32x4*)(src + C_RQ + q * 8); *(LAS u32x4*)(L + RP_KS + row * 272 + seg * 64 + q * 16) = *(const u32x4*)(src + C_RK + q * 8); } }
    __syncthreads();
    { bf16x8 bQ[4];
#pragma unroll
      for (int ks = 0; ks < 4; ++ks) bQ[ks] = ldsfrag(L + RP_QS + (16 * wave + rr) * 272 + (32 * ks + 8 * kg) * 2);
      const int i = 16 * wave + rr;
      for (int jt = 0; jt < 8; ++jt) { f32x4 cc = {0.f, 0.f, 0.f, 0.f};
#pragma unroll
          for (int ks = 0; ks < 4; ++ks) cc = mfma16(ldsfrag(L + RP_KS + (16 * jt + rr) * 272 + (32 * ks + 8 * kg) * 2), bQ[ks], cc);
          const int jb = 16 * jt + 4 * kg; float v0[4], v1[4];
#pragma unroll
          for (int r = 0; r < 4; ++r) { const int j = jb + r; v0[r] = (j <= i) ? cc[r] * __expf((float)(i - j) * lg0) : 0.f; v1[r] = (j >= i) ? cc[r] * __expf((float)(j - i) * lg1) : 0.f; }
          u32x2 w; w.x = pk2(v0[0], v0[1]); w.y = pk2(v0[2], v0[3]); *(u32x2*)(RQKD + (pu0 + 0) * 16384 + i * 128 + jb) = w;
          w.x = pk2(v1[3], v1[2]); w.y = pk2(v1[1], v1[0]); *(u32x2*)(RQKD + (pu0 + 1) * 16384 + (127 - i) * 128 + (124 - jb)) = w; } }
    { const int d = tid >> 2, sg = tid & 3;
#pragma unroll
      for (int dir = 0; dir < 2; ++dir) { const float lg = dir ? lg1 : lg0;
#pragma unroll
          for (int q = 0; q < 4; ++q) { unsigned ow[4];
#pragma unroll
              for (int e = 0; e < 4; ++e) { const int j0 = 32 * sg + 8 * q + 2 * e, j1 = j0 + 1; const int t0 = dir ? 127 - j0 : j0, t1 = dir ? 127 - j1 : j1;
                  const float a0 = bf2f(*(const LAS bf16_t*)(L + RP_KS + t0 * 272 + d * 2)) * __expf((float)(127 - j0) * lg), a1 = bf2f(*(const LAS bf16_t*)(L + RP_KS + t1 * 272 + d * 2)) * __expf((float)(127 - j1) * lg);
                  ow[e] = pk2(a0, a1); }
              *(u32x4*)(RKDT + (pu0 + dir) * 16384 + d * 128 + 32 * sg + 8 * q) = (u32x4){ow[0], ow[1], ow[2], ow[3]}; } } }
    __syncthreads();
}

constexpr int RS_QS = 0, RS_QKD = 34816, RS_KDT = 69632, RS_VT = 104448, RS_SB = 113152;
__device__ __forceinline__ void retscan_unit(Frame& F, int l, int unit) {
    const bf16_t* P = (const bf16_t*)(F.ws + WS_P); const bf16_t* RQKD = (const bf16_t*)(F.ws + WS_RQKD); const bf16_t* RKDT = (const bf16_t*)(F.ws + WS_RKDT); float* ORET = (float*)(F.ws + WS_ORET);
    LAS unsigned char* L = F.lds;
    const int tid = F.tid, lane = F.lane, wave = F.wave, rr = lane & 15, kg = lane >> 4;
    const int sl = unit & 3, dir = (unit >> 2) & 1, h = (unit >> 3) & 3, b = unit >> 5;
    const float lg = log_sigmoid_f(inp(F, I_ret_decay)[l * 8 + dir * 4 + h]), gC = __expf(128.f * lg);
    f32x4 s[2]; s[0] = (f32x4){0.f, 0.f, 0.f, 0.f}; s[1] = s[0];
    for (int i = tid; i < 8704 / 4; i += NWAVES * 64) ((LAS unsigned*)(L + RS_SB))[i] = 0u;
    u32x4 rQ[4], rD[4], rK[4], rV;
#define RS_C(t) (dir ? ((t) < 2 ? 1 - (t) : 67 - (t)) : (t))
#define RS_LOAD(t) do { const int c_ = RS_C(t); const size_t pu_ = (size_t)((b * RET_NCH + c_) * 4 + h) * 2 + dir; const size_t rb_ = (size_t)b * TOK + 128 * c_; \
        _Pragma("unroll") for (int q_ = 0; q_ < 4; ++q_) { const int id_ = tid + 512 * q_, row_ = id_ >> 4, c16_ = id_ & 15; const int tok_ = dir ? 127 - row_ : row_; \
            rQ[q_] = *(const u32x4*)(P + (rb_ + tok_) * PW + C_RQ + h * 128 + c16_ * 8); rD[q_] = *(const u32x4*)(RQKD + pu_ * 16384 + row_ * 128 + c16_ * 8); rK[q_] = *(const u32x4*)(RKDT + pu_ * 16384 + row_ * 128 + c16_ * 8); } \
        { const int row_ = tid >> 2, tok_ = dir ? 127 - row_ : row_; rV = *(const u32x4*)(P + (rb_ + tok_) * PW + C_RV + h * 128 + sl * 32 + (tid & 3) * 8); } } while (0)
#define RS_STORE() do { _Pragma("unroll") for (int q_ = 0; q_ < 4; ++q_) { const int id_ = tid + 512 * q_, row_ = id_ >> 4, c16_ = id_ & 15; \
            *(LAS u32x4*)(L + RS_QS + row_ * 272 + c16_ * 16) = rQ[q_]; *(LAS u32x4*)(L + RS_QKD + row_ * 272 + c16_ * 16) = rD[q_]; *(LAS u32x4*)(L + RS_KDT + row_ * 272 + c16_ * 16) = rK[q_]; } \
        { const int row_ = tid >> 2, e0_ = (tid & 3) * 8; const unsigned vw_[4] = {rV.x, rV.y, rV.z, rV.w}; \
          _Pragma("unroll") for (int e_ = 0; e_ < 4; ++e_) { *(LAS bf16_t*)(L + RS_VT + (e0_ + 2 * e_) * 272 + row_ * 2) = (bf16_t)(vw_[e_] & 0xffffu); *(LAS bf16_t*)(L + RS_VT + (e0_ + 2 * e_ + 1) * 272 + row_ * 2) = (bf16_t)(vw_[e_] >> 16); } } } while (0)
    RS_LOAD(0); VM_WAIT(); RS_STORE();
    __syncthreads();
    for (int t = 0; t < RET_NCH; ++t) {
        const int c = RS_C(t);
        if (t + 1 < RET_NCH) RS_LOAD(t + 1);
        bf16x8 bV[2][4];
#pragma unroll
        for (int nt = 0; nt < 2; ++nt) { f32x4 a1 = {0.f, 0.f, 0.f, 0.f}, a2 = {0.f, 0.f, 0.f, 0.f};
#pragma unroll
            for (int ks = 0; ks < 4; ++ks) { bV[nt][ks] = ldsfrag(L + RS_VT + (16 * nt + rr) * 272 + (32 * ks + 8 * kg) * 2);
                a1 = mfma16(ldsfrag(L + RS_QS + (16 * wave + rr) * 272 + (32 * ks + 8 * kg) * 2), ldsfrag(L + RS_SB + (16 * nt + rr) * 272 + (32 * ks + 8 * kg) * 2), a1);
                a2 = mfma16(ldsfrag(L + RS_QKD + (16 * wave + rr) * 272 + (32 * ks + 8 * kg) * 2), bV[nt][ks], a2); }
#pragma unroll
            for (int r = 0; r < 4; ++r) { const int i = 16 * wave + 4 * kg + r, tok = dir ? 127 - i : i;
                ORET[((size_t)dir * MROWS + (size_t)(b * TOK + 128 * c + tok)) * 512 + h * 128 + sl * 32 + 16 * nt + rr] = a1[r] * __expf((float)(i + 1) * lg) + a2[r]; } }
#pragma unroll
        for (int et = 0; et < 2; ++et) { s[et] = s[et] * gC;
#pragma unroll
            for (int ks = 0; ks < 4; ++ks) s[et] = mfma16(ldsfrag(L + RS_KDT + (16 * wave + rr) * 272 + (32 * ks + 8 * kg) * 2), bV[et][ks], s[et]); }
        __syncthreads();
#pragma unroll
        for (int et = 0; et < 2; ++et) { u32x2 w; w.x = pk2(s[et][0], s[et][1]); w.y = pk2(s[et][2], s[et][3]); *(LAS u32x2*)(L + RS_SB + (16 * et + rr) * 272 + (16 * wave + 4 * kg) * 2) = w; }
        if (t + 1 < RET_NCH) { VM_WAIT(); RS_STORE(); }
        __syncthreads();
    }
#undef RS_C
#undef RS_LOAD
#undef RS_STORE
}

__device__ __forceinline__ void attention_phase(Frame& F, int l, bool keep_ctx) {
    const bf16_t* P = (const bf16_t*)(F.ws + WS_P); bf16_t* Y = (bf16_t*)(F.ws + WS_Y);
    unsigned* qhead = F.ctl + CW_ATTQ + 64 * l; volatile LAS unsigned* slot = F.MISC + 4;
    const unsigned nunits = 512u + (keep_ctx ? 16u : 0u);
    for (;;) {
        __syncthreads();
        if (F.tid == 0) *slot = __hip_atomic_fetch_add(qhead, 1u, __ATOMIC_RELAXED, __HIP_MEMORY_SCOPE_AGENT);
        __syncthreads();
        const unsigned idx = *slot;
        if (idx >= nunits) break;
        int hq, kvh, b, qrow0, seq;
        if (idx < 512u) { const int qb = idx & 31, g = (idx >> 5) & 3; kvh = (idx >> 7) & 1; b = idx >> 8; hq = kvh * 4 + g; qrow0 = b * TOK + CTXL + 256 * qb; seq = TOK; }
        else { const int j = idx - 512; hq = j & 7; b = j >> 3; kvh = hq >> 2; qrow0 = b * TOK; seq = CTXL; }
        const size_t krow0 = (size_t)b * TOK;
        att::attn_dense_body<att::bf16>((const att::bf16*)(P + (size_t)qrow0 * PW + C_AQ + hq * 128), (const att::bf16*)(P + krow0 * PW + C_AK + kvh * 128), (const att::bf16*)(P + krow0 * PW + C_AV + kvh * 128),
                                        Y + (size_t)qrow0 * YW + 1024 + hq * 128, seq, (char*)F.ldsg);
    }
}

__device__ __forceinline__ void mixepi_phase(Frame& F, int l, bool keep_ctx) {
    const bf16_t* P = (const bf16_t*)(F.ws + WS_P); bf16_t* Y = (bf16_t*)(F.ws + WS_Y); const float* ORET = (const float*)(F.ws + WS_ORET); const float* ODN = (const float*)(F.ws + WS_ODN);
    const int lane = F.lane, gw = F.vcu * NWAVES + F.wave, NGW = F.G * NWAVES, c0 = 8 * lane;
    const f32x4 nw0 = *(const f32x4*)(inp(F, I_dn_norm_w) + l * 128 + (c0 & 127)), nw1 = *(const f32x4*)(inp(F, I_dn_norm_w) + l * 128 + (c0 & 127) + 4);
    for (int r = gw; r < MROWS; r += NGW) {
        const int tp = r % TOK; if (!keep_ctx && tp < CTXL) continue;
#pragma unroll
        for (int grp = 0; grp < 2; ++grp) {
            const float* O = grp ? ODN : ORET;
            const f32x4 a0 = *(const f32x4*)(O + (size_t)r * 512 + c0), a1 = *(const f32x4*)(O + (size_t)r * 512 + c0 + 4), b0 = *(const f32x4*)(O + ((size_t)MROWS + r) * 512 + c0), b1 = *(const f32x4*)(O + ((size_t)MROWS + r) * 512 + c0 + 4);
            f32x4 o0 = a0 + b0, o1 = a1 + b1;
            float ss = (o0[0] * o0[0] + o0[1] * o0[1]) + (o0[2] * o0[2] + o0[3] * o0[3]) + (o1[0] * o1[0] + o1[1] * o1[1]) + (o1[2] * o1[2] + o1[3] * o1[3]);
            const float ri = rsqrtf(sum16(ss) * (1.f / 128.f) + EPS);
            o0 = o0 * ri; o1 = o1 * ri; if (grp) { o0 = o0 * nw0; o1 = o1 * nw1; }
            const u32x4 gz = *(const u32x4*)(P + (size_t)r * PW + (grp ? C_DZ : C_RG) + c0);
            u32x4 w; w.x = pk2(o0[0] * silu_f(bflo(gz.x)), o0[1] * silu_f(bfhi(gz.x))); w.y = pk2(o0[2] * silu_f(bflo(gz.y)), o0[3] * silu_f(bfhi(gz.y)));
            w.z = pk2(o1[0] * silu_f(bflo(gz.z)), o1[1] * silu_f(bfhi(gz.z))); w.w = pk2(o1[2] * silu_f(bflo(gz.w)), o1[3] * silu_f(bfhi(gz.w)));
            *(u32x4*)(Y + (size_t)r * YW + grp * 512 + c0) = w;
        }
    }
}
constexpr int NSTEPS = 2 + 10 * DEPTH;
#ifndef PH_MASK
#define PH_MASK 0xFFFFF
#endif
#define PH(k) (((PH_MASK) >> (k)) & 1)
struct Args { const float* in[21]; float* out; unsigned char* ws; int s_lo, s_hi; };
__global__ void __launch_bounds__(NWAVES * 64, 2) fwd(Args a) {
    extern __shared__ __attribute__((aligned(16))) unsigned char lds_raw[];
    Frame F;
    F.lds = (LAS unsigned char*)lds_raw; F.ldsg = lds_raw;
    F.MISC = (volatile LAS unsigned*)(F.lds + MISC_OFF);
    F.tid = threadIdx.x; F.lane = F.tid & 63; F.wave = __builtin_amdgcn_readfirstlane(F.tid >> 6);
    F.G = gridDim.x; { const int bx = blockIdx.x; F.vcu = (F.G % 8 == 0) ? (bx % 8) * (F.G / 8) + bx / 8 : bx; }
    F.ws = a.ws; F.ctl = (unsigned*)(a.ws + WS_CTL);
    for (int u = F.tid; u < (LDS_BYTES - RING_BYTES) / 4; u += NWAVES * 64) ((LAS unsigned*)(F.lds + RING_BYTES))[u] = 0u;
    __syncthreads();
    if (F.tid == 0) {
#define PUTP(k, p) do { const unsigned long long v_ = (unsigned long long)(p); F.MISC[16 + 2 * (k)] = (unsigned)v_; F.MISC[17 + 2 * (k)] = (unsigned)(v_ >> 32); } while (0)
        PUTP(0, a.in[0]); PUTP(1, a.in[1]); PUTP(2, a.in[2]); PUTP(3, a.in[3]); PUTP(4, a.in[4]); PUTP(5, a.in[5]); PUTP(6, a.in[6]); PUTP(7, a.in[7]); PUTP(8, a.in[8]); PUTP(9, a.in[9]); PUTP(10, a.in[10]);
        PUTP(11, a.in[11]); PUTP(12, a.in[12]); PUTP(13, a.in[13]); PUTP(14, a.in[14]); PUTP(15, a.in[15]); PUTP(16, a.in[16]); PUTP(17, a.in[17]); PUTP(18, a.in[18]); PUTP(19, a.in[19]); PUTP(20, a.in[20]); PUTP(21, a.out);
#undef PUTP
    }
    __syncthreads();
    XcdBarrier bar; bar.bar = F.ctl + CW_BAR; bar.x = 0; bar.st = nullptr;
    if (MK_ONE_LAUNCH) bar = xcd_barrier_post(F.ctl + CW_BAR, F.MISC + 8);
    const int lo = a.s_lo, hi = a.s_hi;
#define IN(k) (lo <= (k) && (k) < hi)
#define ENTER() do { F.tid = opaque_tid(); F.lane = F.tid & 63; F.wave = __builtin_amdgcn_readfirstlane(F.tid >> 6); F.ws = opaque_ptr(a.ws); F.ctl = (unsigned*)F.ws; } while (0)
#define SEAM(k) do { if (MK_ONE_LAUNCH && IN(k) && IN((k) + 1)) xcd_barrier(bar); } while (0)
#define Hb ((bf16_t*)(F.ws + WS_H))
#define Pb ((bf16_t*)(F.ws + WS_P))
#define Yb ((bf16_t*)(F.ws + WS_Y))
#define Xf ((float*)(F.ws + WS_X))
#define ABf ((float*)(F.ws + WS_AB))
#define MOD ((const float*)(F.ws + WS_MOD))

    if (PH(0) && IN(0)) { ENTER(); prologue_phase(F); }
    SEAM(0);
    if (PH(1) && IN(1)) { ENTER(); ln_mod_phase<0>(F, 0, false); }
    SEAM(1);
    for (int l = 0; l < DEPTH; ++l) {
        const int sb = 2 + 10 * l; if (sb + 10 <= lo || sb >= hi) continue;
        const bool keep_ctx = l < DEPTH - 1; const int skip = keep_ctx ? 0 : 1;
        if (PH(2) && IN(sb + 0)) { ENTER();
            pg8::Gemm g{Hb, (const bf16_t*)(F.ws + WS_WIN) + (size_t)l * PWPAD * DM, MROWS, PWPAD, DM}; pg8::RowOrder S; S.init(PWPAD / 256, F.G, (int)blockIdx.x, 0);
            pg8::EpiProj E{Pb, ABf};
            pg8::gemm_phase<pg8::EpiProj, pg8::RowOrder, true, true>(F.lds, g, S, E);
        }
        SEAM(sb + 0);
        if (PH(3) && IN(sb + 1)) { ENTER(); rowprep_phase(F, l); }
        SEAM(sb + 1);
        if (IN(sb + 2)) {
            if (PH(4)) { ENTER(); for (int u = F.vcu; u < NBATCH * DN_NCH * 4; u += F.G) dnprep_unit(F, u); }
            if (PH(13)) { ENTER(); for (int u = F.G - 1 - F.vcu; u < NBATCH * RET_NCH * 4; u += F.G) retprep_unit(F, l, u); }
        }
        SEAM(sb + 2);
        if (IN(sb + 3)) {
            if (PH(5)) { ENTER(); for (int u = (int)blockIdx.x; u < 64; u += F.G) dnscan_unit(F, u); }
            if (PH(14)) { ENTER(); for (int u = (int)blockIdx.x - 64; u < 64; u += F.G) { if (u >= 0) retscan_unit(F, l, u); } }
            if (PH(6)) { ENTER(); attention_phase(F, l, keep_ctx); }
        }
        SEAM(sb + 3);
        if (PH(7) && IN(sb + 4)) { ENTER(); mixepi_phase(F, l, keep_ctx); }
        SEAM(sb + 4);
        if (PH(8) && IN(sb + 5)) { ENTER();
            pg8::Gemm g{Yb, (const bf16_t*)(F.ws + WS_WO) + (size_t)l * DM * DM, MROWS, DM, DM}; pg8::RowOrder S; S.init(DM / 256, F.G, (int)blockIdx.x, skip);
            pg8::EpiResid E{Xf, MOD + (size_t)(l * 3) * 12288 + 2 * DM, ALPHA};
            pg8::gemm_phase<pg8::EpiResid, pg8::RowOrder, true, true>(F.lds, g, S, E);
        }
        SEAM(sb + 5);
        if (PH(9) && IN(sb + 6)) { ENTER(); ln_mod_phase<1>(F, l, !keep_ctx); }
        SEAM(sb + 6);
        if (PH(10) && IN(sb + 7)) { ENTER();
            pg8::Gemm g{Hb, (const bf16_t*)(F.ws + WS_WFI) + (size_t)l * 2 * DFF * DM, MROWS, 2 * DFF, DM}; pg8::RowOrder S; S.init(2 * DFF / 256, F.G, (int)blockIdx.x, skip);
            pg8::EpiSwiglu E{Pb};
            pg8::gemm_phase<pg8::EpiSwiglu, pg8::RowOrder, true, true>(F.lds, g, S, E);
        }
        SEAM(sb + 7);
        if (PH(11) && IN(sb + 8)) { ENTER();
            pg8::Gemm g{Pb, (const bf16_t*)(F.ws + WS_WFO) + (size_t)l * DM * DFF, MROWS, DM, DFF}; pg8::RowOrder S; S.init(DM / 256, F.G, (int)blockIdx.x, skip);
            pg8::EpiResid E{Xf, MOD + (size_t)(l * 3) * 12288 + 5 * DM, ALPHA};
            pg8::gemm_phase<pg8::EpiResid, pg8::RowOrder, true, true>(F.lds, g, S, E);
        }
        SEAM(sb + 8);
        if (PH(12) && IN(sb + 9)) { ENTER(); if (keep_ctx) ln_mod_phase<2>(F, l, false); else ln_mod_phase<3>(F, l, true); }
        SEAM(sb + 9);
    }
#undef IN
#undef SEAM
#undef ENTER
#undef Hb
#undef Pb
#undef Yb
#undef Xf
#undef ABf
#undef MOD
}

extern "C" void kernel_launch(void* const* d_in, const int* in_sizes, int n_in, void* d_out, int out_size, void* d_ws, size_t ws_size, hipStream_t stream) {
    static int grid = 0;
    if (grid == 0) {
        if (n_in != 21 || in_sizes[0] != NBATCH * SEQ * DM || out_size != NBATCH * SEQ * DM || ws_size < WS_END) {
            fprintf(stderr, "kernel_launch: shape mismatch: n_in %d in0 %d out %d ws %zu (need >= %zu)\n", n_in, n_in > 0 ? in_sizes[0] : -1, out_size, ws_size, (size_t)WS_END); grid = -1; return; }
        int dev = 0, cus = 0, per_cu = 0;
        if (hipGetDevice(&dev) != hipSuccess || hipDeviceGetAttribute(&cus, hipDeviceAttributeMultiprocessorCount, dev) != hipSuccess) { fprintf(stderr, "kernel_launch: device query failed\n"); grid = -1; return; }
        if (hipFuncSetAttribute((const void*)fwd, hipFuncAttributeMaxDynamicSharedMemorySize, LDS_BYTES) != hipSuccess) { fprintf(stderr, "kernel_launch: hipFuncSetAttribute failed\n"); grid = -1; return; }
        if (hipOccupancyMaxActiveBlocksPerMultiprocessor(&per_cu, (const void*)fwd, NWAVES * 64, LDS_BYTES) != hipSuccess || per_cu < 1)
            fprintf(stderr, "kernel_launch: note: occupancy query reports %d workgroups per CU\n", per_cu);
        (void)hipGetLastError();
        grid = cus;
    }
    if (grid < 0) return;
    if (hipMemsetAsync((char*)d_ws + WS_CTL, 0, CTL_ZERO_BYTES, stream) != hipSuccess) { fprintf(stderr, "kernel_launch: memset failed\n"); return; }
    Args a{};
    for (int i = 0; i < 21; ++i) a.in[i] = (const float*)d_in[i];
    a.out = (float*)d_out; a.ws = (unsigned char*)d_ws;
#if MK_ONE_LAUNCH
    a.s_lo = 0; a.s_hi = NSTEPS;
    hipLaunchKernelGGL(fwd, dim3(grid), dim3(NWAVES * 64), LDS_BYTES, stream, a);
#else
    for (int s = 0; s < NSTEPS; ++s) { a.s_lo = s; a.s_hi = s + 1; hipLaunchKernelGGL(fwd, dim3(grid), dim3(NWAVES * 64), LDS_BYTES, stream, a); }
#endif
    const hipError_t le = hipPeekAtLastError();
    if (le != hipSuccess) fprintf(stderr, "kernel_launch: launch failed: %s\n", hipGetErrorName(le));
}
```

```cpp
#include <hip/hip_runtime.h>
#include <hip/hip_bf16.h>
#include <cstdio>
#include <cstdint>

#ifndef MK_ONE_LAUNCH
#define MK_ONE_LAUNCH 1
#endif

constexpr int DM = 2048, NBATCH = 2, SEQ = 8192, CTXL = 256, TOK = CTXL + SEQ  , MROWS = NBATCH * TOK  , DEPTH = 4;
constexpr int HD = 128, DFF = 5632, PW = 5632  , PWPAD = 5888, PROJ_SRC = 5648;
constexpr int C_RQ = 0, C_RK = 512, C_RV = 1024, C_RG = 1536, C_DQKV = 2048, C_DZ = 3584, C_AQ = 4096, C_AK = 5120, C_AV = 5376;
constexpr int YW = 2048;
constexpr float ALPHA = 1.6817928305074292f;
constexpr float EPS = 1e-6f;
constexpr int DN_NCH = TOK / 64  , RET_NCH = TOK / 128  ;
constexpr int DN_PU = NBATCH * DN_NCH * 4 * 2  , RET_PU = NBATCH * RET_NCH * 4 * 2  ;

constexpr size_t MiB = 1u << 20;
constexpr size_t WS_CTL = 0, CTL_ZERO_BYTES = 1 * MiB;
constexpr size_t WS_MOD = 1 * MiB;
constexpr size_t WS_WIN = 2 * MiB;
constexpr size_t WS_WO = 94 * MiB;
constexpr size_t WS_WFI = 126 * MiB;
constexpr size_t WS_WFO = 302 * MiB;
constexpr size_t WS_X = 390 * MiB;
constexpr size_t WS_H = 522 * MiB;
constexpr size_t WS_P = 588 * MiB;
constexpr size_t WS_AB = 770 * MiB;
constexpr size_t WS_Y = 772 * MiB;
constexpr size_t WS_DQ = 838 * MiB;
constexpr size_t WS_DNW = 888 * MiB, WS_DNKC = 921 * MiB, WS_DNQG = 954 * MiB, WS_DNKGT = 987 * MiB;
constexpr size_t WS_DNQK = 1020 * MiB;
constexpr size_t WS_DNGL = 1037 * MiB;
constexpr size_t WS_ODN = 1038 * MiB;
constexpr size_t WS_ORET = 1104 * MiB;
constexpr size_t WS_RQKD = 1170 * MiB, WS_RKDT = 1203 * MiB;
constexpr size_t WS_END = 1236 * MiB;
static_assert(WS_WIN + (size_t)DEPTH * PWPAD * DM * 2 <= WS_WO && WS_WO + (size_t)DEPTH * DM * DM * 2 <= WS_WFI && WS_WFI + (size_t)DEPTH * 2 * DFF * DM * 2 <= WS_WFO && WS_WFO + (size_t)DEPTH * DM * DFF * 2 <= WS_X, "ws map (weights)");
static_assert(WS_X + (size_t)MROWS * DM * 4 <= WS_H && WS_H + (size_t)MROWS * DM * 2 <= WS_P && WS_P + (size_t)MROWS * PW * 2 <= WS_AB && WS_AB + (size_t)MROWS * 64 <= WS_Y && WS_Y + (size_t)MROWS * YW * 2 <= WS_DQ && WS_DQ + (size_t)MROWS * 1536 * 2 <= WS_DNW, "ws map (activations)");
static_assert(WS_DNW + (size_t)DN_PU * 16384 <= WS_DNKC && WS_DNQK + (size_t)DN_PU * 8192 <= WS_DNGL && WS_ODN + (size_t)2 * MROWS * 512 * 4 <= WS_ORET && WS_ORET + (size_t)2 * MROWS * 512 * 4 <= WS_RQKD && WS_RQKD + (size_t)RET_PU * 32768 <= WS_RKDT && WS_RKDT + (size_t)RET_PU * 32768 <= WS_END, "ws map (mixers)");
constexpr int CW_BAR = 4096;
constexpr int CW_ATTQ = 16384;

constexpr int RING_BYTES = 131072;
constexpr int MISC_OFF = RING_BYTES + 320;
constexpr int LDS_BYTES = 147456;
constexpr int NWAVES = 8;

#define GAS __attribute__((address_space(1)))
#define LAS __attribute__((address_space(3)))
typedef unsigned short bf16_t;
typedef short bf16x8 __attribute__((ext_vector_type(8)));
typedef short s16x4 __attribute__((ext_vector_type(4)));
typedef float f32x4 __attribute__((ext_vector_type(4)));
typedef float f32x2 __attribute__((ext_vector_type(2)));
typedef unsigned u32x4 __attribute__((ext_vector_type(4)));
typedef unsigned u32x2 __attribute__((ext_vector_type(2)));
#define LDS_WAIT() asm volatile("s_waitcnt lgkmcnt(0)" ::: "memory")
#define VM_WAIT() asm volatile("s_waitcnt vmcnt(0)" ::: "memory")
__device__ __forceinline__ unsigned f2bf(float f) { unsigned u = __builtin_bit_cast(unsigned, f); return (u + 0x7fffu + ((u >> 16) & 1u)) >> 16; }
__device__ __forceinline__ unsigned pk2(float lo, float hi) { return f2bf(lo) | (f2bf(hi) << 16); }
__device__ __forceinline__ float bf2f(unsigned short b) { return __builtin_bit_cast(float, ((unsigned)b) << 16); }
__device__ __forceinline__ float bflo(unsigned w) { return __builtin_bit_cast(float, w << 16); }
__device__ __forceinline__ float bfhi(unsigned w) { return __builtin_bit_cast(float, w & 0xffff0000u); }
__device__ __forceinline__ int opaque_tid() { int t = (int)threadIdx.x; asm volatile("" : "+v"(t)); return t; }
__device__ __forceinline__ unsigned char* opaque_ptr(unsigned char* p) { asm volatile("" : "+s"(p)); return p; }
__device__ __forceinline__ float wave_sum(float v) {
#pragma unroll
    for (int o = 1; o < 64; o <<= 1) v += __shfl_xor(v, o);
    return v;
}
__device__ __forceinline__ float sum16(float v) { v += __shfl_xor(v, 1); v += __shfl_xor(v, 2); v += __shfl_xor(v, 4); v += __shfl_xor(v, 8); return v; }
__device__ __forceinline__ float silu_f(float x) { return x / (1.f + __expf(-x)); }
__device__ __forceinline__ f32x4 mfma16(bf16x8 a, bf16x8 b, f32x4 c) { return __builtin_amdgcn_mfma_f32_16x16x32_bf16(a, b, c, 0, 0, 0); }
__device__ __forceinline__ bf16x8 ldsfrag(const LAS unsigned char* p) { return *(const LAS bf16x8*)p; }

#define XB_TMO      128
#define XB_XCNT(j)  (256  + 64 * (j))
#define XB_XSUB(j)  (1280 + 64 * (j))
#define XB_XGEN(j)  (2304 + 64 * (j))
#define XB_TOP      3328
#define XB_TOPGEN   3392
#define XCD_BAR_WORDS 3456
#define XB_SPIN_CAP (1u << 18)
__device__ __forceinline__ unsigned xb_ld(unsigned* p)              { return __hip_atomic_load(p, __ATOMIC_RELAXED, __HIP_MEMORY_SCOPE_AGENT); }
__device__ __forceinline__ unsigned xb_add(unsigned* p, unsigned v) { return __hip_atomic_fetch_add(p, v, __ATOMIC_RELAXED, __HIP_MEMORY_SCOPE_AGENT); }
__device__ __forceinline__ unsigned xb_xcc_id() { return (unsigned)__builtin_amdgcn_s_getreg((3 << 11) | 20) & 0xFu; }
#define XB_SPIN(cond, bar) do { unsigned _sp = 0; while (cond) { __builtin_amdgcn_s_sleep(1); \
    if ((++_sp & 255u) == 0u) { if (xb_ld(&(bar)[XB_TMO])) break; if (_sp > XB_SPIN_CAP) { atomicAdd(&(bar)[XB_TMO], 1u); break; } } } } while (0)
struct XcdBarrier { unsigned* bar; unsigned x; volatile LAS unsigned* st; };
__device__ __forceinline__ XcdBarrier xcd_barrier_post(unsigned* bar, volatile LAS unsigned* st) {
    XcdBarrier b; b.bar = bar; b.x = xb_xcc_id(); b.st = st;
    if (threadIdx.x == 0) (void)xb_add(&bar[XB_XCNT(b.x)], 1u);
    return b;
}
__device__ __forceinline__ void xcd_barrier_complete(unsigned* bar, unsigned x, unsigned& nloc, unsigned& nx) {
    const unsigned G = gridDim.x * gridDim.y * gridDim.z;
    unsigned sum, cnt, mine, sp = 0u;
    for (;;) {
        sum = 0u; cnt = 0u; mine = 0u;
#pragma unroll
        for (unsigned j = 0; j < 16; ++j) { const unsigned c = xb_ld(&bar[XB_XCNT(j)]); sum += c; cnt += (c > 0u) ? 1u : 0u; mine = (j == x) ? c : mine; }
        if (sum == G) break;
        __builtin_amdgcn_s_sleep(1);
        if ((++sp & 255u) == 0u) { if (xb_ld(&bar[XB_TMO])) break; if (sp > XB_SPIN_CAP) { atomicAdd(&bar[XB_TMO], 1u); break; } }
    }
    nloc = mine > 0u ? mine : 1u; nx = cnt > 0u ? cnt : 1u;
}
__device__ __forceinline__ void xcd_barrier(const XcdBarrier& b) {
    asm volatile("s_waitcnt vmcnt(0)" ::: "memory");
    __syncthreads();
    if (threadIdx.x == 0) {
        unsigned* bar = b.bar;
        __builtin_amdgcn_s_waitcnt(0);
        unsigned nloc = b.st[0], nx = b.st[1];
        if (nloc == 0u) { xcd_barrier_complete(bar, b.x, nloc, nx); b.st[0] = nloc; b.st[1] = nx; }
        const unsigned old = xb_add(&bar[XB_XSUB(b.x)], 1u);
        const unsigned gen = old / nloc;
        if (old + 1u == (gen + 1u) * nloc) {
            __builtin_amdgcn_fence(__ATOMIC_RELEASE, "agent");
            asm volatile("s_waitcnt vmcnt(0)" ::: "memory");
            const unsigned og = xb_add(&bar[XB_TOP], 1u);
            const unsigned tg = og / nx;
            if (og + 1u == (tg + 1u) * nx) xb_add(&bar[XB_TOPGEN], 1u);
            else XB_SPIN(xb_ld(&bar[XB_TOPGEN]) == tg, bar);
            __builtin_amdgcn_fence(__ATOMIC_ACQUIRE, "agent");
            xb_add(&bar[XB_XGEN(b.x)], 1u);
            asm volatile("s_waitcnt vmcnt(0)" ::: "memory");
        } else {
            XB_SPIN(xb_ld(&bar[XB_XGEN(b.x)]) == gen, bar);
            __builtin_amdgcn_fence(__ATOMIC_ACQUIRE, "agent");
            asm volatile("s_waitcnt vmcnt(0)" ::: "memory");
        }
    }
    __syncthreads();
}
namespace pg8 {
#define PG8_LAS __attribute__((address_space(3)))
typedef unsigned short bf16_t;
typedef short bf16x8 __attribute__((ext_vector_type(8)));
typedef float f32x4 __attribute__((ext_vector_type(4)));
typedef unsigned u32x4 __attribute__((ext_vector_type(4)));
constexpr int BM = 256, BK = 64, HALF = 128, HTB = HALF * BK * 2  , STAGE_BYTES = 8 * HTB, NXCD = 8, WGM = 8;

__host__ __device__ __forceinline__ int lds_byte(int r, int c) { const int st = (r >> 4) * 2 + (c >> 5), rr = r & 15, cc = c & 31, ob = rr * 64 + cc * 2; return st * 1024 + (ob ^ (((ob >> 9) & 1) << 5)); }
__host__ __device__ __forceinline__ void stage_rc(int b, int& R, int& C) { const int st = b / 1024, sb = b % 1024, swz = sb ^ (((sb >> 9) & 1) << 5); R = (st >> 1) * 16 + swz / 64; C = (st & 1) * 32 + (swz % 64) / 2; }
__host__ __device__ __forceinline__ int perm32(int rho) { const int n = rho >> 4, i = rho & 15; return 8 * (i >> 2) + 4 * n + (i & 3); }

struct Unit { int pm, pn; };
struct Gemm { const bf16_t* A; const bf16_t* Bt; int M, N, K; };

struct StaticOrder {
    int nM, nN, nwg, G, c;
    __host__ __device__ void init(int M, int N, int G_, int c_) { nM = M / BM; nN = N / BM; nwg = nM * nN; G = G_; c = c_; }
    __host__ __device__ bool next(int i, Unit& u) const {
        const long L = (long)i * G + c; if (L >= nwg) return false;
        int wgid = (int)L; { const int q = nwg / NXCD, r = nwg % NXCD, xcd = wgid % NXCD, off = wgid / NXCD; wgid = (xcd < r ? xcd * (q + 1) : r * (q + 1) + (xcd - r) * q) + off; }
        const int nig = WGM * nN, gid = wgid / nig, fm = gid * WGM, gsz = (nM - fm) < WGM ? (nM - fm) : WGM;
        u.pm = fm + ((wgid % nig) % gsz); u.pn = (wgid % nig) / gsz; return true;
    }
    __device__ __forceinline__ void a_ready(const Unit&) const {}
    __device__ __forceinline__ void done(const Unit&) const {}
};

__device__ __forceinline__ unsigned cvt_pk_bf16(float lo, float hi) { unsigned r; asm volatile("v_cvt_pk_bf16_f32 %0, %1, %2" : "=v"(r) : "v"(lo), "v"(hi)); return r; }
typedef float f32x2 __attribute__((ext_vector_type(2)));
struct RowOrder {
    int nM, nN, nwg, G, c, skip;
    __device__ __forceinline__ void init(int nN_, int G_, int c_, int skip_) { skip = skip_; nM = skip_ ? 64 : 66; nN = nN_; nwg = nM * nN; G = G_; c = c_; }
    __device__ __forceinline__ bool next(int i, Unit& u) const {
        const long L = (long)i * G + c; if (L >= nwg) return false;
        int wgid = (int)L; { const int q = nwg / NXCD, r = nwg % NXCD, xcd = wgid % NXCD, off = wgid / NXCD; wgid = (xcd < r ? xcd * (q + 1) : r * (q + 1) + (xcd - r) * q) + off; }
        const int nig = WGM * nN, gid = wgid / nig, fm = gid * WGM, gsz = (nM - fm) < WGM ? (nM - fm) : WGM;
        int pm = fm + ((wgid % nig) % gsz); u.pn = (wgid % nig) / gsz;
        if (skip) pm = pm + 1 + (pm >= 32 ? 1 : 0);
        u.pm = pm; return true;
    }
    __device__ __forceinline__ void a_ready(const Unit&) const {}
    __device__ __forceinline__ void done(const Unit&) const {}
};
struct EpiProj {
    static constexpr bool PERM = true, AFTER_DRAIN = false;
    bf16_t* P; float* AB;
    __device__ __forceinline__ void operator()(const f32x4 (&acc)[2][2][4][2], const Unit& u, int wr, int wc, int fr, int fq) const {
        const int row0 = u.pm * BM + wr * 64 + fr;
        if (u.pn < 22) {
            const int col0 = u.pn * BM + wc * 32 + 8 * fq;
#pragma unroll
            for (int ai = 0; ai < 2; ++ai)
#pragma unroll
                for (int m = 0; m < 4; ++m) { bf16_t* rowp = P + (size_t)(row0 + ai * HALF + m * 16) * 5632 + col0;
#pragma unroll
                    for (int bj = 0; bj < 2; ++bj) { const f32x4 v0 = acc[ai][bj][m][0], v1 = acc[ai][bj][m][1];
                        u32x4 w; w.x = cvt_pk_bf16(v0[0], v0[1]); w.y = cvt_pk_bf16(v0[2], v0[3]); w.z = cvt_pk_bf16(v1[0], v1[1]); w.w = cvt_pk_bf16(v1[2], v1[3]);
                        *(u32x4*)(rowp + bj * HALF) = w; } }
        } else if (wc == 0 && fq < 2) {
#pragma unroll
            for (int ai = 0; ai < 2; ++ai)
#pragma unroll
                for (int m = 0; m < 4; ++m) { float* rp = AB + (size_t)(row0 + ai * HALF + m * 16) * 16 + 8 * fq;
                    *(f32x4*)rp = acc[ai][0][m][0]; *(f32x4*)(rp + 4) = acc[ai][0][m][1]; }
        }
    }
};
struct EpiResid {
    static constexpr bool PERM = false, AFTER_DRAIN = false;
    float* X; const float* gate; float alpha;
    __device__ __forceinline__ void operator()(const f32x4 (&acc)[2][2][4][2], const Unit& u, int wr, int wc, int fr, int fq) const {
        const int s = (u.pm % 33 == 0) ? 2 : u.pm / 33; const float* g = gate + (size_t)s * 12288;
        const int row0 = u.pm * BM + wr * 64 + fr, col0 = u.pn * BM + wc * 32 + 4 * fq;
        f32x4 gv[2][2];
#pragma unroll
        for (int bj = 0; bj < 2; ++bj)
#pragma unroll
            for (int n = 0; n < 2; ++n) gv[bj][n] = *(const f32x4*)(g + col0 + bj * HALF + n * 16);
#pragma unroll
        for (int ai = 0; ai < 2; ++ai)
#pragma unroll
            for (int m = 0; m < 4; ++m) { float* rowp = X + (size_t)(row0 + ai * HALF + m * 16) * 2048 + col0;
#pragma unroll
                for (int bj = 0; bj < 2; ++bj)
#pragma unroll
                    for (int n = 0; n < 2; ++n) { f32x4 x = *(const f32x4*)(rowp + bj * HALF + n * 16); x = x * alpha + gv[bj][n] * acc[ai][bj][m][n]; *(f32x4*)(rowp + bj * HALF + n * 16) = x; } }
    }
};
__device__ __forceinline__ float silu_mul(float g, float u) { return g * u * __builtin_amdgcn_rcpf(1.f + __expf(-g)); }
struct EpiSwiglu {
    static constexpr bool PERM = true, AFTER_DRAIN = false;
    bf16_t* G;
    __device__ __forceinline__ void operator()(const f32x4 (&acc)[2][2][4][2], const Unit& u, int wr, int wc, int fr, int fq) const {
        const int row0 = u.pm * BM + wr * 64 + fr, col0 = u.pn * HALF + wc * 32 + 8 * fq;
#pragma unroll
        for (int ai = 0; ai < 2; ++ai)
#pragma unroll
            for (int m = 0; m < 4; ++m) { bf16_t* rowp = G + (size_t)(row0 + ai * HALF + m * 16) * 5632 + col0;
                const f32x4 g0 = acc[ai][0][m][0], g1 = acc[ai][0][m][1], u0 = acc[ai][1][m][0], u1 = acc[ai][1][m][1];
                u32x4 w; w.x = cvt_pk_bf16(silu_mul(g0[0], u0[0]), silu_mul(g0[1], u0[1])); w.y = cvt_pk_bf16(silu_mul(g0[2], u0[2]), silu_mul(g0[3], u0[3]));
                w.z = cvt_pk_bf16(silu_mul(g1[0], u1[0]), silu_mul(g1[1], u1[1])); w.w = cvt_pk_bf16(silu_mul(g1[2], u1[2]), silu_mul(g1[3], u1[3]));
                *(u32x4*)rowp = w; }
    }
};
template <class Epi, class Sched, bool ALIGN_EPI = false, bool SP2 = false>
__device__ __forceinline__ void gemm_phase(PG8_LAS unsigned char* lds, const Gemm g, const Sched& S, const Epi& E) {
    const int tid = opaque_tid(), wid = __builtin_amdgcn_readfirstlane(tid >> 6), lane = tid & 63, wr = wid >> 2, wc = wid & 3, fr = lane & 15, fq = lane >> 4;
    const int K = g.K, nt = K / BK;
    unsigned voffA[2], voffB[2];
#pragma unroll
    for (int i = 0; i < 2; ++i) { int R, C; stage_rc(tid * 16 + i * 8192, R, C); const int Rb = Epi::PERM ? ((R & ~31) + perm32(R & 31)) : R;
        voffA[i] = (unsigned)(R * K + C) * 2u; voffB[i] = (unsigned)(Rb * K + C) * 2u; }
    const size_t kstep = (size_t)(BK * 2);
    const size_t hstep = (size_t)HALF * K * 2;
    const size_t tstep = 2 * hstep;
    const unsigned ldsw = (unsigned)wid * 1024u;
    const int aoff = lds_byte(wr * 64 + fr, fq * 8), boff = lds_byte(wc * 32 + fr, fq * 8);
#define PG8_SA(b, h) (((b) * 2 + (h)) * HTB)
#define PG8_SB(b, h) ((4 + (b) * 2 + (h)) * HTB)
#define PG8_STAGE(bufoff, gbase, voff) do { _Pragma("unroll") for (int _i = 0; _i < 2; ++_i) \
        __builtin_amdgcn_global_load_lds((const unsigned*)((const char*)(gbase) + (voff)[_i]), (PG8_LAS unsigned*)(lds + (bufoff) + ldsw + _i * 8192), 16, 0, 0); } while (0)
#define PG8_LDA(dst, b, h) do { _Pragma("unroll") for (int m = 0; m < 4; ++m) _Pragma("unroll") for (int k = 0; k < 2; ++k) dst[m][k] = *(const PG8_LAS bf16x8*)(lds + PG8_SA(b, h) + aoff + m * 2048 + k * 1024); } while (0)
#define PG8_LDB(dst, b, h) do { _Pragma("unroll") for (int n = 0; n < 2; ++n) _Pragma("unroll") for (int k = 0; k < 2; ++k) dst[n][k] = *(const PG8_LAS bf16x8*)(lds + PG8_SB(b, h) + boff + n * 2048 + k * 1024); } while (0)
#define PG8_MMA(ai, bj, At, Bt) do { __builtin_amdgcn_s_setprio(1); _Pragma("unroll") for (int m = 0; m < 4; ++m) _Pragma("unroll") for (int n = 0; n < 2; ++n) _Pragma("unroll") for (int k = 0; k < 2; ++k) \
        acc[ai][bj][m][n] = __builtin_amdgcn_mfma_f32_16x16x32_bf16(Bt[n][k], At[m][k], acc[ai][bj][m][n], 0, 0, 0); __builtin_amdgcn_s_setprio(0); } while (0)
#define PG8_WAIT_V(n) asm volatile("s_waitcnt vmcnt(" #n ")" ::: "memory")
#define PG8_WAIT_L(n) asm volatile("s_waitcnt lgkmcnt(" #n ")" ::: "memory")
#define PG8_BAR __builtin_amdgcn_s_barrier()
#define PG8_SCHED __builtin_amdgcn_sched_barrier(0)
    Unit cur, nxt; int ui = 0;
    if (!S.next(0, cur)) return;
    f32x4 acc[2][2][4][2];
#pragma unroll
    for (int a = 0; a < 2; ++a)
#pragma unroll
        for (int b = 0; b < 2; ++b)
#pragma unroll
            for (int m = 0; m < 4; ++m)
#pragma unroll
                for (int n = 0; n < 2; ++n) acc[a][b][m][n] = (f32x4){0.f, 0.f, 0.f, 0.f};
    bf16x8 At[4][2], B0[2][2], B1[2][2];
    const char* cA = (const char*)g.A + (size_t)cur.pm * tstep; const char* cB = (const char*)g.Bt + (size_t)cur.pn * tstep;
    S.a_ready(cur);
    if constexpr (SP2) {
        PG8_STAGE(PG8_SB(0, 0), cB, voffB); PG8_STAGE(PG8_SB(0, 1), cB + hstep, voffB); PG8_STAGE(PG8_SA(0, 0), cA, voffA); PG8_STAGE(PG8_SA(0, 1), cA + hstep, voffA);
        if (wr == 1) PG8_BAR;
        PG8_WAIT_V(2); PG8_BAR;
        PG8_STAGE(PG8_SB(1, 0), cB + kstep, voffB); PG8_STAGE(PG8_SA(1, 0), cA + kstep, voffA); PG8_STAGE(PG8_SB(1, 1), cB + hstep + kstep, voffB);
        PG8_WAIT_V(6); PG8_BAR;
    } else {
        PG8_STAGE(PG8_SB(0, 0), cB, voffB); PG8_STAGE(PG8_SA(0, 0), cA, voffA); PG8_STAGE(PG8_SB(0, 1), cB + hstep, voffB); PG8_STAGE(PG8_SA(0, 1), cA + hstep, voffA);
        if (wr == 1) PG8_BAR;
        PG8_WAIT_V(4); PG8_BAR;
        PG8_STAGE(PG8_SB(1, 0), cB + kstep, voffB); PG8_STAGE(PG8_SA(1, 0), cA + kstep, voffA); PG8_STAGE(PG8_SB(1, 1), cB + hstep + kstep, voffB);
        PG8_WAIT_V(6); PG8_BAR;
    }
    for (;;) {
        const bool has_next = S.next(ui + 1, nxt);
        const char* nA = has_next ? (const char*)g.A + (size_t)nxt.pm * tstep : cA; const char* nB = has_next ? (const char*)g.Bt + (size_t)nxt.pn * tstep : cB;
        for (int t = 0; t < nt; t += 2) {
            const bool last = (t == nt - 2);
            const char* a1 = cA + (size_t)(t + 1) * kstep;
            const char* a2 = last ? nA : cA + (size_t)(t + 2) * kstep; const char* b2 = last ? nB : cB + (size_t)(t + 2) * kstep;
            const char* a3 = a2 + kstep; const char* b3 = b2 + kstep;
            if (last && has_next) S.a_ready(nxt);
            if constexpr (SP2) {
            PG8_LDB(B0, 0, 0); PG8_LDB(B1, 0, 1); PG8_SCHED; PG8_LDA(At, 0, 0); PG8_STAGE(PG8_SA(1, 1), a1 + hstep, voffA);
            PG8_WAIT_V(8); PG8_WAIT_L(0); PG8_BAR; PG8_MMA(0, 0, At, B0); PG8_MMA(0, 1, At, B1); PG8_BAR; PG8_SCHED;
            PG8_LDA(At, 0, 1); PG8_STAGE(PG8_SB(0, 0), b2, voffB); PG8_STAGE(PG8_SB(0, 1), b2 + hstep, voffB); PG8_STAGE(PG8_SA(0, 0), a2, voffA);
            PG8_WAIT_V(8); PG8_WAIT_L(0); PG8_BAR; PG8_MMA(1, 0, At, B0); PG8_MMA(1, 1, At, B1); PG8_BAR; PG8_SCHED;
            PG8_LDB(B0, 1, 0); PG8_LDB(B1, 1, 1); PG8_SCHED; PG8_LDA(At, 1, 0); PG8_STAGE(PG8_SA(0, 1), a2 + hstep, voffA);
            PG8_WAIT_V(8); PG8_WAIT_L(0); PG8_BAR; PG8_MMA(0, 0, At, B0); PG8_MMA(0, 1, At, B1); PG8_BAR; PG8_SCHED;
            PG8_LDA(At, 1, 1); PG8_STAGE(PG8_SB(1, 0), b3, voffB); PG8_STAGE(PG8_SB(1, 1), b3 + hstep, voffB); PG8_STAGE(PG8_SA(1, 0), a3, voffA);
            PG8_WAIT_V(8); PG8_WAIT_L(0); PG8_BAR; PG8_MMA(1, 0, At, B0); PG8_MMA(1, 1, At, B1); PG8_BAR; PG8_SCHED;
            } else {
            PG8_LDB(B0, 0, 0); PG8_SCHED; PG8_LDA(At, 0, 0); PG8_STAGE(PG8_SA(1, 1), a1 + hstep, voffA);
            PG8_WAIT_L(8); PG8_BAR; PG8_WAIT_L(0); PG8_MMA(0, 0, At, B0); PG8_BAR; PG8_SCHED;
            PG8_LDB(B1, 0, 1); PG8_STAGE(PG8_SB(0, 0), b2, voffB);
            PG8_BAR; PG8_WAIT_L(0); PG8_MMA(0, 1, At, B1); PG8_BAR;
            PG8_LDA(At, 0, 1); PG8_STAGE(PG8_SA(0, 0), a2, voffA);
            PG8_BAR; PG8_WAIT_L(0); PG8_MMA(1, 0, At, B0); PG8_BAR; PG8_SCHED;
            PG8_STAGE(PG8_SB(0, 1), b2 + hstep, voffB);
            PG8_WAIT_V(6); PG8_BAR; PG8_MMA(1, 1, At, B1); PG8_BAR;
            PG8_LDB(B0, 1, 0); PG8_SCHED; PG8_LDA(At, 1, 0); PG8_STAGE(PG8_SA(0, 1), a2 + hstep, voffA);
            PG8_WAIT_L(8); PG8_BAR; PG8_WAIT_L(0); PG8_MMA(0, 0, At, B0); PG8_BAR; PG8_SCHED;
            PG8_LDB(B1, 1, 1); PG8_STAGE(PG8_SB(1, 0), b3, voffB);
            PG8_BAR; PG8_WAIT_L(0); PG8_MMA(0, 1, At, B1); PG8_BAR;
            PG8_LDA(At, 1, 1); PG8_STAGE(PG8_SA(1, 0), a3, voffA);
            PG8_BAR; PG8_WAIT_L(0); PG8_MMA(1, 0, At, B0); PG8_BAR; PG8_SCHED;
            PG8_STAGE(PG8_SB(1, 1), b3 + hstep, voffB);
            PG8_WAIT_V(6); PG8_BAR; PG8_MMA(1, 1, At, B1); PG8_BAR;
            }
        }
        if constexpr (ALIGN_EPI) { if (wr == 0) PG8_BAR; }
        if constexpr (!Epi::AFTER_DRAIN) { E(acc, cur, wr, wc, fr, fq); S.done(cur); }
        if (!has_next) break;
#pragma unroll
        for (int a = 0; a < 2; ++a)
#pragma unroll
            for (int b = 0; b < 2; ++b)
#pragma unroll
                for (int m = 0; m < 4; ++m)
#pragma unroll
                    for (int n = 0; n < 2; ++n) acc[a][b][m][n] = (f32x4){0.f, 0.f, 0.f, 0.f};
        cur = nxt; cA = nA; cB = nB; ++ui;
        if constexpr (ALIGN_EPI) { if (wr == 1) PG8_BAR; }
    }
    PG8_WAIT_V(0);
    if constexpr (!ALIGN_EPI) { if (wr == 0) PG8_BAR; }
    PG8_BAR;
    if constexpr (Epi::AFTER_DRAIN) { E.fused(acc, cur, wr, wc, fr, fq, lds, wid, lane); S.done(cur); }
#undef PG8_SA
#undef PG8_SB
#undef PG8_STAGE
#undef PG8_LDA
#undef PG8_LDB
#undef PG8_MMA
#undef PG8_WAIT_V
#undef PG8_WAIT_L
#undef PG8_BAR
#undef PG8_SCHED
}
}
namespace att {
using bf16 = __hip_bfloat16;
constexpr int D = 128, NW = 8, QBLK = 32, KVBLK = 64;
constexpr float SCALE = 0.088388347648318440f;
constexpr float THR = 8.f;
constexpr int SDEPTH = 2;
constexpr int LDQ = PW, LDK = PW, LDO = YW;
constexpr size_t SHM_V = KVBLK * D * 2, SHM_K = KVBLK * D * 2, SHM_ATTN = 2 * SHM_V + 2 * SHM_K + NW * 64 * 4;
using bf16x8 = __attribute__((ext_vector_type(8))) short;
using s16x4  = __attribute__((ext_vector_type(4))) short;
using f32x16 = __attribute__((ext_vector_type(16))) float;
using f32x8  = __attribute__((ext_vector_type(8))) float;
using u32x4  = __attribute__((ext_vector_type(4))) unsigned;
#define KSWZ(row, colB) ((row) * 256 + ((colB) ^ (((row) & 7) << 4)))
#define SBAR() __builtin_amdgcn_sched_barrier(0)
__device__ __forceinline__ int crow(int r, int hi) { return (r & 3) + 8 * (r >> 2) + 4 * hi; }
__device__ __forceinline__ unsigned cvtpk(float lo, float hi) {
  unsigned r; asm volatile("v_cvt_pk_bf16_f32 %0, %1, %2" : "=v"(r) : "v"(lo), "v"(hi)); return r;
}
template <typename TIn> struct Stage;
template <> struct Stage<bf16>  { using T = bf16x8;
  __device__ static __forceinline__ T ld8(const bf16* p) { return *reinterpret_cast<const bf16x8*>(p); }
  __device__ static __forceinline__ bf16x8 tobf(T x) { return x; } };
template <> struct Stage<float> { using T = f32x8;
  __device__ static __forceinline__ T ld8(const float* p) { return *reinterpret_cast<const f32x8*>(p); }
  __device__ static __forceinline__ bf16x8 tobf(T x) {
    u32x4 w = {cvtpk(x[0], x[1]), cvtpk(x[2], x[3]), cvtpk(x[4], x[5]), cvtpk(x[6], x[7])}; return *reinterpret_cast<bf16x8*>(&w); } };

__device__ __forceinline__ void partialSM(f32x16& p0, f32x16& p1, float& m_reg, float& mn, float& alpha) {
  constexpr float C = SCALE * 1.4426950408889634f;
  float pmax = p0[0]; for (int r = 1; r < 16; ++r) pmax = fmaxf(pmax, p0[r]); for (int r = 0; r < 16; ++r) pmax = fmaxf(pmax, p1[r]);
  { auto rr = __builtin_amdgcn_permlane32_swap(__float_as_uint(pmax), __float_as_uint(pmax), false, false);
    pmax = fmaxf(__uint_as_float(rr[0]), __uint_as_float(rr[1])); }
  if (__builtin_expect(__all(pmax - m_reg <= THR / SCALE), 1)) { mn = m_reg; alpha = 1.f; }
  else { mn = fmaxf(m_reg, pmax); alpha = __builtin_amdgcn_exp2f((m_reg - mn) * C); m_reg = mn; }
  float mnC = -mn * C;
  for (int r = 0; r < 16; ++r) p0[r] = fmaf(p0[r], C, mnC); for (int r = 0; r < 16; ++r) p1[r] = fmaf(p1[r], C, mnC);
  for (int r = 0; r < 16; ++r) p0[r] = __builtin_amdgcn_exp2f(p0[r]);
}
__device__ __forceinline__ void finishSM(f32x16& p0, f32x16& p1, float alpha, float& l_reg, bf16x8& pa0, bf16x8& pa1, bf16x8& pa2, bf16x8& pa3) {
  for (int r = 0; r < 16; ++r) p1[r] = __builtin_amdgcn_exp2f(p1[r]);
  float ps = 0; for (int r = 0; r < 16; ++r) ps += p0[r]; for (int r = 0; r < 16; ++r) ps += p1[r];
  { auto rr = __builtin_amdgcn_permlane32_swap(__float_as_uint(ps), __float_as_uint(ps), false, false);
    ps = __uint_as_float(rr[0]) + __uint_as_float(rr[1]); }
  l_reg = l_reg * alpha + ps;
#define PK4(P, BASE, OUT) do { unsigned a0 = cvtpk(P[BASE + 0], P[BASE + 1]), a1 = cvtpk(P[BASE + 2], P[BASE + 3]);   \
    unsigned b0 = cvtpk(P[BASE + 4], P[BASE + 5]), b1 = cvtpk(P[BASE + 6], P[BASE + 7]);                              \
    auto r0 = __builtin_amdgcn_permlane32_swap(a0, b0, false, false); auto r1 = __builtin_amdgcn_permlane32_swap(a1, b1, false, false); \
    u32x4 w = {r0[0], r1[0], r0[1], r1[1]}; OUT = *reinterpret_cast<bf16x8*>(&w); } while (0)
  PK4(p0, 0, pa0); PK4(p0, 8, pa1); PK4(p1, 0, pa2); PK4(p1, 8, pa3);
#undef PK4
}
__device__ __forceinline__ void qkt(f32x16& p0, f32x16& p1, const bf16* Ks, const bf16x8* qr, int r32, int hi) {
  p0 = f32x16{}; p1 = f32x16{};
  for (int d0 = 0; d0 < 8; ++d0) { int cb = (d0 * 16 + hi * 8) * 2;
    bf16x8 b0 = *reinterpret_cast<const bf16x8*>((const char*)Ks + KSWZ(r32, cb));
    bf16x8 b1 = *reinterpret_cast<const bf16x8*>((const char*)Ks + KSWZ(32 + r32, cb));
    p0 = __builtin_amdgcn_mfma_f32_32x32x16_bf16(b0, qr[d0], p0, 0, 0, 0);
    p1 = __builtin_amdgcn_mfma_f32_32x32x16_bf16(b1, qr[d0], p1, 0, 0, 0); }
}
__device__ __forceinline__ int v_st(int k, int c) { const int kk = (k & ~0xC) | ((k & 4) << 1) | ((k & 8) >> 1); return ((kk >> 3) * 4 + (c >> 5)) * 512 + ((kk & 7) * 32 + (c & 31)) * 2; }
__device__ __forceinline__ int v_rd_base(int lane) { return ((lane & 3) << 3) | (((lane >> 2) & 3) << 6) | (((lane >> 4) & 1) << 5) | (((lane >> 5) & 1) << 8); }
constexpr int v_rd_off(int d0, int ks, int half) { return d0 * 512 + ks * 4096 + half * 2048; }
template <int OFF> __device__ __forceinline__ s16x4 tr_read(int vb) {
  s16x4 r; asm volatile("ds_read_b64_tr_b16 %0, %1 offset:%2" : "=&v"(r) : "v"(vb), "i"(OFF) : "memory"); return r;
}
template <int D0> __device__ __forceinline__ void pv_one(f32x16& od, int vb, bf16x8 pa0, bf16x8 pa1, bf16x8 pa2, bf16x8 pa3) {
  const s16x4 l0 = tr_read<v_rd_off(D0, 0, 0)>(vb), h0 = tr_read<v_rd_off(D0, 0, 1)>(vb), l1 = tr_read<v_rd_off(D0, 1, 0)>(vb), h1 = tr_read<v_rd_off(D0, 1, 1)>(vb);
  const s16x4 l2 = tr_read<v_rd_off(D0, 2, 0)>(vb), h2 = tr_read<v_rd_off(D0, 2, 1)>(vb), l3 = tr_read<v_rd_off(D0, 3, 0)>(vb), h3 = tr_read<v_rd_off(D0, 3, 1)>(vb);
  asm volatile("s_waitcnt lgkmcnt(0)" ::: "memory"); SBAR();
#define PK(L, H) (bf16x8){L[0], L[1], L[2], L[3], H[0], H[1], H[2], H[3]}
  od = __builtin_amdgcn_mfma_f32_32x32x16_bf16(pa0, PK(l0, h0), od, 0, 0, 0);
  od = __builtin_amdgcn_mfma_f32_32x32x16_bf16(pa1, PK(l1, h1), od, 0, 0, 0);
  od = __builtin_amdgcn_mfma_f32_32x32x16_bf16(pa2, PK(l2, h2), od, 0, 0, 0);
  od = __builtin_amdgcn_mfma_f32_32x32x16_bf16(pa3, PK(l3, h3), od, 0, 0, 0);
#undef PK
}
__device__ __forceinline__ void pv_d0(f32x16* o, int vb, bf16x8 pa0, bf16x8 pa1, bf16x8 pa2, bf16x8 pa3) {
  pv_one<0>(o[0], vb, pa0, pa1, pa2, pa3); pv_one<1>(o[1], vb, pa0, pa1, pa2, pa3); pv_one<2>(o[2], vb, pa0, pa1, pa2, pa3); pv_one<3>(o[3], vb, pa0, pa1, pa2, pa3);
}

template <typename TQ>
__device__ __forceinline__ void attn_dense_body(const TQ* __restrict__ Qb, const bf16* __restrict__ Kh, const bf16* __restrict__ Vh,
                                                unsigned short* __restrict__ Ob, int seq, char* lds) {
  using St = Stage<bf16>; using SQ = Stage<TQ>;
  const int tid = opaque_tid(), wid = tid >> 6, lane = tid & 63, r32 = lane & 31, hi = lane >> 5;
  bf16* V_lds = (bf16*)lds; bf16* K_lds = (bf16*)(lds + 2 * SHM_V);
  float* ws = (float*)(lds + 2 * SHM_V + 2 * SHM_K) + wid * 64; float* li_l = ws; float* al_l = ws + 32;
  float m_reg = -1e30f, l_reg = 0; f32x16 o[4] = {}; bf16x8 qr[8];
  const TQ* Qw = Qb + (long)(wid * QBLK + r32) * LDQ + hi * 8;
#pragma unroll
  for (int d0 = 0; d0 < 8; ++d0) qr[d0] = SQ::tobf(SQ::ld8(Qw + d0 * 16));
  const int sr = tid >> 4, sc = (tid & 15) * 8, vst0 = v_st(sr, sc), vst1 = v_st(32 + sr, sc);
  const int vb0 = (int)(uintptr_t)V_lds + v_rd_base(lane);
  struct { typename St::T vs0, vs1, ks0, ks1; } sr_[SDEPTH];
#define SLOAD(i, k0) do { sr_[i].vs0 = St::ld8(&Vh[(long)((k0) + sr) * LDK + sc]); sr_[i].vs1 = St::ld8(&Vh[(long)((k0) + 32 + sr) * LDK + sc]); \
    sr_[i].ks0 = St::ld8(&Kh[(long)((k0) + sr) * LDK + sc]); sr_[i].ks1 = St::ld8(&Kh[(long)((k0) + 32 + sr) * LDK + sc]); } while (0)
#define SWRITE(b, i) do { *(bf16x8*)((char*)V_lds + (b) * SHM_V + vst0) = St::tobf(sr_[i].vs0);          \
    *(bf16x8*)((char*)V_lds + (b) * SHM_V + vst1) = St::tobf(sr_[i].vs1); int kc = sc * 2;               \
    *(bf16x8*)((char*)K_lds + (b) * SHM_K + KSWZ(sr, kc)) = St::tobf(sr_[i].ks0);                       \
    *(bf16x8*)((char*)K_lds + (b) * SHM_K + KSWZ(32 + sr, kc)) = St::tobf(sr_[i].ks1); } while (0)
#define SWAIT() do { if constexpr (SDEPTH == 2) asm volatile("s_waitcnt vmcnt(4)" ::: "memory"); else asm volatile("s_waitcnt vmcnt(0)" ::: "memory"); } while (0)
#define RESC(a) do { if (__any((a) < 1.f)) { if (hi == 0) al_l[r32] = (a); asm volatile("s_waitcnt lgkmcnt(0)" ::: "memory"); \
    for (int d = 0; d < 4; ++d) for (int r = 0; r < 16; ++r) o[d][r] *= al_l[crow(r, hi)]; } } while (0)
  f32x16 pA0, pA1, pB0, pB1; float mnA, mnB, alA, alB; bf16x8 pa0, pa1, pa2, pa3; const int NT = seq / KVBLK;
  constexpr int SE = 0, SO = SDEPTH - 1;
  SLOAD(SE, 0); asm volatile("s_waitcnt vmcnt(0)" ::: "memory"); SWRITE(0, SE); __syncthreads();
  qkt(pA0, pA1, K_lds, qr, r32, hi); partialSM(pA0, pA1, m_reg, mnA, alA);
  SLOAD(SO, KVBLK); if constexpr (SDEPTH == 2) { if (2 < NT) SLOAD(SE, 2 * KVBLK); }
  SWAIT(); SWRITE(1, SO); __syncthreads();
  for (int j = 1; j + 1 < NT; j += 2) {
    SBAR(); qkt(pB0, pB1, (bf16*)((char*)K_lds + SHM_K), qr, r32, hi);
    finishSM(pA0, pA1, alA, l_reg, pa0, pa1, pa2, pa3); SBAR();
    SLOAD(SO, (j + SDEPTH) * KVBLK); SBAR();
    pv_d0(o, vb0, pa0, pa1, pa2, pa3); partialSM(pB0, pB1, m_reg, mnB, alB);
    __syncthreads(); SWAIT(); SWRITE(0, SE);
    RESC(alB); __syncthreads();
    SBAR(); qkt(pA0, pA1, K_lds, qr, r32, hi);
    finishSM(pB0, pB1, alB, l_reg, pa0, pa1, pa2, pa3); SBAR();
    if (SDEPTH == 1 || j + 3 < NT) SLOAD(SE, (j + 1 + SDEPTH) * KVBLK); SBAR();
    pv_d0(o, vb0 + (int)SHM_V, pa0, pa1, pa2, pa3); partialSM(pA0, pA1, m_reg, mnA, alA);
    __syncthreads(); SWAIT(); SWRITE(1, SO);
    RESC(alA); __syncthreads();
  }
  SBAR(); qkt(pB0, pB1, (bf16*)((char*)K_lds + SHM_K), qr, r32, hi);
  finishSM(pA0, pA1, alA, l_reg, pa0, pa1, pa2, pa3); SBAR();
  pv_d0(o, vb0, pa0, pa1, pa2, pa3); partialSM(pB0, pB1, m_reg, mnB, alB);
  __syncthreads(); RESC(alB);
  finishSM(pB0, pB1, alB, l_reg, pa0, pa1, pa2, pa3); SBAR();
  pv_d0(o, vb0 + (int)SHM_V, pa0, pa1, pa2, pa3);
  if (hi == 0) li_l[r32] = l_reg; asm volatile("s_waitcnt lgkmcnt(0)" ::: "memory");
  float rli[16];
#pragma unroll
  for (int r = 0; r < 16; ++r) rli[r] = __builtin_amdgcn_rcpf(li_l[crow(r, hi)]);
  unsigned short* Ow = Ob + (long)(wid * QBLK) * LDO;
#pragma unroll
  for (int r = 0; r < 16; ++r) { int orow = crow(r, hi);
    for (int d0 = 0; d0 < 4; ++d0) Ow[(long)orow * LDO + d0 * 32 + r32] = (unsigned short)f2bf(o[d0][r] * rli[r]); }
#undef SLOAD
#undef SWRITE
#undef SWAIT
#undef RESC
}
}
struct Frame {
    LAS unsigned char* lds; unsigned char* ldsg;
    volatile LAS unsigned* MISC;
    unsigned* ctl; unsigned char* ws;
    int tid, lane, wave, G, vcu;
};
__device__ __forceinline__ const float* inp(const Frame& F, int k) {
    const unsigned lo = __builtin_amdgcn_readfirstlane(F.MISC[16 + 2 * k]), hi = __builtin_amdgcn_readfirstlane(F.MISC[17 + 2 * k]);
    return (const float*)(((unsigned long long)hi << 32) | (unsigned long long)lo);
}
enum { I_x = 0, I_c, I_ctx, I_c_ctx, I_w_ada, I_b_ada, I_w_in, I_ret_decay, I_dn_conv_w, I_dn_a_log, I_dn_dt_bias, I_dn_norm_w, I_att_qn_w, I_att_kn_w, I_w_o, I_ln1_w, I_ln1_b, I_w_ffi, I_w_ffo, I_ln2_w, I_ln2_b, I_out };

__device__ __forceinline__ void transpose_item(const float* W, int ldw, bf16_t* WT, int K, int dst_row0, int src_col0, int ncols, int k0, LAS float* scr, int lane) {
    const int cc = lane & 31;
#pragma unroll 8
    for (int i = 0; i < 32; ++i) { const int kk = 2 * i + (lane >> 5); scr[kk * 33 + cc] = (cc < ncols) ? W[(size_t)(k0 + kk) * ldw + src_col0 + cc] : 0.f; }
    LDS_WAIT();
    const int c8 = lane & 7;
#pragma unroll
    for (int j = 0; j < 4; ++j) { const int n = (lane >> 3) + 8 * j; const LAS float* s = scr + (8 * c8) * 33 + n;
        u32x4 o; o.x = pk2(s[0 * 33], s[1 * 33]); o.y = pk2(s[2 * 33], s[3 * 33]); o.z = pk2(s[4 * 33], s[5 * 33]); o.w = pk2(s[6 * 33], s[7 * 33]);
        if (n < ncols) *(u32x4*)(WT + (size_t)(dst_row0 + n) * K + k0 + 8 * c8) = o; }
    LDS_WAIT();
}
__device__ __forceinline__ void prologue_phase(Frame& F) {
    LAS float* scr = (LAS float*)(F.lds + F.wave * 8448);
    const int gw = F.vcu * NWAVES + F.wave, NGW = F.G * NWAVES, lane = F.lane;
    bf16_t* Win_t = (bf16_t*)(F.ws + WS_WIN); bf16_t* Wo_t = (bf16_t*)(F.ws + WS_WO); bf16_t* Wfi_t = (bf16_t*)(F.ws + WS_WFI); bf16_t* Wfo_t = (bf16_t*)(F.ws + WS_WFO);
    constexpr int I_IN = 32 * 177, I_O = 32 * 64, I_FI = 32 * 352, I_FO = 88 * 64, I_L = I_IN + I_O + I_FI + I_FO;
    for (int it = gw; it < DEPTH * I_L; it += NGW) {
        const int l = it / I_L; int r = it - l * I_L;
        if (r < I_IN) { const int kb = r / 177, nb = r - kb * 177; int dst = 32 * nb, src = 32 * nb, nc = 32;
            if (nb >= 128) src += 16; if (nb == 176) { dst = 5632; src = 4096; nc = 16; }
            transpose_item(inp(F, I_w_in) + (size_t)l * DM * PROJ_SRC, PROJ_SRC, Win_t + (size_t)l * PWPAD * DM, DM, dst, src, nc, 64 * kb, scr, lane); continue; }
        r -= I_IN;
        if (r < I_O) { const int kb = r >> 6, nb = r & 63;
            transpose_item(inp(F, I_w_o) + (size_t)l * DM * DM, DM, Wo_t + (size_t)l * DM * DM, DM, 32 * nb, 32 * nb, 32, 64 * kb, scr, lane); continue; }
        r -= I_O;
        if (r < I_FI) { const int kb = r / 352, nb = r - kb * 352, pn = nb >> 3, q = nb & 7; const int src = q < 4 ? 128 * pn + 32 * q : DFF + 128 * pn + 32 * (q - 4);
            transpose_item(inp(F, I_w_ffi) + (size_t)l * DM * 2 * DFF, 2 * DFF, Wfi_t + (size_t)l * 2 * DFF * DM, DM, 32 * nb, src, 32, 64 * kb, scr, lane); continue; }
        r -= I_FI;
        { const int kb = r >> 6, nb = r & 63;
            transpose_item(inp(F, I_w_ffo) + (size_t)l * DFF * DM, DM, Wfo_t + (size_t)l * DM * DFF, DFF, 32 * nb, 32 * nb, 32, 64 * kb, scr, lane); }
    }
    { constexpr int PER_L = (PWPAD - PROJ_SRC) * DM / 8;
      for (int i = (F.vcu * NWAVES * 64) + F.tid; i < DEPTH * PER_L; i += F.G * NWAVES * 64) { const int l = i / PER_L, j = i - l * PER_L;
          *(u32x4*)(Win_t + (size_t)l * PWPAD * DM + (size_t)PROJ_SRC * DM + (size_t)j * 8) = (u32x4){0u, 0u, 0u, 0u}; } }
    LAS float* cond = (LAS float*)(F.lds + 73728);
    LAS float* red = (LAS float*)(F.lds + 98304);
    __syncthreads();
    for (int i = F.tid; i < 3 * DM; i += NWAVES * 64) { const int s = i / DM, k = i - s * DM; const float v = s < 2 ? inp(F, I_c)[s * DM + k] : inp(F, I_c_ctx)[k]; cond[i] = v / (1.f + expf(-v)); }
    __syncthreads();
    float* MOD = (float*)(F.ws + WS_MOD);
    for (int item = F.vcu; item < DEPTH * 96; item += F.G) {
        const int l = item / 96, cb = item - l * 96;
        const float* W = inp(F, I_w_ada) + (size_t)l * DM * 12288 + cb * 128 + 2 * lane;
        float a00 = 0.f, a01 = 0.f, a10 = 0.f, a11 = 0.f, a20 = 0.f, a21 = 0.f;
        const int kbeg = F.wave * 256;
#pragma unroll 8
        for (int k = kbeg; k < kbeg + 256; ++k) { const f32x2 w = *(const f32x2*)(W + (size_t)k * 12288); const float c0 = cond[k], c1 = cond[DM + k], c2 = cond[2 * DM + k];
            a00 += c0 * w.x; a01 += c0 * w.y; a10 += c1 * w.x; a11 += c1 * w.y; a20 += c2 * w.x; a21 += c2 * w.y; }
        red[(F.wave * 3 + 0) * 128 + 2 * lane] = a00; red[(F.wave * 3 + 0) * 128 + 2 * lane + 1] = a01;
        red[(F.wave * 3 + 1) * 128 + 2 * lane] = a10; red[(F.wave * 3 + 1) * 128 + 2 * lane + 1] = a11;
        red[(F.wave * 3 + 2) * 128 + 2 * lane] = a20; red[(F.wave * 3 + 2) * 128 + 2 * lane + 1] = a21;
        __syncthreads();
        if (F.tid < 384) { const int s = F.tid >> 7, cc = F.tid & 127; float sum = inp(F, I_b_ada)[l * 12288 + cb * 128 + cc];
#pragma unroll
            for (int w = 0; w < 8; ++w) sum += red[(w * 3 + s) * 128 + cc];
            MOD[(size_t)(l * 3 + s) * 12288 + cb * 128 + cc] = sum; }
        __syncthreads();
    }
}

template <int MODE> __device__ __forceinline__ void ln_mod_phase(Frame& F, int l, bool skip_ctx) {
    float* X = (float*)(F.ws + WS_X); bf16_t* H = (bf16_t*)(F.ws + WS_H); const float* MOD = (const float*)(F.ws + WS_MOD);
    const int gw = F.vcu * NWAVES + F.wave, NGW = F.G * NWAVES, lane = F.lane;
    const float* lw = (MODE == 1 ? inp(F, I_ln1_w) : inp(F, I_ln2_w)) + l * DM; const float* lb = (MODE == 1 ? inp(F, I_ln1_b) : inp(F, I_ln2_b)) + l * DM;
    const int lm = MODE == 0 ? 0 : (MODE == 1 ? l : l + 1), ish = MODE == 1 ? 3 : 0, isc = MODE == 1 ? 4 : 1;
    for (int r = gw; r < MROWS; r += NGW) {
        const int b = r / TOK, tp = r - b * TOK; const bool is_ctx = tp < CTXL; const int s = is_ctx ? 2 : b;
        if ((skip_ctx || MODE == 3) && is_ctx) continue;
        const float* src = MODE == 0 ? (is_ctx ? inp(F, I_ctx) + (size_t)(b * CTXL + tp) * DM : inp(F, I_x) + (size_t)(b * SEQ + tp - CTXL) * DM) : X + (size_t)r * DM;
        f32x4 v[8];
#pragma unroll
        for (int j = 0; j < 8; ++j) v[j] = *(const f32x4*)(src + 4 * lane + 256 * j);
        if (MODE != 0) {
            float sm = 0.f;
#pragma unroll
            for (int j = 0; j < 8; ++j) sm += (v[j][0] + v[j][1]) + (v[j][2] + v[j][3]);
            const float mean = wave_sum(sm) * (1.f / DM); float sq = 0.f;
#pragma unroll
            for (int j = 0; j < 8; ++j) { v[j] = v[j] - mean; sq += (v[j][0] * v[j][0] + v[j][1] * v[j][1]) + (v[j][2] * v[j][2] + v[j][3] * v[j][3]); }
            const float rstd = rsqrtf(wave_sum(sq) * (1.f / DM) + EPS);
#pragma unroll
            for (int j = 0; j < 8; ++j) { const f32x4 w = *(const f32x4*)(lw + 4 * lane + 256 * j), bb = *(const f32x4*)(lb + 4 * lane + 256 * j); v[j] = v[j] * rstd * w + bb; }
        }
        if (MODE == 3) {
            float* o = (float*)inp(F, I_out) + (size_t)(b * SEQ + tp - CTXL) * DM;
#pragma unroll
            for (int j = 0; j < 8; ++j) *(f32x4*)(o + 4 * lane + 256 * j) = v[j];
        } else {
            const float* msh = MOD + (size_t)(lm * 3 + s) * 12288 + ish * DM; const float* msc = MOD + (size_t)(lm * 3 + s) * 12288 + isc * DM;
#pragma unroll
            for (int j = 0; j < 8; ++j) { *(f32x4*)(X + (size_t)r * DM + 4 * lane + 256 * j) = v[j];
                const f32x4 sh = *(const f32x4*)(msh + 4 * lane + 256 * j), sc = *(const f32x4*)(msc + 4 * lane + 256 * j); const f32x4 hh = v[j] * (sc + 1.f) + sh;
                u32x2 w; w.x = pk2(hh[0], hh[1]); w.y = pk2(hh[2], hh[3]); *(u32x2*)(H + (size_t)r * DM + 4 * lane + 256 * j) = w; }
        }
    }
}

__device__ __forceinline__ void rowprep_phase(Frame& F, int l) {
    bf16_t* P = (bf16_t*)(F.ws + WS_P); float* AB = (float*)(F.ws + WS_AB); bf16_t* DQ = (bf16_t*)(F.ws + WS_DQ);
    const int lane = F.lane, gw = F.vcu * NWAVES + F.wave, NGW = F.G * NWAVES;
    const float qw1 = inp(F, I_att_qn_w)[l * 128 + lane], qw2 = inp(F, I_att_qn_w)[l * 128 + 64 + lane], kw1 = inp(F, I_att_kn_w)[l * 128 + lane], kw2 = inp(F, I_att_kn_w)[l * 128 + 64 + lane];
    const float* cw = inp(F, I_dn_conv_w) + (size_t)l * 5 * 1536;
    const float inv = powf(10000.f, -(float)(lane & 31) * (1.f / 32.f));
    const float nega = lane < 8 ? -expf(inp(F, I_dn_a_log)[l * 8 + lane]) : 0.f, dtb = lane < 8 ? inp(F, I_dn_dt_bias)[l * 8 + lane] : 0.f;
    for (int r = gw; r < MROWS; r += NGW) {
        const int b = r / TOK, tp = r - b * TOK; const bool is_ctx = tp < CTXL;
        float cs = 1.f, sn = 0.f;
        if (!is_ctx) { const int t = tp - CTXL; const float pos = (lane < 32) ? (float)(t >> 6) : (float)(t & 63); sincosf(pos * inv, &sn, &cs); }
        bf16_t* p = P + (size_t)r * PW;
        for (int hh = 0; hh < 10; ++hh) {
            const int base = hh < 8 ? C_AQ + hh * 128 : C_AK + (hh - 8) * 128;
            float x1 = bf2f(p[base + lane]), x2 = bf2f(p[base + 64 + lane]);
            const float ri = rsqrtf(wave_sum(x1 * x1 + x2 * x2) * (1.f / 128.f) + EPS);
            x1 *= ri * (hh < 8 ? qw1 : kw1); x2 *= ri * (hh < 8 ? qw2 : kw2);
            p[base + lane] = (bf16_t)f2bf(x1 * cs - x2 * sn); p[base + 64 + lane] = (bf16_t)f2bf(x1 * sn + x2 * cs);
        }
        for (int hh = 0; hh < 8; ++hh) {
            const int base = hh < 4 ? C_RQ + hh * 128 : C_RK + (hh - 4) * 128; const float ks = hh < 4 ? 1.f : 0.088388347648318440f;
            const float x1 = bf2f(p[base + lane]), x2 = bf2f(p[base + 64 + lane]);
            p[base + lane] = (bf16_t)f2bf((x1 * cs - x2 * sn) * ks); p[base + 64 + lane] = (bf16_t)f2bf((x1 * sn + x2 * cs) * ks);
        }
#pragma unroll
        for (int j = 0; j < 3; ++j) {
            const int c0 = 8 * (lane + 64 * j); float a[8];
#pragma unroll
            for (int e = 0; e < 8; ++e) a[e] = 0.f;
#pragma unroll
            for (int k = 0; k < 5; ++k) { const int rr = tp + k - 2; const bool valid = is_ctx ? (rr >= 0 && rr < CTXL) : (rr >= CTXL && rr < TOK);
                if (valid) { const u32x4 xv = *(const u32x4*)(P + (size_t)(r + k - 2) * PW + C_DQKV + c0); const f32x4 w0 = *(const f32x4*)(cw + k * 1536 + c0), w1 = *(const f32x4*)(cw + k * 1536 + c0 + 4);
                    a[0] += w0[0] * bflo(xv.x); a[1] += w0[1] * bfhi(xv.x); a[2] += w0[2] * bflo(xv.y); a[3] += w0[3] * bfhi(xv.y);
                    a[4] += w1[0] * bflo(xv.z); a[5] += w1[1] * bfhi(xv.z); a[6] += w1[2] * bflo(xv.w); a[7] += w1[3] * bfhi(xv.w); } }
            float ss = 0.f;
#pragma unroll
            for (int e = 0; e < 8; ++e) { a[e] = a[e] / (1.f + __expf(-a[e])); ss += a[e] * a[e]; }
            if (j < 2) { const float sc = rsqrtf(sum16(ss) + EPS) * (j == 0 ? 0.088388347648318440f : 1.f);
#pragma unroll
                for (int e = 0; e < 8; ++e) a[e] *= sc; }
            u32x4 o; o.x = pk2(a[0], a[1]); o.y = pk2(a[2], a[3]); o.z = pk2(a[4], a[5]); o.w = pk2(a[6], a[7]);
            *(u32x4*)(DQ + (size_t)r * 1536 + c0) = o;
        }
        if (lane < 8) { const float av = AB[(size_t)r * 16 + lane], bv = AB[(size_t)r * 16 + 8 + lane]; const float xx = av + dtb; const float sp = xx > 20.f ? xx : log1pf(expf(xx));
            AB[(size_t)r * 16 + lane] = nega * sp; AB[(size_t)r * 16 + 8 + lane] = 1.f / (1.f + expf(-bv)); }
    }
}

constexpr int DP_QS = 0, DP_KS = 17408, DP_KT = 36864, DP_VT = 55296, DP_AS = 73728, DP_GC = 108544;
__device__ __forceinline__ void dnprep_unit(Frame& F, int unit) {
    const bf16_t* DQ = (const bf16_t*)(F.ws + WS_DQ); const float* GB = (const float*)(F.ws + WS_AB);
    bf16_t* DNW = (bf16_t*)(F.ws + WS_DNW); bf16_t* DNKC = (bf16_t*)(F.ws + WS_DNKC); bf16_t* DNQG = (bf16_t*)(F.ws + WS_DNQG); bf16_t* DNKGT = (bf16_t*)(F.ws + WS_DNKGT); bf16_t* DNQK = (bf16_t*)(F.ws + WS_DNQK); float* DNGL = (float*)(F.ws + WS_DNGL);
    LAS unsigned char* L = F.lds; LAS float* gcs = (LAS float*)(L + DP_GC); LAS float* bes = gcs + 128; LAS float* AS = (LAS float*)(L + DP_AS);
    const int tid = F.tid, lane = F.lane, wave = F.wave, rr = lane & 15, kg = lane >> 4;
    const int h = unit & 3, cg = (unit >> 2) % DN_NCH, b = (unit >> 2) / DN_NCH, rbase = b * TOK + 64 * cg;
    const size_t pu0 = (size_t)((b * DN_NCH + cg) * 4 + h) * 2;
    if (wave < 2) { const int dir = wave, tok = dir ? 63 - lane : lane; const size_t row = rbase + tok;
        float s = GB[row * 16 + dir * 4 + h]; const float be = GB[row * 16 + 8 + dir * 4 + h];
#pragma unroll
        for (int o = 1; o < 64; o <<= 1) { const float t = __shfl_up(s, o); if (lane >= o) s += t; }
        gcs[dir * 64 + lane] = s; bes[dir * 64 + lane] = be; }
    { const int row = tid >> 3, seg = tid & 7; const bf16_t* src = DQ + (size_t)(rbase + row) * 1536 + h * 128 + seg * 16;
      const u32x4 q0 = *(const u32x4*)src, q1 = *(const u32x4*)(src + 8), k0 = *(const u32x4*)(src + 512), k1 = *(const u32x4*)(src + 520), v0 = *(const u32x4*)(src + 1024), v1 = *(const u32x4*)(src + 1032);
      *(LAS u32x4*)(L + DP_QS + row * 272 + seg * 32) = q0; *(LAS u32x4*)(L + DP_QS + row * 272 + seg * 32 + 16) = q1;
      *(LAS u32x4*)(L + DP_KS + row * 272 + seg * 32) = k0; *(LAS u32x4*)(L + DP_KS + row * 272 + seg * 32 + 16) = k1;
      const unsigned kw[8] = {k0.x, k0.y, k0.z, k0.w, k1.x, k1.y, k1.z, k1.w}, vw[8] = {v0.x, v0.y, v0.z, v0.w, v1.x, v1.y, v1.z, v1.w};
#pragma unroll
      for (int e = 0; e < 8; ++e) { const int d = seg * 16 + 2 * e;
          *(LAS bf16_t*)(L + DP_KT + (d * 72 + row) * 2) = (bf16_t)(kw[e] & 0xffffu); *(LAS bf16_t*)(L + DP_KT + ((d + 1) * 72 + row) * 2) = (bf16_t)(kw[e] >> 16);
          *(LAS bf16_t*)(L + DP_VT + (d * 72 + row) * 2) = (bf16_t)(vw[e] & 0xffffu); *(LAS bf16_t*)(L + DP_VT + ((d + 1) * 72 + row) * 2) = (bf16_t)(vw[e] >> 16); } }
    __syncthreads();
#pragma unroll
    for (int jj = 0; jj < 2; ++jj) {
        const int it = wave >> 1, jt = 2 * (wave & 1) + jj; f32x4 kk = {0.f, 0.f, 0.f, 0.f}, qk = {0.f, 0.f, 0.f, 0.f};
#pragma unroll
        for (int ks = 0; ks < 4; ++ks) { const bf16x8 aK = ldsfrag(L + DP_KS + (16 * jt + rr) * 272 + (32 * ks + 8 * kg) * 2), bK = ldsfrag(L + DP_KS + (16 * it + rr) * 272 + (32 * ks + 8 * kg) * 2), bQ = ldsfrag(L + DP_QS + (16 * it + rr) * 272 + (32 * ks + 8 * kg) * 2);
            kk = mfma16(aK, bK, kk); qk = mfma16(aK, bQ, qk); }
        const int i = 16 * it + rr, jb = 16 * jt + 4 * kg;
        { const float gi = gcs[i], bi = bes[i]; float av[4], qv[4];
#pragma unroll
          for (int r = 0; r < 4; ++r) { const int j = jb + r; const float e = (j <= i) ? __expf(gi - gcs[j]) : 0.f; av[r] = (j < i) ? bi * kk[r] * e : 0.f; qv[r] = qk[r] * e; }
          *(LAS f32x4*)(AS + i * 68 + jb) = (f32x4){av[0], av[1], av[2], av[3]};
          u32x2 w; w.x = pk2(qv[0], qv[1]); w.y = pk2(qv[2], qv[3]); *(u32x2*)(DNQK + (pu0 + 0) * 4096 + i * 64 + jb) = w; }
        { const int i1 = 63 - i; const float gi = gcs[64 + i1], bi = bes[64 + i1]; float av[4], qv[4];
#pragma unroll
          for (int r = 0; r < 4; ++r) { const int j1 = 63 - (jb + r); const float e = (j1 <= i1) ? __expf(gi - gcs[64 + j1]) : 0.f; av[r] = (j1 < i1) ? bi * kk[r] * e : 0.f; qv[r] = qk[r] * e; }
          const int jl = 60 - jb;
          *(LAS f32x4*)(AS + 64 * 68 + i1 * 68 + jl) = (f32x4){av[3], av[2], av[1], av[0]};
          u32x2 w; w.x = pk2(qv[3], qv[2]); w.y = pk2(qv[1], qv[0]); *(u32x2*)(DNQK + (pu0 + 1) * 4096 + i1 * 64 + jl) = w; }
    }
    { const int row = tid >> 3, seg = tid & 7;
#pragma unroll
      for (int dir = 0; dir < 2; ++dir) { const int tok = dir ? 63 - row : row; const float e = __expf(gcs[dir * 64 + row]);
          const u32x4 a0 = *(const LAS u32x4*)(L + DP_QS + tok * 272 + seg * 32), a1 = *(const LAS u32x4*)(L + DP_QS + tok * 272 + seg * 32 + 16);
          u32x4 o0, o1; o0.x = pk2(bflo(a0.x) * e, bfhi(a0.x) * e); o0.y = pk2(bflo(a0.y) * e, bfhi(a0.y) * e); o0.z = pk2(bflo(a0.z) * e, bfhi(a0.z) * e); o0.w = pk2(bflo(a0.w) * e, bfhi(a0.w) * e);
          o1.x = pk2(bflo(a1.x) * e, bfhi(a1.x) * e); o1.y = pk2(bflo(a1.y) * e, bfhi(a1.y) * e); o1.z = pk2(bflo(a1.z) * e, bfhi(a1.z) * e); o1.w = pk2(bflo(a1.w) * e, bfhi(a1.w) * e);
          bf16_t* dst = DNQG + (pu0 + dir) * 8192 + row * 128 + seg * 16; *(u32x4*)dst = o0; *(u32x4*)(dst + 8) = o1; } }
    { const int d = tid >> 2, sg = tid & 3;
#pragma unroll
      for (int dir = 0; dir < 2; ++dir) { const float gl = gcs[dir * 64 + 63]; unsigned ow[8];
#pragma unroll
          for (int e = 0; e < 8; ++e) { const int i0 = 16 * sg + 2 * e, i1 = i0 + 1; const int t0 = dir ? 63 - i0 : i0, t1 = dir ? 63 - i1 : i1;
              const float v0 = bf2f(*(const LAS bf16_t*)(L + DP_KT + (d * 72 + t0) * 2)) * __expf(gl - gcs[dir * 64 + i0]), v1 = bf2f(*(const LAS bf16_t*)(L + DP_KT + (d * 72 + t1) * 2)) * __expf(gl - gcs[dir * 64 + i1]);
              ow[e] = pk2(v0, v1); }
          bf16_t* dst = DNKGT + (pu0 + dir) * 8192 + d * 64 + 16 * sg; *(u32x4*)dst = (u32x4){ow[0], ow[1], ow[2], ow[3]}; *(u32x4*)(dst + 8) = (u32x4){ow[4], ow[5], ow[6], ow[7]}; } }
    if (tid < 2) DNGL[pu0 + tid] = __expf(gcs[tid * 64 + 63]);
    __syncthreads();
    if (wave < 2) { const int dir = wave; const LAS float* A = AS + dir * 64 * 68; float t[64];
#pragma unroll
        for (int i = 0; i < 64; ++i) { float acc0 = (i == lane) ? 1.f : 0.f, acc1 = 0.f;
#pragma unroll
            for (int j4 = 0; j4 < (i + 3) / 4; ++j4) { const f32x4 a = *(const LAS f32x4*)(A + i * 68 + 4 * j4);
                if (4 * j4 + 0 < i) acc0 -= a[0] * t[4 * j4 + 0]; if (4 * j4 + 1 < i) acc1 -= a[1] * t[4 * j4 + 1];
                if (4 * j4 + 2 < i) acc0 -= a[2] * t[4 * j4 + 2]; if (4 * j4 + 3 < i) acc1 -= a[3] * t[4 * j4 + 3]; }
            t[i] = acc0 + acc1; }
        const float be = bes[dir * 64 + lane], bg = be * __expf(gcs[dir * 64 + lane]); const int tau = dir ? 63 - lane : lane;
        LAS bf16_t* TP = (LAS bf16_t*)(L + (dir * 2 + 0) * 9216); LAS bf16_t* TPP = (LAS bf16_t*)(L + (dir * 2 + 1) * 9216);
#pragma unroll
        for (int i = 0; i < 64; ++i) { TP[i * 72 + tau] = (bf16_t)f2bf(t[i] * be); TPP[i * 72 + tau] = (bf16_t)f2bf(t[i] * bg); } }
    __syncthreads();
#pragma unroll
    for (int mat = 0; mat < 2; ++mat) { const LAS unsigned char* As_ = L + (mat ? DP_KT : DP_VT); bf16x8 a[2];
#pragma unroll
        for (int ks = 0; ks < 2; ++ks) a[ks] = ldsfrag(As_ + (16 * wave + rr) * 144 + (32 * ks + 8 * kg) * 2);
#pragma unroll
        for (int dir = 0; dir < 2; ++dir) { const LAS unsigned char* Bs_ = L + (dir * 2 + mat) * 9216; bf16_t* OUT = (mat ? DNKC : DNW) + (pu0 + dir) * 8192;
#pragma unroll
            for (int it = 0; it < 4; ++it) { f32x4 c = {0.f, 0.f, 0.f, 0.f};
#pragma unroll
                for (int ks = 0; ks < 2; ++ks) c = mfma16(a[ks], ldsfrag(Bs_ + (16 * it + rr) * 144 + (32 * ks + 8 * kg) * 2), c);
                u32x2 w; w.x = pk2(c[0], c[1]); w.y = pk2(c[2], c[3]); *(u32x2*)(OUT + (16 * it + rr) * 128 + 16 * wave + 4 * kg) = w; } } }
    __syncthreads();
}

constexpr int DS_KC = 0, DS_QG = 17408, DS_KGT = 34816, DS_QK = 53248, DS_W = 62464, DS_SB = 67584, DS_VT = 76288;
__device__ __forceinline__ void dnscan_unit(Frame& F, int unit) {
    const bf16_t* DNW = (const bf16_t*)(F.ws + WS_DNW); const bf16_t* DNKC = (const bf16_t*)(F.ws + WS_DNKC); const bf16_t* DNQG = (const bf16_t*)(F.ws + WS_DNQG); const bf16_t* DNKGT = (const bf16_t*)(F.ws + WS_DNKGT); const bf16_t* DNQK = (const bf16_t*)(F.ws + WS_DNQK); const float* DNGL = (const float*)(F.ws + WS_DNGL);
    float* ODN = (float*)(F.ws + WS_ODN);
    LAS unsigned char* L = F.lds;
    const int tid = F.tid, lane = F.lane, wave = F.wave, rr = lane & 15, kg = lane >> 4;
    const int sl = unit & 3, dir = (unit >> 2) & 1, h = (unit >> 3) & 3, b = unit >> 5;
    const int mt = wave >> 1, nt = wave & 1, dt0 = 2 * (wave >> 1), dt1 = dt0 + 1;
    f32x4 s0 = {0.f, 0.f, 0.f, 0.f}, s1 = {0.f, 0.f, 0.f, 0.f};
    for (int i = tid; i < 8704 / 4; i += NWAVES * 64) ((LAS unsigned*)(L + DS_SB))[i] = 0u;
    u32x4 rKC[2], rQG[2], rKGT[2], rQK, rW = {0u, 0u, 0u, 0u}; float rGL;
#define DS_CG(t) (dir ? ((t) < 4 ? 3 - (t) : 135 - (t)) : (t))
#define DS_LOAD(t) do { const size_t pu_ = (size_t)((b * DN_NCH + DS_CG(t)) * 4 + h) * 2 + dir; \
        _Pragma("unroll") for (int q_ = 0; q_ < 2; ++q_) { const int id_ = tid + 512 * q_; \
            rKC[q_] = *(const u32x4*)(DNKC + pu_ * 8192 + (id_ >> 4) * 128 + (id_ & 15) * 8); rQG[q_] = *(const u32x4*)(DNQG + pu_ * 8192 + (id_ >> 4) * 128 + (id_ & 15) * 8); \
            rKGT[q_] = *(const u32x4*)(DNKGT + pu_ * 8192 + (id_ >> 3) * 64 + (id_ & 7) * 8); } \
        rQK = *(const u32x4*)(DNQK + pu_ * 4096 + (tid >> 3) * 64 + (tid & 7) * 8); \
        if (tid < 256) rW = *(const u32x4*)(DNW + pu_ * 8192 + (tid >> 2) * 128 + sl * 32 + (tid & 3) * 8); \
        rGL = DNGL[pu_]; } while (0)
#define DS_STORE() do { _Pragma("unroll") for (int q_ = 0; q_ < 2; ++q_) { const int id_ = tid + 512 * q_; \
            *(LAS u32x4*)(L + DS_KC + (id_ >> 4) * 272 + (id_ & 15) * 16) = rKC[q_]; *(LAS u32x4*)(L + DS_QG + (id_ >> 4) * 272 + (id_ & 15) * 16) = rQG[q_]; \
            *(LAS u32x4*)(L + DS_KGT + (id_ >> 3) * 144 + (id_ & 7) * 16) = rKGT[q_]; } \
        *(LAS u32x4*)(L + DS_QK + (tid >> 3) * 144 + (tid & 7) * 16) = rQK; \
        if (tid < 256) *(LAS u32x4*)(L + DS_W + (tid >> 2) * 80 + (tid & 3) * 16) = rW; } while (0)
    DS_LOAD(0); VM_WAIT(); DS_STORE(); float gl = rGL;
    __syncthreads();
    for (int t = 0; t < DN_NCH; ++t) {
        const int cg = DS_CG(t);
        if (t + 1 < DN_NCH) DS_LOAD(t + 1);
        bf16x8 bS[4]; f32x4 av = {0.f, 0.f, 0.f, 0.f};
#pragma unroll
        for (int ks = 0; ks < 4; ++ks) { bS[ks] = ldsfrag(L + DS_SB + (16 * nt + rr) * 272 + (32 * ks + 8 * kg) * 2); av = mfma16(ldsfrag(L + DS_KC + (16 * mt + rr) * 272 + (32 * ks + 8 * kg) * 2), bS[ks], av); }
        float vn[4];
#pragma unroll
        for (int r = 0; r < 4; ++r) vn[r] = bf2f(*(const LAS bf16_t*)(L + DS_W + (16 * mt + 4 * kg + r) * 80 + (16 * nt + rr) * 2)) - av[r];
        { u32x2 w; w.x = pk2(vn[0], vn[1]); w.y = pk2(vn[2], vn[3]); *(LAS u32x2*)(L + DS_VT + (16 * nt + rr) * 144 + (16 * mt + 4 * kg) * 2) = w; }
        __syncthreads();
        f32x4 ao = {0.f, 0.f, 0.f, 0.f};
#pragma unroll
        for (int ks = 0; ks < 4; ++ks) ao = mfma16(ldsfrag(L + DS_QG + (16 * mt + rr) * 272 + (32 * ks + 8 * kg) * 2), bS[ks], ao);
        bf16x8 bV[2];
#pragma unroll
        for (int ks = 0; ks < 2; ++ks) { bV[ks] = ldsfrag(L + DS_VT + (16 * nt + rr) * 144 + (32 * ks + 8 * kg) * 2); ao = mfma16(ldsfrag(L + DS_QK + (16 * mt + rr) * 144 + (32 * ks + 8 * kg) * 2), bV[ks], ao); }
#pragma unroll
        for (int r = 0; r < 4; ++r) { const int i = 16 * mt + 4 * kg + r, tok = dir ? 63 - i : i;
            ODN[((size_t)dir * MROWS + (size_t)(b * TOK + 64 * cg + tok)) * 512 + h * 128 + sl * 32 + 16 * nt + rr] = ao[r]; }
        s0 = s0 * gl; s1 = s1 * gl;
#pragma unroll
        for (int ks = 0; ks < 2; ++ks) { s0 = mfma16(ldsfrag(L + DS_KGT + (16 * dt0 + rr) * 144 + (32 * ks + 8 * kg) * 2), bV[ks], s0); s1 = mfma16(ldsfrag(L + DS_KGT + (16 * dt1 + rr) * 144 + (32 * ks + 8 * kg) * 2), bV[ks], s1); }
        __syncthreads();
        { u32x2 w; w.x = pk2(s0[0], s0[1]); w.y = pk2(s0[2], s0[3]); *(LAS u32x2*)(L + DS_SB + (16 * nt + rr) * 272 + (16 * dt0 + 4 * kg) * 2) = w;
          w.x = pk2(s1[0], s1[1]); w.y = pk2(s1[2], s1[3]); *(LAS u32x2*)(L + DS_SB + (16 * nt + rr) * 272 + (16 * dt1 + 4 * kg) * 2) = w; }
        if (t + 1 < DN_NCH) { VM_WAIT(); DS_STORE(); gl = rGL; }
        __syncthreads();
    }
#undef DS_CG
#undef DS_LOAD
#undef DS_STORE
}

__device__ __forceinline__ float log_sigmoid_f(float x) { return -log1pf(expf(-x)); }
constexpr int RP_QS = 0, RP_KS = 34816;
__device__ __forceinline__ void retprep_unit(Frame& F, int l, int unit) {
    const bf16_t* P = (const bf16_t*)(F.ws + WS_P); bf16_t* RQKD = (bf16_t*)(F.ws + WS_RQKD); bf16_t* RKDT = (bf16_t*)(F.ws + WS_RKDT);
    LAS unsigned char* L = F.lds;
    const int tid = F.tid, lane = F.lane, wave = F.wave, rr = lane & 15, kg = lane >> 4;
    const int h = unit & 3, c = (unit >> 2) % RET_NCH, b = (unit >> 2) / RET_NCH, rbase = b * TOK + 128 * c;
    const size_t pu0 = (size_t)((b * RET_NCH + c) * 4 + h) * 2;
    const float lg0 = log_sigmoid_f(inp(F, I_ret_decay)[l * 8 + h]), lg1 = log_sigmoid_f(inp(F, I_ret_decay)[l * 8 + 4 + h]);
    { const int row = tid >> 2, seg = tid & 3; const bf16_t* src = P + (size_t)(rbase + row) * PW + h * 128 + seg * 32;
#pragma unroll
      for (int q = 0; q < 4; ++q) { *(LAS u32x4*)(L + RP_QS + row * 272 + seg * 64 + q * 16) = *(const u32x4*)(src + C_RQ + q * 8); *(LAS u32x4*)(L + RP_KS + row * 272 + seg * 64 + q * 16) = *(const u32x4*)(src + C_RK + q * 8); } }
    __syncthreads();
    { bf16x8 bQ[4];
#pragma unroll
      for (int ks = 0; ks < 4; ++ks) bQ[ks] = ldsfrag(L + RP_QS + (16 * wave + rr) * 272 + (32 * ks + 8 * kg) * 2);
      const int i = 16 * wave + rr;
      for (int jt = 0; jt < 8; ++jt) { f32x4 cc = {0.f, 0.f, 0.f, 0.f};
#pragma unroll
          for (int ks = 0; ks < 4; ++ks) cc = mfma16(ldsfrag(L + RP_KS + (16 * jt + rr) * 272 + (32 * ks + 8 * kg) * 2), bQ[ks], cc);
          const int jb = 16 * jt + 4 * kg; float v0[4], v1[4];
#pragma unroll
          for (int r = 0; r < 4; ++r) { const int j = jb + r; v0[r] = (j <= i) ? cc[r] * __expf((float)(i - j) * lg0) : 0.f; v1[r] = (j >= i) ? cc[r] * __expf((float)(j - i) * lg1) : 0.f; }
          u32x2 w; w.x = pk2(v0[0], v0[1]); w.y = pk2(v0[2], v0[3]); *(u32x2*)(RQKD + (pu0 + 0) * 16384 + i * 128 + jb) = w;
          w.x = pk2(v1[3], v1[2]); w.y = pk2(v1[1], v1[0]); *(u32x2*)(RQKD + (pu0 + 1) * 16384 + (127 - i) * 128 + (124 - jb)) = w; } }
    { const int d = tid >> 2, sg = tid & 3;
#pragma unroll
      for (int dir = 0; dir < 2; ++dir) { const float lg = dir ? lg1 : lg0;
#pragma unroll
          for (int q = 0; q < 4; ++q) { unsigned ow[4];
#pragma unroll
              for (int e = 0; e < 4; ++e) { const int j0 = 32 * sg + 8 * q + 2 * e, j1 = j0 + 1; const int t0 = dir ? 127 - j0 : j0, t1 = dir ? 127 - j1 : j1;
                  const float a0 = bf2f(*(const LAS bf16_t*)(L + RP_KS + t0 * 272 + d * 2)) * __expf((float)(127 - j0) * lg), a1 = bf2f(*(const LAS bf16_t*)(L + RP_KS + t1 * 272 + d * 2)) * __expf((float)(127 - j1) * lg);
                  ow[e] = pk2(a0, a1); }
              *(u32x4*)(RKDT + (pu0 + dir) * 16384 + d * 128 + 32 * sg + 8 * q) = (u32x4){ow[0], ow[1], ow[2], ow[3]}; } } }
    __syncthreads();
}

constexpr int RS_QS = 0, RS_QKD = 34816, RS_KDT = 69632, RS_VT = 104448, RS_SB = 113152;
__device__ __forceinline__ void retscan_unit(Frame& F, int l, int unit) {
    const bf16_t* P = (const bf16_t*)(F.ws + WS_P); const bf16_t* RQKD = (const bf16_t*)(F.ws + WS_RQKD); const bf16_t* RKDT = (const bf16_t*)(F.ws + WS_RKDT); float* ORET = (float*)(F.ws + WS_ORET);
    LAS unsigned char* L = F.lds;
    const int tid = F.tid, lane = F.lane, wave = F.wave, rr = lane & 15, kg = lane >> 4;
    const int sl = unit & 3, dir = (unit >> 2) & 1, h = (unit >> 3) & 3, b = unit >> 5;
    const float lg = log_sigmoid_f(inp(F, I_ret_decay)[l * 8 + dir * 4 + h]), gC = __expf(128.f * lg);
    f32x4 s[2]; s[0] = (f32x4){0.f, 0.f, 0.f, 0.f}; s[1] = s[0];
    for (int i = tid; i < 8704 / 4; i += NWAVES * 64) ((LAS unsigned*)(L + RS_SB))[i] = 0u;
    u32x4 rQ[4], rD[4], rK[4], rV;
#define RS_C(t) (dir ? ((t) < 2 ? 1 - (t) : 67 - (t)) : (t))
#define RS_LOAD(t) do { const int c_ = RS_C(t); const size_t pu_ = (size_t)((b * RET_NCH + c_) * 4 + h) * 2 + dir; const size_t rb_ = (size_t)b * TOK + 128 * c_; \
        _Pragma("unroll") for (int q_ = 0; q_ < 4; ++q_) { const int id_ = tid + 512 * q_, row_ = id_ >> 4, c16_ = id_ & 15; const int tok_ = dir ? 127 - row_ : row_; \
            rQ[q_] = *(const u32x4*)(P + (rb_ + tok_) * PW + C_RQ + h * 128 + c16_ * 8); rD[q_] = *(const u32x4*)(RQKD + pu_ * 16384 + row_ * 128 + c16_ * 8); rK[q_] = *(const u32x4*)(RKDT + pu_ * 16384 + row_ * 128 + c16_ * 8); } \
        { const int row_ = tid >> 2, tok_ = dir ? 127 - row_ : row_; rV = *(const u32x4*)(P + (rb_ + tok_) * PW + C_RV + h * 128 + sl * 32 + (tid & 3) * 8); } } while (0)
#define RS_STORE() do { _Pragma("unroll") for (int q_ = 0; q_ < 4; ++q_) { const int id_ = tid + 512 * q_, row_ = id_ >> 4, c16_ = id_ & 15; \
            *(LAS u32x4*)(L + RS_QS + row_ * 272 + c16_ * 16) = rQ[q_]; *(LAS u32x4*)(L + RS_QKD + row_ * 272 + c16_ * 16) = rD[q_]; *(LAS u32x4*)(L + RS_KDT + row_ * 272 + c16_ * 16) = rK[q_]; } \
        { const int row_ = tid >> 2, e0_ = (tid & 3) * 8; const unsigned vw_[4] = {rV.x, rV.y, rV.z, rV.w}; \
          _Pragma("unroll") for (int e_ = 0; e_ < 4; ++e_) { *(LAS bf16_t*)(L + RS_VT + (e0_ + 2 * e_) * 272 + row_ * 2) = (bf16_t)(vw_[e_] & 0xffffu); *(LAS bf16_t*)(L + RS_VT + (e0_ + 2 * e_ + 1) * 272 + row_ * 2) = (bf16_t)(vw_[e_] >> 16); } } } while (0)
    RS_LOAD(0); VM_WAIT(); RS_STORE();
    __syncthreads();
    for (int t = 0; t < RET_NCH; ++t) {
        const int c = RS_C(t);
        if (t + 1 < RET_NCH) RS_LOAD(t + 1);
        bf16x8 bV[2][4];
#pragma unroll
        for (int nt = 0; nt < 2; ++nt) { f32x4 a1 = {0.f, 0.f, 0.f, 0.f}, a2 = {0.f, 0.f, 0.f, 0.f};
#pragma unroll
            for (int ks = 0; ks < 4; ++ks) { bV[nt][ks] = ldsfrag(L + RS_VT + (16 * nt + rr) * 272 + (32 * ks + 8 * kg) * 2);
                a1 = mfma16(ldsfrag(L + RS_QS + (16 * wave + rr) * 272 + (32 * ks + 8 * kg) * 2), ldsfrag(L + RS_SB + (16 * nt + rr) * 272 + (32 * ks + 8 * kg) * 2), a1);
                a2 = mfma16(ldsfrag(L + RS_QKD + (16 * wave + rr) * 272 + (32 * ks + 8 * kg) * 2), bV[nt][ks], a2); }
#pragma unroll
            for (int r = 0; r < 4; ++r) { const int i = 16 * wave + 4 * kg + r, tok = dir ? 127 - i : i;
                ORET[((size_t)dir * MROWS + (size_t)(b * TOK + 128 * c + tok)) * 512 + h * 128 + sl * 32 + 16 * nt + rr] = a1[r] * __expf((float)(i + 1) * lg) + a2[r]; } }
#pragma unroll
        for (int et = 0; et < 2; ++et) { s[et] = s[et] * gC;
#pragma unroll
            for (int ks = 0; ks < 4; ++ks) s[et] = mfma16(ldsfrag(L + RS_KDT + (16 * wave + rr) * 272 + (32 * ks + 8 * kg) * 2), bV[et][ks], s[et]); }
        __syncthreads();
#pragma unroll
        for (int et = 0; et < 2; ++et) { u32x2 w; w.x = pk2(s[et][0], s[et][1]); w.y = pk2(s[et][2], s[et][3]); *(LAS u32x2*)(L + RS_SB + (16 * et + rr) * 272 + (16 * wave + 4 * kg) * 2) = w; }
        if (t + 1 < RET_NCH) { VM_WAIT(); RS_STORE(); }
        __syncthreads();
    }
#undef RS_C
#undef RS_LOAD
#undef RS_STORE
}

__device__ __forceinline__ void attention_phase(Frame& F, int l, bool keep_ctx) {
    const bf16_t* P = (const bf16_t*)(F.ws + WS_P); bf16_t* Y = (bf16_t*)(F.ws + WS_Y);
    unsigned* qhead = F.ctl + CW_ATTQ + 64 * l; volatile LAS unsigned* slot = F.MISC + 4;
    const unsigned nunits = 512u + (keep_ctx ? 16u : 0u);
    for (;;) {
        __syncthreads();
        if (F.tid == 0) *slot = __hip_atomic_fetch_add(qhead, 1u, __ATOMIC_RELAXED, __HIP_MEMORY_SCOPE_AGENT);
        __syncthreads();
        const unsigned idx = *slot;
        if (idx >= nunits) break;
        int hq, kvh, b, qrow0, seq;
        if (idx < 512u) { const int qb = idx & 31, g = (idx >> 5) & 3; kvh = (idx >> 7) & 1; b = idx >> 8; hq = kvh * 4 + g; qrow0 = b * TOK + CTXL + 256 * qb; seq = TOK; }
        else { const int j = idx - 512; hq = j & 7; b = j >> 3; kvh = hq >> 2; qrow0 = b * TOK; seq = CTXL; }
        const size_t krow0 = (size_t)b * TOK;
        att::attn_dense_body<att::bf16>((const att::bf16*)(P + (size_t)qrow0 * PW + C_AQ + hq * 128), (const att::bf16*)(P + krow0 * PW + C_AK + kvh * 128), (const att::bf16*)(P + krow0 * PW + C_AV + kvh * 128),
                                        Y + (size_t)qrow0 * YW + 1024 + hq * 128, seq, (char*)F.ldsg);
    }
}

__device__ __forceinline__ void mixepi_phase(Frame& F, int l, bool keep_ctx) {
    const bf16_t* P = (const bf16_t*)(F.ws + WS_P); bf16_t* Y = (bf16_t*)(F.ws + WS_Y); const float* ORET = (const float*)(F.ws + WS_ORET); const float* ODN = (const float*)(F.ws + WS_ODN);
    const int lane = F.lane, gw = F.vcu * NWAVES + F.wave, NGW = F.G * NWAVES, c0 = 8 * lane;
    const f32x4 nw0 = *(const f32x4*)(inp(F, I_dn_norm_w) + l * 128 + (c0 & 127)), nw1 = *(const f32x4*)(inp(F, I_dn_norm_w) + l * 128 + (c0 & 127) + 4);
    for (int r = gw; r < MROWS; r += NGW) {
        const int tp = r % TOK; if (!keep_ctx && tp < CTXL) continue;
#pragma unroll
        for (int grp = 0; grp < 2; ++grp) {
            const float* O = grp ? ODN : ORET;
            const f32x4 a0 = *(const f32x4*)(O + (size_t)r * 512 + c0), a1 = *(const f32x4*)(O + (size_t)r * 512 + c0 + 4), b0 = *(const f32x4*)(O + ((size_t)MROWS + r) * 512 + c0), b1 = *(const f32x4*)(O + ((size_t)MROWS + r) * 512 + c0 + 4);
            f32x4 o0 = a0 + b0, o1 = a1 + b1;
            float ss = (o0[0] * o0[0] + o0[1] * o0[1]) + (o0[2] * o0[2] + o0[3] * o0[3]) + (o1[0] * o1[0] + o1[1] * o1[1]) + (o1[2] * o1[2] + o1[3] * o1[3]);
            const float ri = rsqrtf(sum16(ss) * (1.f / 128.f) + EPS);
            o0 = o0 * ri; o1 = o1 * ri; if (grp) { o0 = o0 * nw0; o1 = o1 * nw1; }
            const u32x4 gz = *(const u32x4*)(P + (size_t)r * PW + (grp ? C_DZ : C_RG) + c0);
            u32x4 w; w.x = pk2(o0[0] * silu_f(bflo(gz.x)), o0[1] * silu_f(bfhi(gz.x))); w.y = pk2(o0[2] * silu_f(bflo(gz.y)), o0[3] * silu_f(bfhi(gz.y)));
            w.z = pk2(o1[0] * silu_f(bflo(gz.z)), o1[1] * silu_f(bfhi(gz.z))); w.w = pk2(o1[2] * silu_f(bflo(gz.w)), o1[3] * silu_f(bfhi(gz.w)));
            *(u32x4*)(Y + (size_t)r * YW + grp * 512 + c0) = w;
        }
    }
}
constexpr int NSTEPS = 2 + 10 * DEPTH;
#ifndef PH_MASK
#define PH_MASK 0xFFFFF
#endif
#define PH(k) (((PH_MASK) >> (k)) & 1)
struct Args { const float* in[21]; float* out; unsigned char* ws; int s_lo, s_hi; };
__global__ void __launch_bounds__(NWAVES * 64, 2) fwd(Args a) {
    extern __shared__ __attribute__((aligned(16))) unsigned char lds_raw[];
    Frame F;
    F.lds = (LAS unsigned char*)lds_raw; F.ldsg = lds_raw;
    F.MISC = (volatile LAS unsigned*)(F.lds + MISC_OFF);
    F.tid = threadIdx.x; F.lane = F.tid & 63; F.wave = __builtin_amdgcn_readfirstlane(F.tid >> 6);
    F.G = gridDim.x; { const int bx = blockIdx.x; F.vcu = (F.G % 8 == 0) ? (bx % 8) * (F.G / 8) + bx / 8 : bx; }
    F.ws = a.ws; F.ctl = (unsigned*)(a.ws + WS_CTL);
    for (int u = F.tid; u < (LDS_BYTES - RING_BYTES) / 4; u += NWAVES * 64) ((LAS unsigned*)(F.lds + RING_BYTES))[u] = 0u;
    __syncthreads();
    if (F.tid == 0) {
#define PUTP(k, p) do { const unsigned long long v_ = (unsigned long long)(p); F.MISC[16 + 2 * (k)] = (unsigned)v_; F.MISC[17 + 2 * (k)] = (unsigned)(v_ >> 32); } while (0)
        PUTP(0, a.in[0]); PUTP(1, a.in[1]); PUTP(2, a.in[2]); PUTP(3, a.in[3]); PUTP(4, a.in[4]); PUTP(5, a.in[5]); PUTP(6, a.in[6]); PUTP(7, a.in[7]); PUTP(8, a.in[8]); PUTP(9, a.in[9]); PUTP(10, a.in[10]);
        PUTP(11, a.in[11]); PUTP(12, a.in[12]); PUTP(13, a.in[13]); PUTP(14, a.in[14]); PUTP(15, a.in[15]); PUTP(16, a.in[16]); PUTP(17, a.in[17]); PUTP(18, a.in[18]); PUTP(19, a.in[19]); PUTP(20, a.in[20]); PUTP(21, a.out);
#undef PUTP
    }
    __syncthreads();
    XcdBarrier bar; bar.bar = F.ctl + CW_BAR; bar.x = 0; bar.st = nullptr;
    if (MK_ONE_LAUNCH) bar = xcd_barrier_post(F.ctl + CW_BAR, F.MISC + 8);
    const int lo = a.s_lo, hi = a.s_hi;
#define IN(k) (lo <= (k) && (k) < hi)
#define ENTER() do { F.tid = opaque_tid(); F.lane = F.tid & 63; F.wave = __builtin_amdgcn_readfirstlane(F.tid >> 6); F.ws = opaque_ptr(a.ws); F.ctl = (unsigned*)F.ws; } while (0)
#define SEAM(k) do { if (MK_ONE_LAUNCH && IN(k) && IN((k) + 1)) xcd_barrier(bar); } while (0)
#define Hb ((bf16_t*)(F.ws + WS_H))
#define Pb ((bf16_t*)(F.ws + WS_P))
#define Yb ((bf16_t*)(F.ws + WS_Y))
#define Xf ((float*)(F.ws + WS_X))
#define ABf ((float*)(F.ws + WS_AB))
#define MOD ((const float*)(F.ws + WS_MOD))

    if (PH(0) && IN(0)) { ENTER(); prologue_phase(F); }
    SEAM(0);
    if (PH(1) && IN(1)) { ENTER(); ln_mod_phase<0>(F, 0, false); }
    SEAM(1);
    for (int l = 0; l < DEPTH; ++l) {
        const int sb = 2 + 10 * l; if (sb + 10 <= lo || sb >= hi) continue;
        const bool keep_ctx = l < DEPTH - 1; const int skip = keep_ctx ? 0 : 1;
        if (PH(2) && IN(sb + 0)) { ENTER();
            pg8::Gemm g{Hb, (const bf16_t*)(F.ws + WS_WIN) + (size_t)l * PWPAD * DM, MROWS, PWPAD, DM}; pg8::RowOrder S; S.init(PWPAD / 256, F.G, (int)blockIdx.x, 0);
            pg8::EpiProj E{Pb, ABf};
            pg8::gemm_phase<pg8::EpiProj, pg8::RowOrder, true, true>(F.lds, g, S, E);
        }
        SEAM(sb + 0);
        if (PH(3) && IN(sb + 1)) { ENTER(); rowprep_phase(F, l); }
        SEAM(sb + 1);
        if (IN(sb + 2)) {
            if (PH(4)) { ENTER(); for (int u = F.vcu; u < NBATCH * DN_NCH * 4; u += F.G) dnprep_unit(F, u); }
            if (PH(13)) { ENTER(); for (int u = F.G - 1 - F.vcu; u < NBATCH * RET_NCH * 4; u += F.G) retprep_unit(F, l, u); }
        }
        SEAM(sb + 2);
        if (IN(sb + 3)) {
            if (PH(5)) { ENTER(); for (int u = (int)blockIdx.x; u < 64; u += F.G) dnscan_unit(F, u); }
            if (PH(14)) { ENTER(); for (int u = (int)blockIdx.x - 64; u < 64; u += F.G) { if (u >= 0) retscan_unit(F, l, u); } }
            if (PH(6)) { ENTER(); attention_phase(F, l, keep_ctx); }
        }
        SEAM(sb + 3);
        if (PH(7) && IN(sb + 4)) { ENTER(); mixepi_phase(F, l, keep_ctx); }
        SEAM(sb + 4);
        if (PH(8) && IN(sb + 5)) { ENTER();
            pg8::Gemm g{Yb, (const bf16_t*)(F.ws + WS_WO) + (size_t)l * DM * DM, MROWS, DM, DM}; pg8::RowOrder S; S.init(DM / 256, F.G, (int)blockIdx.x, skip);
            pg8::EpiResid E{Xf, MOD + (size_t)(l * 3) * 12288 + 2 * DM, ALPHA};
            pg8::gemm_phase<pg8::EpiResid, pg8::RowOrder, true, true>(F.lds, g, S, E);
        }
        SEAM(sb + 5);
        if (PH(9) && IN(sb + 6)) { ENTER(); ln_mod_phase<1>(F, l, !keep_ctx); }
        SEAM(sb + 6);
        if (PH(10) && IN(sb + 7)) { ENTER();
            pg8::Gemm g{Hb, (const bf16_t*)(F.ws + WS_WFI) + (size_t)l * 2 * DFF * DM, MROWS, 2 * DFF, DM}; pg8::RowOrder S; S.init(2 * DFF / 256, F.G, (int)blockIdx.x, skip);
            pg8::EpiSwiglu E{Pb};
            pg8::gemm_phase<pg8::EpiSwiglu, pg8::RowOrder, true, true>(F.lds, g, S, E);
        }
        SEAM(sb + 7);
        if (PH(11) && IN(sb + 8)) { ENTER();
            pg8::Gemm g{Pb, (const bf16_t*)(F.ws + WS_WFO) + (size_t)l * DM * DFF, MROWS, DM, DFF}; pg8::RowOrder S; S.init(DM / 256, F.G, (int)blockIdx.x, skip);
            pg8::EpiResid E{Xf, MOD + (size_t)(l * 3) * 12288 + 5 * DM, ALPHA};
            pg8::gemm_phase<pg8::EpiResid, pg8::RowOrder, true, true>(F.lds, g, S, E);
        }
        SEAM(sb + 8);
        if (PH(12) && IN(sb + 9)) { ENTER(); if (keep_ctx) ln_mod_phase<2>(F, l, false); else ln_mod_phase<3>(F, l, true); }
        SEAM(sb + 9);
    }
#undef IN
#undef SEAM
#undef ENTER
#undef Hb
#undef Pb
#undef Yb
#undef Xf
#undef ABf
#undef MOD
}

extern "C" void kernel_launch(void* const* d_in, const int* in_sizes, int n_in, void* d_out, int out_size, void* d_ws, size_t ws_size, hipStream_t stream) {
    static int grid = 0;
    if (grid == 0) {
        if (n_in != 21 || in_sizes[0] != NBATCH * SEQ * DM || out_size != NBATCH * SEQ * DM || ws_size < WS_END) {
            fprintf(stderr, "kernel_launch: shape mismatch: n_in %d in0 %d out %d ws %zu (need >= %zu)\n", n_in, n_in > 0 ? in_sizes[0] : -1, out_size, ws_size, (size_t)WS_END); grid = -1; return; }
        int dev = 0, cus = 0, per_cu = 0;
        if (hipGetDevice(&dev) != hipSuccess || hipDeviceGetAttribute(&cus, hipDeviceAttributeMultiprocessorCount, dev) != hipSuccess) { fprintf(stderr, "kernel_launch: device query failed\n"); grid = -1; return; }
        if (hipFuncSetAttribute((const void*)fwd, hipFuncAttributeMaxDynamicSharedMemorySize, LDS_BYTES) != hipSuccess) { fprintf(stderr, "kernel_launch: hipFuncSetAttribute failed\n"); grid = -1; return; }
        if (hipOccupancyMaxActiveBlocksPerMultiprocessor(&per_cu, (const void*)fwd, NWAVES * 64, LDS_BYTES) != hipSuccess || per_cu < 1)
            fprintf(stderr, "kernel_launch: note: occupancy query reports %d workgroups per CU\n", per_cu);
        (void)hipGetLastError();
        grid = cus;
    }
    if (grid < 0) return;
    if (hipMemsetAsync((char*)d_ws + WS_CTL, 0, CTL_ZERO_BYTES, stream) != hipSuccess) { fprintf(stderr, "kernel_launch: memset failed\n"); return; }
    Args a{};
    for (int i = 0; i < 21; ++i) a.in[i] = (const float*)d_in[i];
    a.out = (float*)d_out; a.ws = (unsigned char*)d_ws;
#if MK_ONE_LAUNCH
    a.s_lo = 0; a.s_hi = NSTEPS;
    hipLaunchKernelGGL(fwd, dim3(grid), dim3(NWAVES * 64), LDS_BYTES, stream, a);
#else
    for (int s = 0; s < NSTEPS; ++s) { a.s_lo = s; a.s_hi = s + 1; hipLaunchKernelGGL(fwd, dim3(grid), dim3(NWAVES * 64), LDS_BYTES, stream, a); }
#endif
    const hipError_t le = hipPeekAtLastError();
    if (le != hipSuccess) fprintf(stderr, "kernel_launch: launch failed: %s\n", hipGetErrorName(le));
}
```

```cpp
#include <hip/hip_runtime.h>
#include <hip/hip_bf16.h>
#include <cstdio>
#include <cstdint>

#ifndef MK_ONE_LAUNCH
#define MK_ONE_LAUNCH 1
#endif

constexpr int DM = 2048, NBATCH = 2, SEQ = 8192, CTXL = 256, TOK = CTXL + SEQ  , MROWS = NBATCH * TOK  , DEPTH = 4;
constexpr int HD = 128, DFF = 5632, PW = 5632  , PWPAD = 5888, PROJ_SRC = 5648;
constexpr int C_RQ = 0, C_RK = 512, C_RV = 1024, C_RG = 1536, C_DQKV = 2048, C_DZ = 3584, C_AQ = 4096, C_AK = 5120, C_AV = 5376;
constexpr int YW = 2048;
constexpr float ALPHA = 1.6817928305074292f;
constexpr float EPS = 1e-6f;
constexpr int DN_NCH = TOK / 64  , RET_NCH = TOK / 128  ;
constexpr int DN_PU = NBATCH * DN_NCH * 4 * 2  , RET_PU = NBATCH * RET_NCH * 4 * 2  ;

constexpr size_t MiB = 1u << 20;
constexpr size_t WS_CTL = 0, CTL_ZERO_BYTES = 1 * MiB;
constexpr size_t WS_MOD = 1 * MiB;
constexpr size_t WS_WIN = 2 * MiB;
constexpr size_t WS_WO = 94 * MiB;
constexpr size_t WS_WFI = 126 * MiB;
constexpr size_t WS_WFO = 302 * MiB;
constexpr size_t WS_X = 390 * MiB;
constexpr size_t WS_H = 522 * MiB;
constexpr size_t WS_P = 588 * MiB;
constexpr size_t WS_AB = 770 * MiB;
constexpr size_t WS_Y = 772 * MiB;
constexpr size_t WS_DQ = 838 * MiB;
constexpr size_t WS_DNW = 888 * MiB, WS_DNKC = 921 * MiB, WS_DNQG = 954 * MiB, WS_DNKGT = 987 * MiB;
constexpr size_t WS_DNQK = 1020 * MiB;
constexpr size_t WS_DNGL = 1037 * MiB;
constexpr size_t WS_ODN = 1038 * MiB;
constexpr size_t WS_ORET = 1104 * MiB;
constexpr size_t WS_RQKD = 1170 * MiB, WS_RKDT = 1203 * MiB;
constexpr size_t WS_OPART = 1236 * MiB;
constexpr size_t WS_ASTAT = 1302 * MiB;
constexpr size_t WS_LNS = 1305 * MiB;
constexpr size_t WS_END = 1306 * MiB;
static_assert(WS_WIN + (size_t)DEPTH * PWPAD * DM * 2 <= WS_WO && WS_WO + (size_t)DEPTH * DM * DM * 2 <= WS_WFI && WS_WFI + (size_t)DEPTH * 2 * DFF * DM * 2 <= WS_WFO && WS_WFO + (size_t)DEPTH * DM * DFF * 2 <= WS_X, "ws map (weights)");
static_assert(WS_X + (size_t)MROWS * DM * 4 <= WS_H && WS_H + (size_t)MROWS * DM * 2 <= WS_P && WS_P + (size_t)MROWS * PW * 2 <= WS_AB && WS_AB + (size_t)MROWS * 64 <= WS_Y && WS_Y + (size_t)MROWS * YW * 2 <= WS_DQ && WS_DQ + (size_t)MROWS * 1536 * 2 <= WS_DNW, "ws map (activations)");
static_assert(WS_DNW + (size_t)DN_PU * 16384 <= WS_DNKC && WS_DNQK + (size_t)DN_PU * 8192 <= WS_DNGL && WS_ODN + (size_t)2 * MROWS * 512 * 4 <= WS_ORET && WS_ORET + (size_t)2 * MROWS * 512 * 4 <= WS_RQKD && WS_RQKD + (size_t)RET_PU * 32768 <= WS_RKDT && WS_RKDT + (size_t)RET_PU * 32768 <= WS_END, "ws map (mixers)");
constexpr int CW_BAR = 4096;
constexpr int CW_ATTQ = 16384;

constexpr int RING_BYTES = 143360;
constexpr int MISC_OFF = RING_BYTES + 320;
constexpr int LDS_BYTES = 147456;
constexpr int NWAVES = 8;

#define GAS __attribute__((address_space(1)))
#define LAS __attribute__((address_space(3)))
typedef unsigned short bf16_t;
typedef short bf16x8 __attribute__((ext_vector_type(8)));
typedef short s16x4 __attribute__((ext_vector_type(4)));
typedef float f32x4 __attribute__((ext_vector_type(4)));
typedef float f32x2 __attribute__((ext_vector_type(2)));
typedef unsigned u32x4 __attribute__((ext_vector_type(4)));
typedef unsigned u32x2 __attribute__((ext_vector_type(2)));
#define LDS_WAIT() asm volatile("s_waitcnt lgkmcnt(0)" ::: "memory")
#define VM_WAIT() asm volatile("s_waitcnt vmcnt(0)" ::: "memory")
typedef float f32x2_cv __attribute__((ext_vector_type(2))); typedef __bf16 bf16x2_cv __attribute__((ext_vector_type(2)));
__device__ __forceinline__ unsigned pk2(float lo, float hi) { const bf16x2_cv r = __builtin_convertvector((f32x2_cv){lo, hi}, bf16x2_cv); return __builtin_bit_cast(unsigned, r); }
__device__ __forceinline__ unsigned f2bf(float f) { return pk2(f, 0.f) & 0xffffu; }
__device__ __forceinline__ float bf2f(unsigned short b) { return __builtin_bit_cast(float, ((unsigned)b) << 16); }
__device__ __forceinline__ float bflo(unsigned w) { return __builtin_bit_cast(float, w << 16); }
__device__ __forceinline__ float bfhi(unsigned w) { return __builtin_bit_cast(float, w & 0xffff0000u); }
__device__ __forceinline__ int opaque_tid() { int t = (int)threadIdx.x; asm volatile("" : "+v"(t)); return t; }
__device__ __forceinline__ unsigned char* opaque_ptr(unsigned char* p) { unsigned long long v = (unsigned long long)p; asm volatile("" : "+s"(v)); return (unsigned char*)(GAS unsigned char*)v; }
__device__ __forceinline__ float wave_sum(float v) {
#pragma unroll
    for (int o = 1; o < 64; o <<= 1) v += __shfl_xor(v, o);
    return v;
}
__device__ __forceinline__ float sum16(float v) { v += __shfl_xor(v, 1); v += __shfl_xor(v, 2); v += __shfl_xor(v, 4); v += __shfl_xor(v, 8); return v; }
__device__ __forceinline__ float silu_f(float x) { return x * __builtin_amdgcn_rcpf(1.f + __expf(-x)); }
__device__ __forceinline__ f32x4 mfma16(bf16x8 a, bf16x8 b, f32x4 c) { return __builtin_amdgcn_mfma_f32_16x16x32_bf16(a, b, c, 0, 0, 0); }
__device__ __forceinline__ bf16x8 ldsfrag(const LAS unsigned char* p) { return *(const LAS bf16x8*)p; }

#define XB_TMO      128
#define XB_XCNT(j)  (256  + 64 * (j))
#define XB_XSUB(j)  (1280 + 64 * (j))
#define XB_XGEN(j)  (2304 + 64 * (j))
#define XB_TOP      3328
#define XB_TOPGEN   3392
#define XCD_BAR_WORDS 3456
#define XB_SPIN_CAP (1u << 18)
__device__ __forceinline__ unsigned xb_ld(unsigned* p)              { return __hip_atomic_load(p, __ATOMIC_RELAXED, __HIP_MEMORY_SCOPE_AGENT); }
__device__ __forceinline__ unsigned xb_add(unsigned* p, unsigned v) { return __hip_atomic_fetch_add(p, v, __ATOMIC_RELAXED, __HIP_MEMORY_SCOPE_AGENT); }
__device__ __forceinline__ unsigned xb_xcc_id() { return (unsigned)__builtin_amdgcn_s_getreg((3 << 11) | 20) & 0xFu; }
#define XB_SPIN(cond, bar) do { unsigned _sp = 0; while (cond) { __builtin_amdgcn_s_sleep(1); \
    if ((++_sp & 255u) == 0u) { if (xb_ld(&(bar)[XB_TMO])) break; if (_sp > XB_SPIN_CAP) { atomicAdd(&(bar)[XB_TMO], 1u); break; } } } } while (0)
struct XcdBarrier { unsigned* bar; unsigned x; volatile LAS unsigned* st; };
__device__ __forceinline__ XcdBarrier xcd_barrier_post(unsigned* bar, volatile LAS unsigned* st) {
    XcdBarrier b; b.bar = bar; b.x = xb_xcc_id(); b.st = st;
    if (threadIdx.x == 0) (void)xb_add(&bar[XB_XCNT(b.x)], 1u);
    return b;
}
__device__ __forceinline__ void xcd_barrier_complete(unsigned* bar, unsigned x, unsigned& nloc, unsigned& nx) {
    const unsigned G = gridDim.x * gridDim.y * gridDim.z;
    unsigned sum, cnt, mine, sp = 0u;
    for (;;) {
        sum = 0u; cnt = 0u; mine = 0u;
#pragma unroll
        for (unsigned j = 0; j < 16; ++j) { const unsigned c = xb_ld(&bar[XB_XCNT(j)]); sum += c; cnt += (c > 0u) ? 1u : 0u; mine = (j == x) ? c : mine; }
        if (sum == G) break;
        __builtin_amdgcn_s_sleep(1);
        if ((++sp & 255u) == 0u) { if (xb_ld(&bar[XB_TMO])) break; if (sp > XB_SPIN_CAP) { atomicAdd(&bar[XB_TMO], 1u); break; } }
    }
    nloc = mine > 0u ? mine : 1u; nx = cnt > 0u ? cnt : 1u;
}
__device__ __forceinline__ void xcd_barrier(const XcdBarrier& b) {
    asm volatile("s_waitcnt vmcnt(0)" ::: "memory");
    __syncthreads();
    if (threadIdx.x == 0) {
        unsigned* bar = b.bar;
        __builtin_amdgcn_s_waitcnt(0);
        unsigned nloc = b.st[0], nx = b.st[1];
        if (nloc == 0u) { xcd_barrier_complete(bar, b.x, nloc, nx); b.st[0] = nloc; b.st[1] = nx; }
        const unsigned old = xb_add(&bar[XB_XSUB(b.x)], 1u);
        const unsigned gen = old / nloc;
        if (old + 1u == (gen + 1u) * nloc) {
            __builtin_amdgcn_fence(__ATOMIC_RELEASE, "agent");
            asm volatile("s_waitcnt vmcnt(0)" ::: "memory");
            const unsigned og = xb_add(&bar[XB_TOP], 1u);
            const unsigned tg = og / nx;
            if (og + 1u == (tg + 1u) * nx) xb_add(&bar[XB_TOPGEN], 1u);
            else XB_SPIN(xb_ld(&bar[XB_TOPGEN]) == tg, bar);
            __builtin_amdgcn_fence(__ATOMIC_ACQUIRE, "agent");
            xb_add(&bar[XB_XGEN(b.x)], 1u);
            asm volatile("s_waitcnt vmcnt(0)" ::: "memory");
        } else {
            XB_SPIN(xb_ld(&bar[XB_XGEN(b.x)]) == gen, bar);
            __builtin_amdgcn_fence(__ATOMIC_ACQUIRE, "agent");
            asm volatile("s_waitcnt vmcnt(0)" ::: "memory");
        }
    }
    __syncthreads();
}
namespace pg8 {
#define PG8_LAS __attribute__((address_space(3)))
typedef unsigned short bf16_t;
typedef short bf16x8 __attribute__((ext_vector_type(8)));
typedef float f32x4 __attribute__((ext_vector_type(4)));
typedef unsigned u32x4 __attribute__((ext_vector_type(4)));
constexpr int BM = 256, BK = 64, HALF = 128, HTB = HALF * BK * 2  , STAGE_BYTES = 8 * HTB, NXCD = 8, WGM = 8;

__host__ __device__ __forceinline__ int lds_byte(int r, int c) { const int st = (r >> 4) * 2 + (c >> 5), rr = r & 15, cc = c & 31, ob = rr * 64 + cc * 2; return st * 1024 + (ob ^ (((ob >> 9) & 1) << 5)); }
__host__ __device__ __forceinline__ void stage_rc(int b, int& R, int& C) { const int st = b / 1024, sb = b % 1024, swz = sb ^ (((sb >> 9) & 1) << 5); R = (st >> 1) * 16 + swz / 64; C = (st & 1) * 32 + (swz % 64) / 2; }
__host__ __device__ __forceinline__ int perm32(int rho) { const int n = rho >> 4, i = rho & 15; return 8 * (i >> 2) + 4 * n + (i & 3); }

struct Unit { int pm, pn; };
struct Gemm { const bf16_t* A; const bf16_t* Bt; int M, N, K; };

struct StaticOrder {
    int nM, nN, nwg, G, c;
    __host__ __device__ void init(int M, int N, int G_, int c_) { nM = M / BM; nN = N / BM; nwg = nM * nN; G = G_; c = c_; }
    __host__ __device__ bool next(int i, Unit& u) const {
        const long L = (long)i * G + c; if (L >= nwg) return false;
        int wgid = (int)L; { const int q = nwg / NXCD, r = nwg % NXCD, xcd = wgid % NXCD, off = wgid / NXCD; wgid = (xcd < r ? xcd * (q + 1) : r * (q + 1) + (xcd - r) * q) + off; }
        const int nig = WGM * nN, gid = wgid / nig, fm = gid * WGM, gsz = (nM - fm) < WGM ? (nM - fm) : WGM;
        u.pm = fm + ((wgid % nig) % gsz); u.pn = (wgid % nig) / gsz; return true;
    }
    __device__ __forceinline__ void a_ready(const Unit&) const {}
    __device__ __forceinline__ void done(const Unit&) const {}
};

__device__ __forceinline__ unsigned cvt_pk_bf16(float lo, float hi) { return ::pk2(lo, hi); }
typedef float f32x2 __attribute__((ext_vector_type(2)));
struct RowOrder {
    int nM, nN, nwg, G, c, skip;
    __device__ __forceinline__ void init(int nN_, int G_, int c_, int skip_) { skip = skip_; nM = skip_ ? 64 : 66; nN = nN_; nwg = nM * nN; G = G_; c = c_; }
    __device__ __forceinline__ bool next(int i, Unit& u) const {
        const long L = (long)i * G + c; if (L >= nwg) return false;
        int wgid = (int)L; { const int q = nwg / NXCD, r = nwg % NXCD, xcd = wgid % NXCD, off = wgid / NXCD; wgid = (xcd < r ? xcd * (q + 1) : r * (q + 1) + (xcd - r) * q) + off; }
        const int nig = WGM * nN, gid = wgid / nig, fm = gid * WGM, gsz = (nM - fm) < WGM ? (nM - fm) : WGM;
        int pm = fm + ((wgid % nig) % gsz); u.pn = (wgid % nig) / gsz;
        if (skip) pm = pm + 1 + (pm >= 32 ? 1 : 0);
        u.pm = pm; return true;
    }
    __device__ __forceinline__ void a_ready(const Unit&) const {}
    __device__ __forceinline__ void done(const Unit&) const {}
};
struct EpiProj {
    static constexpr bool PERM = true, AFTER_DRAIN = false;
    bf16_t* P; float* AB;
    __device__ __forceinline__ void operator()(const f32x4 (&acc)[2][2][4][2], const Unit& u, int wr, int wc, int fr, int fq) const {
        const int row0 = u.pm * BM + wr * 64 + fr;
        if (u.pn < 22) {
            const int col0 = u.pn * BM + wc * 32 + 8 * fq;
#pragma unroll
            for (int ai = 0; ai < 2; ++ai)
#pragma unroll
                for (int m = 0; m < 4; ++m) { bf16_t* rowp = P + (size_t)(row0 + ai * HALF + m * 16) * 5632 + col0;
#pragma unroll
                    for (int bj = 0; bj < 2; ++bj) { const f32x4 v0 = acc[ai][bj][m][0], v1 = acc[ai][bj][m][1];
                        u32x4 w; w.x = cvt_pk_bf16(v0[0], v0[1]); w.y = cvt_pk_bf16(v0[2], v0[3]); w.z = cvt_pk_bf16(v1[0], v1[1]); w.w = cvt_pk_bf16(v1[2], v1[3]);
                        *(u32x4*)(rowp + bj * HALF) = w; } }
        } else if (wc == 0 && fq < 2) {
#pragma unroll
            for (int ai = 0; ai < 2; ++ai)
#pragma unroll
                for (int m = 0; m < 4; ++m) { float* rp = AB + (size_t)(row0 + ai * HALF + m * 16) * 16 + 8 * fq;
                    *(f32x4*)rp = acc[ai][0][m][0]; *(f32x4*)(rp + 4) = acc[ai][0][m][1]; }
        }
    }
};
struct EpiResid {
    static constexpr bool PERM = false, AFTER_DRAIN = false;
    float* X; const float* gate; float alpha; const float* stats; const float* lnw; const float* lnb; int ln;
    __device__ __forceinline__ void operator()(const f32x4 (&acc)[2][2][4][2], const Unit& u, int wr, int wc, int fr, int fq) const {
        const int s = (u.pm % 33 == 0) ? 2 : u.pm / 33; const float* g = gate + (size_t)s * 12288;
        const int row0 = u.pm * BM + wr * 64 + fr, col0 = u.pn * BM + wc * 32 + 4 * fq;
        f32x2 st[2][4];
#pragma unroll
        for (int ai = 0; ai < 2; ++ai)
#pragma unroll
            for (int m = 0; m < 4; ++m) st[ai][m] = ln ? *(const f32x2*)(stats + (size_t)(row0 + ai * HALF + m * 16) * 2) : (f32x2){0.f, 1.f};
#pragma unroll
        for (int bj = 0; bj < 2; ++bj)
#pragma unroll
            for (int n = 0; n < 2; ++n) { const int cc = col0 + bj * HALF + n * 16; const f32x4 gv = *(const f32x4*)(g + cc);
                const f32x4 w4 = ln ? *(const f32x4*)(lnw + cc) : (f32x4){1.f, 1.f, 1.f, 1.f}, b4 = ln ? *(const f32x4*)(lnb + cc) : (f32x4){0.f, 0.f, 0.f, 0.f};
#pragma unroll
                for (int ai = 0; ai < 2; ++ai) { f32x4 xr[4];
#pragma unroll
                    for (int m = 0; m < 4; ++m) xr[m] = *(const f32x4*)(X + (size_t)(row0 + ai * HALF + m * 16) * 2048 + cc);
                    asm volatile("" ::: "memory");
#pragma unroll
                    for (int m = 0; m < 4; ++m) { const f32x4 xl = (xr[m] - st[ai][m].x) * st[ai][m].y * w4 + b4;
                        *(f32x4*)(X + (size_t)(row0 + ai * HALF + m * 16) * 2048 + cc) = xl * alpha + gv * acc[ai][bj][m][n]; }
                    asm volatile("" ::: "memory"); } }
    }
};
__device__ __forceinline__ float silu_mul(float g, float u) { return g * u * __builtin_amdgcn_rcpf(1.f + __expf(-g)); }
struct EpiSwiglu {
    static constexpr bool PERM = true, AFTER_DRAIN = false;
    bf16_t* G;
    __device__ __forceinline__ void operator()(const f32x4 (&acc)[2][2][4][2], const Unit& u, int wr, int wc, int fr, int fq) const {
        const int row0 = u.pm * BM + wr * 64 + fr, col0 = u.pn * HALF + wc * 32 + 8 * fq;
#pragma unroll
        for (int ai = 0; ai < 2; ++ai)
#pragma unroll
            for (int m = 0; m < 4; ++m) { bf16_t* rowp = G + (size_t)(row0 + ai * HALF + m * 16) * 5632 + col0;
                const f32x4 g0 = acc[ai][0][m][0], g1 = acc[ai][0][m][1], u0 = acc[ai][1][m][0], u1 = acc[ai][1][m][1];
                u32x4 w; w.x = cvt_pk_bf16(silu_mul(g0[0], u0[0]), silu_mul(g0[1], u0[1])); w.y = cvt_pk_bf16(silu_mul(g0[2], u0[2]), silu_mul(g0[3], u0[3]));
                w.z = cvt_pk_bf16(silu_mul(g1[0], u1[0]), silu_mul(g1[1], u1[1])); w.w = cvt_pk_bf16(silu_mul(g1[2], u1[2]), silu_mul(g1[3], u1[3]));
                *(u32x4*)rowp = w; }
    }
};
template <class Epi, class Sched, bool ALIGN_EPI = false, bool SP2 = false>
__device__ __forceinline__ void gemm_phase(PG8_LAS unsigned char* lds, const Gemm g, const Sched& S, const Epi& E) {
    const int tid = opaque_tid(), wid = __builtin_amdgcn_readfirstlane(tid >> 6), lane = tid & 63, wr = wid >> 2, wc = wid & 3, fr = lane & 15, fq = lane >> 4;
    const int K = g.K, nt = K / BK;
    unsigned voffA[2], voffB[2];
#pragma unroll
    for (int i = 0; i < 2; ++i) { int R, C; stage_rc(tid * 16 + i * 8192, R, C); const int Rb = Epi::PERM ? ((R & ~31) + perm32(R & 31)) : R;
        voffA[i] = (unsigned)(R * K + C) * 2u; voffB[i] = (unsigned)(Rb * K + C) * 2u; }
    const size_t kstep = (size_t)(BK * 2);
    const size_t hstep = (size_t)HALF * K * 2;
    const size_t tstep = 2 * hstep;
    const unsigned ldsw = (unsigned)wid * 1024u;
    const int aoff = lds_byte(wr * 64 + fr, fq * 8), boff = lds_byte(wc * 32 + fr, fq * 8);
#define PG8_SA(b, h) (((b) * 2 + (h)) * HTB)
#define PG8_SB(b, h) ((4 + (b) * 2 + (h)) * HTB)
#define PG8_STAGE(bufoff, gbase, voff) do { _Pragma("unroll") for (int _i = 0; _i < 2; ++_i) \
        __builtin_amdgcn_global_load_lds((const unsigned*)((const char*)(gbase) + (voff)[_i]), (PG8_LAS unsigned*)(lds + (bufoff) + ldsw + _i * 8192), 16, 0, 0); } while (0)
#define PG8_LDA(dst, b, h) do { _Pragma("unroll") for (int m = 0; m < 4; ++m) _Pragma("unroll") for (int k = 0; k < 2; ++k) dst[m][k] = *(const PG8_LAS bf16x8*)(lds + PG8_SA(b, h) + aoff + m * 2048 + k * 1024); } while (0)
#define PG8_LDB(dst, b, h) do { _Pragma("unroll") for (int n = 0; n < 2; ++n) _Pragma("unroll") for (int k = 0; k < 2; ++k) dst[n][k] = *(const PG8_LAS bf16x8*)(lds + PG8_SB(b, h) + boff + n * 2048 + k * 1024); } while (0)
#define PG8_MMA(ai, bj, At, Bt) do { __builtin_amdgcn_s_setprio(1); _Pragma("unroll") for (int m = 0; m < 4; ++m) _Pragma("unroll") for (int n = 0; n < 2; ++n) _Pragma("unroll") for (int k = 0; k < 2; ++k) \
        acc[ai][bj][m][n] = __builtin_amdgcn_mfma_f32_16x16x32_bf16(Bt[n][k], At[m][k], acc[ai][bj][m][n], 0, 0, 0); __builtin_amdgcn_s_setprio(0); } while (0)
#define PG8_WAIT_V(n) asm volatile("s_waitcnt vmcnt(" #n ")" ::: "memory")
#define PG8_WAIT_L(n) asm volatile("s_waitcnt lgkmcnt(" #n ")" ::: "memory")
#define PG8_BAR __builtin_amdgcn_s_barrier()
#define PG8_SCHED __builtin_amdgcn_sched_barrier(0)
    Unit cur, nxt; int ui = 0;
    if (!S.next(0, cur)) return;
    f32x4 acc[2][2][4][2];
#pragma unroll
    for (int a = 0; a < 2; ++a)
#pragma unroll
        for (int b = 0; b < 2; ++b)
#pragma unroll
            for (int m = 0; m < 4; ++m)
#pragma unroll
                for (int n = 0; n < 2; ++n) acc[a][b][m][n] = (f32x4){0.f, 0.f, 0.f, 0.f};
    bf16x8 At[4][2], B0[2][2], B1[2][2];
    const char* cA = (const char*)g.A + (size_t)cur.pm * tstep; const char* cB = (const char*)g.Bt + (size_t)cur.pn * tstep;
    S.a_ready(cur);
    if constexpr (SP2) {
        PG8_STAGE(PG8_SB(0, 0), cB, voffB); PG8_STAGE(PG8_SB(0, 1), cB + hstep, voffB); PG8_STAGE(PG8_SA(0, 0), cA, voffA); PG8_STAGE(PG8_SA(0, 1), cA + hstep, voffA);
        if (wr == 1) PG8_BAR;
        PG8_WAIT_V(2); PG8_BAR;
        PG8_STAGE(PG8_SB(1, 0), cB + kstep, voffB); PG8_STAGE(PG8_SA(1, 0), cA + kstep, voffA); PG8_STAGE(PG8_SB(1, 1), cB + hstep + kstep, voffB);
        PG8_WAIT_V(6); PG8_BAR;
    } else {
        PG8_STAGE(PG8_SB(0, 0), cB, voffB); PG8_STAGE(PG8_SA(0, 0), cA, voffA); PG8_STAGE(PG8_SB(0, 1), cB + hstep, voffB); PG8_STAGE(PG8_SA(0, 1), cA + hstep, voffA);
        if (wr == 1) PG8_BAR;
        PG8_WAIT_V(4); PG8_BAR;
        PG8_STAGE(PG8_SB(1, 0), cB + kstep, voffB); PG8_STAGE(PG8_SA(1, 0), cA + kstep, voffA); PG8_STAGE(PG8_SB(1, 1), cB + hstep + kstep, voffB);
        PG8_WAIT_V(6); PG8_BAR;
    }
    for (;;) {
        const bool has_next = S.next(ui + 1, nxt);
        const char* nA = has_next ? (const char*)g.A + (size_t)nxt.pm * tstep : cA; const char* nB = has_next ? (const char*)g.Bt + (size_t)nxt.pn * tstep : cB;
        for (int t = 0; t < nt; t += 2) {
            const bool last = (t == nt - 2);
            const char* a1 = cA + (size_t)(t + 1) * kstep;
            const char* a2 = last ? nA : cA + (size_t)(t + 2) * kstep; const char* b2 = last ? nB : cB + (size_t)(t + 2) * kstep;
            const char* a3 = a2 + kstep; const char* b3 = b2 + kstep;
            if (last && has_next) S.a_ready(nxt);
            if constexpr (SP2) {
            PG8_LDB(B0, 0, 0); PG8_LDB(B1, 0, 1); PG8_SCHED; PG8_LDA(At, 0, 0); PG8_STAGE(PG8_SA(1, 1), a1 + hstep, voffA);
            PG8_WAIT_V(8); PG8_WAIT_L(0); PG8_BAR; PG8_MMA(0, 0, At, B0); PG8_MMA(0, 1, At, B1); PG8_BAR; PG8_SCHED;
            PG8_LDA(At, 0, 1); PG8_STAGE(PG8_SB(0, 0), b2, voffB); PG8_STAGE(PG8_SB(0, 1), b2 + hstep, voffB); PG8_STAGE(PG8_SA(0, 0), a2, voffA);
            PG8_WAIT_V(8); PG8_WAIT_L(0); PG8_BAR; PG8_MMA(1, 0, At, B0); PG8_MMA(1, 1, At, B1); PG8_BAR; PG8_SCHED;
            PG8_LDB(B0, 1, 0); PG8_LDB(B1, 1, 1); PG8_SCHED; PG8_LDA(At, 1, 0); PG8_STAGE(PG8_SA(0, 1), a2 + hstep, voffA);
            PG8_WAIT_V(8); PG8_WAIT_L(0); PG8_BAR; PG8_MMA(0, 0, At, B0); PG8_MMA(0, 1, At, B1); PG8_BAR; PG8_SCHED;
            PG8_LDA(At, 1, 1); PG8_STAGE(PG8_SB(1, 0), b3, voffB); PG8_STAGE(PG8_SB(1, 1), b3 + hstep, voffB); PG8_STAGE(PG8_SA(1, 0), a3, voffA);
            PG8_WAIT_V(8); PG8_WAIT_L(0); PG8_BAR; PG8_MMA(1, 0, At, B0); PG8_MMA(1, 1, At, B1); PG8_BAR; PG8_SCHED;
            } else {
            PG8_LDB(B0, 0, 0); PG8_SCHED; PG8_LDA(At, 0, 0); PG8_STAGE(PG8_SA(1, 1), a1 + hstep, voffA);
            PG8_WAIT_L(8); PG8_BAR; PG8_WAIT_L(0); PG8_MMA(0, 0, At, B0); PG8_BAR; PG8_SCHED;
            PG8_LDB(B1, 0, 1); PG8_STAGE(PG8_SB(0, 0), b2, voffB);
            PG8_BAR; PG8_WAIT_L(0); PG8_MMA(0, 1, At, B1); PG8_BAR;
            PG8_LDA(At, 0, 1); PG8_STAGE(PG8_SA(0, 0), a2, voffA);
            PG8_BAR; PG8_WAIT_L(0); PG8_MMA(1, 0, At, B0); PG8_BAR; PG8_SCHED;
            PG8_STAGE(PG8_SB(0, 1), b2 + hstep, voffB);
            PG8_WAIT_V(6); PG8_BAR; PG8_MMA(1, 1, At, B1); PG8_BAR;
            PG8_LDB(B0, 1, 0); PG8_SCHED; PG8_LDA(At, 1, 0); PG8_STAGE(PG8_SA(0, 1), a2 + hstep, voffA);
            PG8_WAIT_L(8); PG8_BAR; PG8_WAIT_L(0); PG8_MMA(0, 0, At, B0); PG8_BAR; PG8_SCHED;
            PG8_LDB(B1, 1, 1); PG8_STAGE(PG8_SB(1, 0), b3, voffB);
            PG8_BAR; PG8_WAIT_L(0); PG8_MMA(0, 1, At, B1); PG8_BAR;
            PG8_LDA(At, 1, 1); PG8_STAGE(PG8_SA(1, 0), a3, voffA);
            PG8_BAR; PG8_WAIT_L(0); PG8_MMA(1, 0, At, B0); PG8_BAR; PG8_SCHED;
            PG8_STAGE(PG8_SB(1, 1), b3 + hstep, voffB);
            PG8_WAIT_V(6); PG8_BAR; PG8_MMA(1, 1, At, B1); PG8_BAR;
            }
        }
        if constexpr (ALIGN_EPI) { if (wr == 0) PG8_BAR; }
        if constexpr (!Epi::AFTER_DRAIN) { E(acc, cur, wr, wc, fr, fq); S.done(cur); }
        if (!has_next) break;
#pragma unroll
        for (int a = 0; a < 2; ++a)
#pragma unroll
            for (int b = 0; b < 2; ++b)
#pragma unroll
                for (int m = 0; m < 4; ++m)
#pragma unroll
                    for (int n = 0; n < 2; ++n) acc[a][b][m][n] = (f32x4){0.f, 0.f, 0.f, 0.f};
        cur = nxt; cA = nA; cB = nB; ++ui;
        if constexpr (ALIGN_EPI) { if (wr == 1) PG8_BAR; }
    }
    PG8_WAIT_V(0);
    if constexpr (!ALIGN_EPI) { if (wr == 0) PG8_BAR; }
    PG8_BAR;
    if constexpr (Epi::AFTER_DRAIN) { E.fused(acc, cur, wr, wc, fr, fq, lds, wid, lane); S.done(cur); }
#undef PG8_SA
#undef PG8_SB
#undef PG8_STAGE
#undef PG8_LDA
#undef PG8_LDB
#undef PG8_MMA
#undef PG8_WAIT_V
#undef PG8_WAIT_L
#undef PG8_BAR
#undef PG8_SCHED
}
}
namespace att {
using bf16 = __hip_bfloat16;
constexpr int D = 128, NW = 8, QBLK = 32, KVBLK = 64;
constexpr float SCALE = 0.088388347648318440f;
constexpr float THR = 8.f;
constexpr int SDEPTH = 2;
constexpr int LDQ = PW, LDK = PW, LDO = YW;
constexpr size_t SHM_V = KVBLK * D * 2, SHM_K = KVBLK * D * 2, SHM_ATTN = 3 * SHM_V + 3 * SHM_K + NW * 64 * 4;
using bf16x8 = __attribute__((ext_vector_type(8))) short;
using s16x4  = __attribute__((ext_vector_type(4))) short;
using f32x16 = __attribute__((ext_vector_type(16))) float;
using f32x8  = __attribute__((ext_vector_type(8))) float;
using u32x4  = __attribute__((ext_vector_type(4))) unsigned;
#define KSWZ(row, colB) ((row) * 256 + ((colB) ^ (((row) & 7) << 4)))
#define SBAR() __builtin_amdgcn_sched_barrier(0)
__device__ __forceinline__ int crow(int r, int hi) { return (r & 3) + 8 * (r >> 2) + 4 * hi; }
__device__ __forceinline__ unsigned cvtpk(float lo, float hi) {
  unsigned r; asm volatile("v_cvt_pk_bf16_f32 %0, %1, %2" : "=v"(r) : "v"(lo), "v"(hi)); return r;
}
template <typename TIn> struct Stage;
template <> struct Stage<bf16>  { using T = bf16x8;
  __device__ static __forceinline__ T ld8(const bf16* p) { return *reinterpret_cast<const bf16x8*>(p); }
  __device__ static __forceinline__ bf16x8 tobf(T x) { return x; } };
template <> struct Stage<float> { using T = f32x8;
  __device__ static __forceinline__ T ld8(const float* p) { return *reinterpret_cast<const f32x8*>(p); }
  __device__ static __forceinline__ bf16x8 tobf(T x) {
    u32x4 w = {cvtpk(x[0], x[1]), cvtpk(x[2], x[3]), cvtpk(x[4], x[5]), cvtpk(x[6], x[7])}; return *reinterpret_cast<bf16x8*>(&w); } };

template <bool FIXM = false> __device__ __forceinline__ void smax(const f32x16& p0, const f32x16& p1, float& m_reg, float& mn, float& alpha) {
  if constexpr (FIXM) { mn = m_reg; alpha = 1.f; return; }
  float pmax = p0[0]; for (int r = 1; r < 16; ++r) pmax = fmaxf(pmax, p0[r]); for (int r = 0; r < 16; ++r) pmax = fmaxf(pmax, p1[r]);
  { auto rr = __builtin_amdgcn_permlane32_swap(__float_as_uint(pmax), __float_as_uint(pmax), false, false);
    pmax = fmaxf(__uint_as_float(rr[0]), __uint_as_float(rr[1])); }
  if (__builtin_expect(__all(pmax - m_reg <= THR * 1.4426950408889634f), 1)) { mn = m_reg; alpha = 1.f; }
  else { mn = fmaxf(m_reg, pmax); alpha = __builtin_amdgcn_exp2f(m_reg - mn); m_reg = mn; }
}
template <bool FIXM = false> __device__ __forceinline__ void sexp(f32x16& p0, f32x16& p1, float mn) {
  if constexpr (!FIXM) { for (int r = 0; r < 16; ++r) p0[r] -= mn; for (int r = 0; r < 16; ++r) p1[r] -= mn; }
  for (int r = 0; r < 16; ++r) p0[r] = __builtin_amdgcn_exp2f(p0[r]);
  asm volatile("" : "+v"(p0), "+v"(p1));
}
template <bool FIXM = false> __device__ __forceinline__ void partialSM(f32x16& p0, f32x16& p1, float& m_reg, float& mn, float& alpha) { smax<FIXM>(p0, p1, m_reg, mn, alpha); sexp<FIXM>(p0, p1, mn); }
__device__ __forceinline__ void finishSM(f32x16& p0, f32x16& p1, float alpha, float& l_reg, bf16x8& pa0, bf16x8& pa1, bf16x8& pa2, bf16x8& pa3) {
  for (int r = 0; r < 16; ++r) p1[r] = __builtin_amdgcn_exp2f(p1[r]);
  float ps = 0; for (int r = 0; r < 16; ++r) ps += p0[r]; for (int r = 0; r < 16; ++r) ps += p1[r];
  { auto rr = __builtin_amdgcn_permlane32_swap(__float_as_uint(ps), __float_as_uint(ps), false, false);
    ps = __uint_as_float(rr[0]) + __uint_as_float(rr[1]); }
  l_reg = l_reg * alpha + ps;
#define PK4(P, BASE, OUT) do { unsigned a0 = cvtpk(P[BASE + 0], P[BASE + 1]), a1 = cvtpk(P[BASE + 2], P[BASE + 3]);   \
    unsigned b0 = cvtpk(P[BASE + 4], P[BASE + 5]), b1 = cvtpk(P[BASE + 6], P[BASE + 7]);                              \
    auto r0 = __builtin_amdgcn_permlane32_swap(a0, b0, false, false); auto r1 = __builtin_amdgcn_permlane32_swap(a1, b1, false, false); \
    u32x4 w = {r0[0], r1[0], r0[1], r1[1]}; OUT = *reinterpret_cast<bf16x8*>(&w); } while (0)
  PK4(p0, 0, pa0); PK4(p0, 8, pa1); PK4(p1, 0, pa2); PK4(p1, 8, pa3);
#undef PK4
}
template <int OFF> __device__ __forceinline__ bf16x8 k_rd(int addr) { bf16x8 r; asm volatile("ds_read_b128 %0, %1 offset:%2" : "=&v"(r) : "v"(addr), "i"(OFF) : "memory"); return r; }
#define K_WAIT(N, X, Y) asm volatile("s_waitcnt lgkmcnt(" #N ")" : "+v"(X), "+v"(Y) :: "memory")
__device__ __forceinline__ void qkt(f32x16& p0, f32x16& p1, int kb, const bf16x8* qr, const int (&ka)[4]) {
  p0 = f32x16{}; p1 = f32x16{};
  const int a0 = kb + ka[0], a1 = kb + ka[1], a2 = kb + ka[2], a3 = kb + ka[3];
  bf16x8 x0 = k_rd<0>(a0), y0 = k_rd<8192>(a0), x1 = k_rd<0>(a1), y1 = k_rd<8192>(a1);
#define K_STEP(D0, X, Y, N, NEXT) do { K_WAIT(N, X, Y); p0 = __builtin_amdgcn_mfma_f32_32x32x16_bf16(X, qr[D0], p0, 0, 0, 0); p1 = __builtin_amdgcn_mfma_f32_32x32x16_bf16(Y, qr[D0], p1, 0, 0, 0); NEXT; } while (0)
  K_STEP(0, x0, y0, 2, (x0 = k_rd<0>(a2), y0 = k_rd<8192>(a2)));
  K_STEP(1, x1, y1, 2, (x1 = k_rd<0>(a3), y1 = k_rd<8192>(a3)));
  K_STEP(2, x0, y0, 2, (x0 = k_rd<128>(a0), y0 = k_rd<8320>(a0)));
  K_STEP(3, x1, y1, 2, (x1 = k_rd<128>(a1), y1 = k_rd<8320>(a1)));
  K_STEP(4, x0, y0, 2, (x0 = k_rd<128>(a2), y0 = k_rd<8320>(a2)));
  K_STEP(5, x1, y1, 2, (x1 = k_rd<128>(a3), y1 = k_rd<8320>(a3)));
  K_STEP(6, x0, y0, 2, (void)0);
  K_STEP(7, x1, y1, 0, (void)0);
#undef K_STEP
}
#undef K_WAIT
__device__ __forceinline__ int v_st(int k, int c) { const int kk = (k & ~0xC) | ((k & 4) << 1) | ((k & 8) >> 1); return ((kk >> 3) * 4 + (c >> 5)) * 512 + ((kk & 7) * 32 + (c & 31)) * 2; }
__device__ __forceinline__ int v_rd_base(int lane) { return ((lane & 3) << 3) | (((lane >> 2) & 3) << 6) | (((lane >> 4) & 1) << 5) | (((lane >> 5) & 1) << 8); }
constexpr int v_rd_off(int d0, int ks, int half) { return d0 * 512 + ks * 4096 + half * 2048; }
template <int OFF> __device__ __forceinline__ s16x4 tr_read(int vb) {
  s16x4 r; asm volatile("ds_read_b64_tr_b16 %0, %1 offset:%2" : "=&v"(r) : "v"(vb), "i"(OFF) : "memory"); return r;
}
#define PK(L, H) (bf16x8){L[0], L[1], L[2], L[3], H[0], H[1], H[2], H[3]}
template <int D0> __device__ __forceinline__ void pv_two(f32x16& oa, f32x16& ob, int vb, bf16x8 pa0, bf16x8 pa1, bf16x8 pa2, bf16x8 pa3) {
  const s16x4 l0 = tr_read<v_rd_off(D0, 0, 0)>(vb), h0 = tr_read<v_rd_off(D0, 0, 1)>(vb), l1 = tr_read<v_rd_off(D0, 1, 0)>(vb), h1 = tr_read<v_rd_off(D0, 1, 1)>(vb);
  const s16x4 l2 = tr_read<v_rd_off(D0, 2, 0)>(vb), h2 = tr_read<v_rd_off(D0, 2, 1)>(vb), l3 = tr_read<v_rd_off(D0, 3, 0)>(vb), h3 = tr_read<v_rd_off(D0, 3, 1)>(vb);
  const s16x4 m0 = tr_read<v_rd_off(D0 + 1, 0, 0)>(vb), g0 = tr_read<v_rd_off(D0 + 1, 0, 1)>(vb), m1 = tr_read<v_rd_off(D0 + 1, 1, 0)>(vb), g1 = tr_read<v_rd_off(D0 + 1, 1, 1)>(vb);
  const s16x4 m2 = tr_read<v_rd_off(D0 + 1, 2, 0)>(vb), g2 = tr_read<v_rd_off(D0 + 1, 2, 1)>(vb), m3 = tr_read<v_rd_off(D0 + 1, 3, 0)>(vb), g3 = tr_read<v_rd_off(D0 + 1, 3, 1)>(vb);
  asm volatile("s_waitcnt lgkmcnt(0)" ::: "memory"); SBAR();
  oa = __builtin_amdgcn_mfma_f32_32x32x16_bf16(pa0, PK(l0, h0), oa, 0, 0, 0);
  ob = __builtin_amdgcn_mfma_f32_32x32x16_bf16(pa0, PK(m0, g0), ob, 0, 0, 0);
  oa = __builtin_amdgcn_mfma_f32_32x32x16_bf16(pa1, PK(l1, h1), oa, 0, 0, 0);
  ob = __builtin_amdgcn_mfma_f32_32x32x16_bf16(pa1, PK(m1, g1), ob, 0, 0, 0);
  oa = __builtin_amdgcn_mfma_f32_32x32x16_bf16(pa2, PK(l2, h2), oa, 0, 0, 0);
  ob = __builtin_amdgcn_mfma_f32_32x32x16_bf16(pa2, PK(m2, g2), ob, 0, 0, 0);
  oa = __builtin_amdgcn_mfma_f32_32x32x16_bf16(pa3, PK(l3, h3), oa, 0, 0, 0);
  ob = __builtin_amdgcn_mfma_f32_32x32x16_bf16(pa3, PK(m3, g3), ob, 0, 0, 0);
}
#undef PK
__device__ __forceinline__ void pv_d0(f32x16* o, int vb, bf16x8 pa0, bf16x8 pa1, bf16x8 pa2, bf16x8 pa3) {
  pv_two<0>(o[0], o[1], vb, pa0, pa1, pa2, pa3); pv_two<2>(o[2], o[3], vb, pa0, pa1, pa2, pa3);
}

template <typename TQ, int LDO_T, bool FIXM>
__device__ __forceinline__ void attn_dense_body(const TQ* __restrict__ Qb, const bf16* __restrict__ Kh, const bf16* __restrict__ Vh,
                                                unsigned short* __restrict__ Ob, float* __restrict__ stat, int seq, char* lds, float mfix) {
  using St = Stage<bf16>; using SQ = Stage<TQ>;
  const int tid = opaque_tid(), wid = tid >> 6, lane = tid & 63, r32 = lane & 31, hi = lane >> 5;
  bf16* V_lds = (bf16*)lds; bf16* K_lds = (bf16*)(lds + 3 * SHM_V);
  float* ws = (float*)(lds + 3 * SHM_V + 3 * SHM_K) + wid * 64; float* li_l = ws; float* al_l = ws + 32;
  float m_reg = FIXM ? mfix : -1e30f, l_reg = 0; f32x16 o[4] = {}; bf16x8 qr[8];
  const TQ* Qw = Qb + (long)(wid * QBLK + r32) * LDQ + hi * 8;
#pragma unroll
  for (int d0 = 0; d0 < 8; ++d0) qr[d0] = SQ::tobf(SQ::ld8(Qw + d0 * 16));
  const int sr = tid >> 4, sc = (tid & 15) * 8, vst0 = v_st(sr, sc), vst1 = v_st(32 + sr, sc);
  const int vb0 = (int)(uintptr_t)V_lds + v_rd_base(lane);
  const int kb0 = (int)(uintptr_t)K_lds; const int ka[4] = {KSWZ(r32, (0 * 16 + hi * 8) * 2), KSWZ(r32, (1 * 16 + hi * 8) * 2), KSWZ(r32, (2 * 16 + hi * 8) * 2), KSWZ(r32, (3 * 16 + hi * 8) * 2)};
  struct { typename St::T vs0, vs1, ks0, ks1; } sr_[SDEPTH];
#define SLOAD(i, k0) do { sr_[i].vs0 = St::ld8(&Vh[(long)((k0) + sr) * LDK + sc]); sr_[i].vs1 = St::ld8(&Vh[(long)((k0) + 32 + sr) * LDK + sc]); \
    sr_[i].ks0 = St::ld8(&Kh[(long)((k0) + sr) * LDK + sc]); sr_[i].ks1 = St::ld8(&Kh[(long)((k0) + 32 + sr) * LDK + sc]); } while (0)
#define SWRITE(b, i) do { *(bf16x8*)((char*)V_lds + (b) * (int)SHM_V + vst0) = St::tobf(sr_[i].vs0);          \
    *(bf16x8*)((char*)V_lds + (b) * (int)SHM_V + vst1) = St::tobf(sr_[i].vs1); int kc = sc * 2;               \
    *(bf16x8*)((char*)K_lds + (b) * (int)SHM_K + KSWZ(sr, kc)) = St::tobf(sr_[i].ks0);                       \
    *(bf16x8*)((char*)K_lds + (b) * (int)SHM_K + KSWZ(32 + sr, kc)) = St::tobf(sr_[i].ks1); } while (0)
#define SWAIT() do { if constexpr (SDEPTH == 2) asm volatile("s_waitcnt vmcnt(4)" ::: "memory"); else asm volatile("s_waitcnt vmcnt(0)" ::: "memory"); } while (0)
#define RESC(a) do { if constexpr (!FIXM) if (__any((a) < 1.f)) { if (hi == 0) al_l[r32] = (a); asm volatile("s_waitcnt lgkmcnt(0)" ::: "memory"); \
    for (int d = 0; d < 4; ++d) for (int r = 0; r < 16; ++r) o[d][r] *= al_l[crow(r, hi)]; } } while (0)
#define KBUF(b) ((bf16*)((char*)K_lds + (b) * (int)SHM_K))
  f32x16 pA0, pA1, pB0, pB1; float mnA, mnB, alA, alB; bf16x8 pa0, pa1, pa2, pa3; const int NT = seq / KVBLK;
  constexpr int SE = 0, SO = SDEPTH - 1;
  SLOAD(SE, 0); asm volatile("s_waitcnt vmcnt(0)" ::: "memory"); SWRITE(0, SE); __syncthreads();
  qkt(pA0, pA1, kb0, qr, ka); partialSM<FIXM>(pA0, pA1, m_reg, mnA, alA);
  SLOAD(SO, KVBLK); if constexpr (SDEPTH == 2) { if (2 < NT) SLOAD(SE, 2 * KVBLK); }
  SWAIT(); SWRITE(1, SO); __syncthreads();
  int iV = 0, iK = 1, iW = 2;
  for (int j = 1; j + 1 < NT; j += 2) {
    SBAR(); qkt(pB0, pB1, kb0 + iK * (int)SHM_K, qr, ka);
    finishSM(pA0, pA1, alA, l_reg, pa0, pa1, pa2, pa3); SBAR();
    SLOAD(SO, (j + SDEPTH) * KVBLK); SBAR();
    pv_two<0>(o[0], o[1], vb0 + iV * (int)SHM_V, pa0, pa1, pa2, pa3); smax<FIXM>(pB0, pB1, m_reg, mnB, alB);
    pv_two<2>(o[2], o[3], vb0 + iV * (int)SHM_V, pa0, pa1, pa2, pa3); sexp<FIXM>(pB0, pB1, mnB);
    SWAIT(); SWRITE(iW, SE);
    RESC(alB); __syncthreads();
    { const int t_ = iV; iV = iK; iK = iW; iW = t_; }
    SBAR(); qkt(pA0, pA1, kb0 + iK * (int)SHM_K, qr, ka);
    finishSM(pB0, pB1, alB, l_reg, pa0, pa1, pa2, pa3); SBAR();
    if (SDEPTH == 1 || j + 3 < NT) SLOAD(SE, (j + 1 + SDEPTH) * KVBLK); SBAR();
    pv_two<0>(o[0], o[1], vb0 + iV * (int)SHM_V, pa0, pa1, pa2, pa3); smax<FIXM>(pA0, pA1, m_reg, mnA, alA);
    pv_two<2>(o[2], o[3], vb0 + iV * (int)SHM_V, pa0, pa1, pa2, pa3); sexp<FIXM>(pA0, pA1, mnA);
    SWAIT(); SWRITE(iW, SO);
    RESC(alA); __syncthreads();
    { const int t_ = iV; iV = iK; iK = iW; iW = t_; }
  }
  SBAR(); qkt(pB0, pB1, kb0 + iK * (int)SHM_K, qr, ka);
  finishSM(pA0, pA1, alA, l_reg, pa0, pa1, pa2, pa3); SBAR();
  pv_d0(o, vb0 + iV * (int)SHM_V, pa0, pa1, pa2, pa3); partialSM<FIXM>(pB0, pB1, m_reg, mnB, alB);
  RESC(alB);
  finishSM(pB0, pB1, alB, l_reg, pa0, pa1, pa2, pa3); SBAR();
  pv_d0(o, vb0 + iK * (int)SHM_V, pa0, pa1, pa2, pa3);
#undef KBUF
  if (hi == 0) li_l[r32] = l_reg; asm volatile("s_waitcnt lgkmcnt(0)" ::: "memory");
  float rli[16];
#pragma unroll
  for (int r = 0; r < 16; ++r) rli[r] = __builtin_amdgcn_rcpf(li_l[crow(r, hi)]);
  if (stat != nullptr && hi == 0) { stat[(wid * QBLK + r32) * 16] = m_reg; stat[(wid * QBLK + r32) * 16 + 1] = l_reg; }
  unsigned short* Ow = Ob + (long)(wid * QBLK) * LDO_T;
#pragma unroll
  for (int r = 0; r < 16; ++r) { int orow = crow(r, hi);
    for (int d0 = 0; d0 < 4; ++d0) Ow[(long)orow * LDO_T + d0 * 32 + r32] = (unsigned short)f2bf(o[d0][r] * rli[r]); }
#undef SLOAD
#undef SWRITE
#undef SWAIT
#undef RESC
}
}
struct Frame {
    LAS unsigned char* lds; unsigned char* ldsg;
    volatile LAS unsigned* MISC;
    unsigned* ctl; unsigned char* ws;
    int tid, lane, wave, G, vcu;
};
__device__ __forceinline__ const float* inp(const Frame& F, int k) {
    const unsigned lo = __builtin_amdgcn_readfirstlane(F.MISC[16 + 2 * k]), hi = __builtin_amdgcn_readfirstlane(F.MISC[17 + 2 * k]);
    return (const float*)(const GAS float*)(((unsigned long long)hi << 32) | (unsigned long long)lo);
}
enum { I_x = 0, I_c, I_ctx, I_c_ctx, I_w_ada, I_b_ada, I_w_in, I_ret_decay, I_dn_conv_w, I_dn_a_log, I_dn_dt_bias, I_dn_norm_w, I_att_qn_w, I_att_kn_w, I_w_o, I_ln1_w, I_ln1_b, I_w_ffi, I_w_ffo, I_ln2_w, I_ln2_b, I_out };

struct TrItem { const float* src; bf16_t* dst; int ldw, K, ncols; };
__device__ __forceinline__ TrItem tr_decode(const Frame& F, int it) {
    constexpr int I_IN = 32 * 177, I_O = 32 * 64, I_FI = 32 * 352, I_FO = 88 * 64, I_L = I_IN + I_O + I_FI + I_FO;
    bf16_t* Win_t = (bf16_t*)(F.ws + WS_WIN); bf16_t* Wo_t = (bf16_t*)(F.ws + WS_WO); bf16_t* Wfi_t = (bf16_t*)(F.ws + WS_WFI); bf16_t* Wfo_t = (bf16_t*)(F.ws + WS_WFO);
    const int l = it / I_L; int r = it - l * I_L; TrItem t;
    if (r < I_IN) { const int kb = r / 177, nb = r - kb * 177; int dst = 32 * nb, src = 32 * nb, nc = 32;
        if (nb >= 128) src += 16; if (nb == 176) { dst = 5632; src = 4096; nc = 16; }
        t.src = inp(F, I_w_in) + (size_t)l * DM * PROJ_SRC + (size_t)(64 * kb) * PROJ_SRC + src; t.ldw = PROJ_SRC; t.K = DM; t.ncols = nc; t.dst = Win_t + (size_t)l * PWPAD * DM + (size_t)dst * DM + 64 * kb; return t; }
    r -= I_IN;
    if (r < I_O) { const int kb = r >> 6, nb = r & 63;
        t.src = inp(F, I_w_o) + (size_t)l * DM * DM + (size_t)(64 * kb) * DM + 32 * nb; t.ldw = DM; t.K = DM; t.ncols = 32; t.dst = Wo_t + (size_t)l * DM * DM + (size_t)(32 * nb) * DM + 64 * kb; return t; }
    r -= I_O;
    if (r < I_FI) { const int kb = r / 352, nb = r - kb * 352, pn = nb >> 3, q = nb & 7; const int src = q < 4 ? 128 * pn + 32 * q : DFF + 128 * pn + 32 * (q - 4);
        t.src = inp(F, I_w_ffi) + (size_t)l * DM * 2 * DFF + (size_t)(64 * kb) * 2 * DFF + src; t.ldw = 2 * DFF; t.K = DM; t.ncols = 32; t.dst = Wfi_t + (size_t)l * 2 * DFF * DM + (size_t)(32 * nb) * DM + 64 * kb; return t; }
    r -= I_FI;
    { const int kb = r >> 6, nb = r & 63;
        t.src = inp(F, I_w_ffo) + (size_t)l * DFF * DM + (size_t)(64 * kb) * DM + 32 * nb; t.ldw = DM; t.K = DFF; t.ncols = 32; t.dst = Wfo_t + (size_t)l * DM * DFF + (size_t)(32 * nb) * DFF + 64 * kb; return t; }
}
#define TR_LOAD(v, t) do { const int kr_ = lane >> 3, c4_ = (lane & 7) * 4; const bool ok_ = c4_ < (t).ncols; \
        _Pragma("unroll") for (int i_ = 0; i_ < 8; ++i_) v[i_] = ok_ ? *(const f32x4*)((t).src + (size_t)(8 * i_ + kr_) * (t).ldw + c4_) : (f32x4){0.f, 0.f, 0.f, 0.f}; } while (0)
#define TR_PROC(v, t) do { const int kr_ = lane >> 3, c4_ = (lane & 7) * 4; \
        _Pragma("unroll") for (int i_ = 0; i_ < 8; ++i_) { LAS float* s_ = scr + (8 * i_ + kr_) * 33 + c4_; s_[0] = v[i_][0]; s_[1] = v[i_][1]; s_[2] = v[i_][2]; s_[3] = v[i_][3]; } \
        LDS_WAIT(); const int c8_ = lane & 7; \
        _Pragma("unroll") for (int j_ = 0; j_ < 4; ++j_) { const int n_ = (lane >> 3) + 8 * j_; const LAS float* s_ = scr + (8 * c8_) * 33 + n_; \
            u32x4 o_; o_.x = pk2(s_[0 * 33], s_[1 * 33]); o_.y = pk2(s_[2 * 33], s_[3 * 33]); o_.z = pk2(s_[4 * 33], s_[5 * 33]); o_.w = pk2(s_[6 * 33], s_[7 * 33]); \
            if (n_ < (t).ncols) *(u32x4*)((t).dst + (size_t)n_ * (t).K + 8 * c8_) = o_; } \
        LDS_WAIT(); } while (0)
__device__ __forceinline__ void prologue_phase(Frame& F) {
    LAS float* scr = (LAS float*)(F.lds + F.wave * 8448);
    const int gw = F.vcu * NWAVES + F.wave, NGW = F.G * NWAVES, lane = F.lane;
    bf16_t* Win_t = (bf16_t*)(F.ws + WS_WIN);
    constexpr int NIT = DEPTH * (32 * 177 + 32 * 64 + 32 * 352 + 88 * 64);
    { f32x4 va[8], vb[8]; TrItem ta, tb;
      int it = gw; if (it < NIT) { ta = tr_decode(F, it); TR_LOAD(va, ta); }
      while (it < NIT) {
          int in = it + NGW; if (in < NIT) { tb = tr_decode(F, in); TR_LOAD(vb, tb); }
          TR_PROC(va, ta); it = in; if (it >= NIT) break;
          in = it + NGW; if (in < NIT) { ta = tr_decode(F, in); TR_LOAD(va, ta); }
          TR_PROC(vb, tb); it = in;
      } }
    { constexpr int PER_L = (PWPAD - PROJ_SRC) * DM / 8;
      for (int i = (F.vcu * NWAVES * 64) + F.tid; i < DEPTH * PER_L; i += F.G * NWAVES * 64) { const int l = i / PER_L, j = i - l * PER_L;
          *(u32x4*)(Win_t + (size_t)l * PWPAD * DM + (size_t)PROJ_SRC * DM + (size_t)j * 8) = (u32x4){0u, 0u, 0u, 0u}; } }
    LAS float* cond = (LAS float*)(F.lds + 73728);
    LAS float* red = (LAS float*)(F.lds + 98304);
    __syncthreads();
    for (int i = F.tid; i < 3 * DM; i += NWAVES * 64) { const int s = i / DM, k = i - s * DM; const float v = s < 2 ? inp(F, I_c)[s * DM + k] : inp(F, I_c_ctx)[k]; cond[i] = v / (1.f + expf(-v)); }
    __syncthreads();
    float* MOD = (float*)(F.ws + WS_MOD);
    for (int item = F.vcu; item < DEPTH * 96; item += F.G) {
        const int l = item / 96, cb = item - l * 96;
        const float* W = inp(F, I_w_ada) + (size_t)l * DM * 12288 + cb * 128 + 2 * lane;
        float a00 = 0.f, a01 = 0.f, a10 = 0.f, a11 = 0.f, a20 = 0.f, a21 = 0.f;
        const int kbeg = F.wave * 256;
#pragma unroll 16
        for (int k = kbeg; k < kbeg + 256; ++k) { const f32x2 w = *(const f32x2*)(W + (size_t)k * 12288); const float c0 = cond[k], c1 = cond[DM + k], c2 = cond[2 * DM + k];
            a00 += c0 * w.x; a01 += c0 * w.y; a10 += c1 * w.x; a11 += c1 * w.y; a20 += c2 * w.x; a21 += c2 * w.y; }
        red[(F.wave * 3 + 0) * 128 + 2 * lane] = a00; red[(F.wave * 3 + 0) * 128 + 2 * lane + 1] = a01;
        red[(F.wave * 3 + 1) * 128 + 2 * lane] = a10; red[(F.wave * 3 + 1) * 128 + 2 * lane + 1] = a11;
        red[(F.wave * 3 + 2) * 128 + 2 * lane] = a20; red[(F.wave * 3 + 2) * 128 + 2 * lane + 1] = a21;
        __syncthreads();
        if (F.tid < 384) { const int s = F.tid >> 7, cc = F.tid & 127; float sum = inp(F, I_b_ada)[l * 12288 + cb * 128 + cc];
#pragma unroll
            for (int w = 0; w < 8; ++w) sum += red[(w * 3 + s) * 128 + cc];
            MOD[(size_t)(l * 3 + s) * 12288 + cb * 128 + cc] = sum; }
        __syncthreads();
    }
}

template <int MODE> __device__ __forceinline__ void ln_mod_phase(Frame& F, int l, bool skip_ctx) {
    float* X = (float*)(F.ws + WS_X); bf16_t* H = (bf16_t*)(F.ws + WS_H); const float* MOD = (const float*)(F.ws + WS_MOD); float* LNS = (float*)(F.ws + WS_LNS);
    const int gw = F.vcu * NWAVES + F.wave, NGW = F.G * NWAVES, lane = F.lane;
    const int lm = MODE == 0 ? 0 : (MODE == 1 ? l : l + 1), ish = MODE == 1 ? 3 : 0, isc = MODE == 1 ? 4 : 1;
    f32x4 lw[8], lb[8];
    if (MODE != 0) { const float* pw = (MODE == 1 ? inp(F, I_ln1_w) : inp(F, I_ln2_w)) + l * DM; const float* pb = (MODE == 1 ? inp(F, I_ln1_b) : inp(F, I_ln2_b)) + l * DM;
#pragma unroll
        for (int j = 0; j < 8; ++j) { lw[j] = *(const f32x4*)(pw + 4 * lane + 256 * j); lb[j] = *(const f32x4*)(pb + 4 * lane + 256 * j); } }
    const float* xin = MODE == 0 ? inp(F, I_x) : nullptr; const float* cin = MODE == 0 ? inp(F, I_ctx) : nullptr; float* outp = MODE == 3 ? (float*)inp(F, I_out) : nullptr;
#define LN_ROW(seg, i) ((seg) == 0 ? ((i) >> 8) * TOK + ((i) & 255) : ((seg) - 1) * TOK + CTXL + (i))
#define LN_SRC(seg, i) (MODE == 0 ? ((seg) == 0 ? cin + (size_t)(i) * DM : xin + (size_t)(((seg) - 1) * SEQ + (i)) * DM) : X + (size_t)LN_ROW(seg, i) * DM)
#define LN_LOAD(v, seg, i) do { const float* s_ = LN_SRC(seg, i); _Pragma("unroll") for (int j = 0; j < 8; ++j) v[j] = *(const f32x4*)(s_ + 4 * lane + 256 * j); } while (0)
#define LN_PROC(v, seg, i) do { \
        if (MODE != 0) { float sm = 0.f; \
            _Pragma("unroll") for (int j = 0; j < 8; ++j) sm += (v[j][0] + v[j][1]) + (v[j][2] + v[j][3]); \
            const float mean = wave_sum(sm) * (1.f / DM); float sq = 0.f; \
            _Pragma("unroll") for (int j = 0; j < 8; ++j) { v[j] = v[j] - mean; sq += (v[j][0] * v[j][0] + v[j][1] * v[j][1]) + (v[j][2] * v[j][2] + v[j][3] * v[j][3]); } \
            const float rstd = rsqrtf(wave_sum(sq) * (1.f / DM) + EPS); \
            if (MODE != 3 && lane == 0) *(f32x2*)(LNS + (size_t)LN_ROW(seg, i) * 2) = (f32x2){mean, rstd};     \
            _Pragma("unroll") for (int j = 0; j < 8; ++j) v[j] = v[j] * rstd * lw[j] + lb[j]; } \
        if (MODE == 3) { float* o_ = outp + (size_t)(((seg) - 1) * SEQ + (i)) * DM; \
            _Pragma("unroll") for (int j = 0; j < 8; ++j) __builtin_nontemporal_store(v[j], (f32x4*)(o_ + 4 * lane + 256 * j)); } \
        else { const size_t r_ = (size_t)LN_ROW(seg, i); \
            _Pragma("unroll") for (int j = 0; j < 8; ++j) { if (MODE == 0) *(f32x4*)(X + r_ * DM + 4 * lane + 256 * j) = v[j]; const f32x4 hh = v[j] * (sc[j] + 1.f) + sh[j]; \
                u32x2 w_; w_.x = pk2(hh[0], hh[1]); w_.y = pk2(hh[2], hh[3]); *(u32x2*)(H + r_ * DM + 4 * lane + 256 * j) = w_; } } } while (0)
    for (int seg = ((skip_ctx || MODE == 3) ? 1 : 0); seg < 3; ++seg) {
        const int n = seg == 0 ? NBATCH * CTXL : SEQ, s = seg == 0 ? 2 : seg - 1;
        f32x4 sh[8], sc[8];
        if (MODE != 3) { const float* msh = MOD + (size_t)(lm * 3 + s) * 12288 + ish * DM; const float* msc = MOD + (size_t)(lm * 3 + s) * 12288 + isc * DM;
#pragma unroll
            for (int j = 0; j < 8; ++j) { sh[j] = *(const f32x4*)(msh + 4 * lane + 256 * j); sc[j] = *(const f32x4*)(msc + 4 * lane + 256 * j); } }
        f32x4 va[8], vb[8];
        int i = gw; if (i < n) LN_LOAD(va, seg, i);
        while (i < n) {
            int in = i + NGW; if (in < n) LN_LOAD(vb, seg, in);
            LN_PROC(va, seg, i); i = in; if (i >= n) break;
            in = i + NGW; if (in < n) LN_LOAD(va, seg, in);
            LN_PROC(vb, seg, i); i = in;
        }
    }
#undef LN_ROW
#undef LN_SRC
#undef LN_LOAD
#undef LN_PROC
}

__device__ __forceinline__ void ctx_gemm_resid(Frame& F, const bf16_t* A, const bf16_t* Bt, int K, float* X, const float* gate_ctx, float alpha, const float* stats, const float* lnw, const float* lnb, int ln) {
    LAS unsigned char* L = F.lds; const int tid = F.tid, lane = F.lane, wave = F.wave, rr = lane & 15, kg = lane >> 4;
    const int srow = tid >> 3, sc = tid & 7;
    for (int tile = F.vcu; tile < 256; tile += F.G) {
        const int rt = tile >> 5, ct = tile & 31; const size_t row0 = (size_t)(rt >> 2) * TOK + (rt & 3) * 64; const int col0 = ct * 64;
        const bf16_t* ap = A + (row0 + srow) * K + sc * 8; const bf16_t* bp = Bt + (size_t)(col0 + srow) * K + sc * 8;
        f32x4 acc[2]; acc[0] = (f32x4){0.f, 0.f, 0.f, 0.f}; acc[1] = acc[0];
        u32x4 ra0, ra1, ra2, ra3, ra4, ra5, ra6, ra7, rb0, rb1, rb2, rb3, rb4, rb5, rb6, rb7; const int nk = K / 64;
#define CG_LD(i, RA, RB) do { RA = *(const u32x4*)(ap + (i) * 64); RB = *(const u32x4*)(bp + (i) * 64); } while (0)
        CG_LD(0, ra0, rb0); CG_LD(1, ra1, rb1); CG_LD(2, ra2, rb2); CG_LD(3, ra3, rb3); CG_LD(4, ra4, rb4); CG_LD(5, ra5, rb5); CG_LD(6, ra6, rb6); CG_LD(7, ra7, rb7);
#define CG_STEP(kt, RA, RB) do { LAS unsigned char* As_ = L + ((kt) & 1) * 18432; LAS unsigned char* Bs_ = As_ + 9216; \
            *(LAS u32x4*)(As_ + srow * 144 + sc * 16) = RA; *(LAS u32x4*)(Bs_ + srow * 144 + sc * 16) = RB; \
            __syncthreads(); \
            if ((kt) + 8 < nk) CG_LD((kt) + 8, RA, RB); \
            _Pragma("unroll") for (int ks = 0; ks < 2; ++ks) { const bf16x8 af = ldsfrag(As_ + (16 * (wave & 3) + rr) * 144 + (32 * ks + 8 * kg) * 2); \
                _Pragma("unroll") for (int j = 0; j < 2; ++j) acc[j] = mfma16(ldsfrag(Bs_ + (32 * (wave >> 2) + 16 * j + rr) * 144 + (32 * ks + 8 * kg) * 2), af, acc[j]); } } while (0)
        for (int kt = 0; kt < nk; kt += 8) { CG_STEP(kt, ra0, rb0); CG_STEP(kt + 1, ra1, rb1); CG_STEP(kt + 2, ra2, rb2); CG_STEP(kt + 3, ra3, rb3); CG_STEP(kt + 4, ra4, rb4); CG_STEP(kt + 5, ra5, rb5); CG_STEP(kt + 6, ra6, rb6); CG_STEP(kt + 7, ra7, rb7); }
#undef CG_STEP
#undef CG_LD
        const size_t row = row0 + 16 * (wave & 3) + rr;
#pragma unroll
        for (int j = 0; j < 2; ++j) { const int col = col0 + 32 * (wave >> 2) + 16 * j + 4 * kg; float* xp = X + row * DM + col;
            const f32x4 g = *(const f32x4*)(gate_ctx + col); f32x4 x = *(const f32x4*)xp;
            if (ln) { const f32x2 st = *(const f32x2*)(stats + row * 2); x = (x - st.x) * st.y * *(const f32x4*)(lnw + col) + *(const f32x4*)(lnb + col); }
            x = x * alpha + g * acc[j]; *(f32x4*)xp = x; }
        __syncthreads();
    }
}

__device__ __forceinline__ void rowprep_phase(Frame& F, int l) {
    bf16_t* P = (bf16_t*)(F.ws + WS_P); float* AB = (float*)(F.ws + WS_AB); bf16_t* DQ = (bf16_t*)(F.ws + WS_DQ);
    const int lane = F.lane, gw = F.vcu * NWAVES + F.wave, NGW = F.G * NWAVES;
    LAS float* csl = (LAS float*)(F.lds + F.wave * 512);
    const float* cw = inp(F, I_dn_conv_w) + (size_t)l * 5 * 1536;
    const float inv = powf(10000.f, -(float)(lane & 31) * (1.f / 32.f));
    const float nega = lane < 8 ? -expf(inp(F, I_dn_a_log)[l * 8 + lane]) : 0.f, dtb = lane < 8 ? inp(F, I_dn_dt_bias)[l * 8 + lane] : 0.f;
    const int hs = lane >> 3, c8 = (lane & 7) * 8;
    f32x4 qn1a, qn1b, qn2a, qn2b, kn1a, kn1b, kn2a, kn2b;
    { const float* qn = inp(F, I_att_qn_w) + l * 128; const float* kn = inp(F, I_att_kn_w) + l * 128;
      qn1a = *(const f32x4*)(qn + c8); qn1b = *(const f32x4*)(qn + c8 + 4); qn2a = *(const f32x4*)(qn + 64 + c8); qn2b = *(const f32x4*)(qn + 64 + c8 + 4);
      kn1a = *(const f32x4*)(kn + c8); kn1b = *(const f32x4*)(kn + c8 + 4); kn2a = *(const f32x4*)(kn + 64 + c8); kn2b = *(const f32x4*)(kn + 64 + c8 + 4); }
#define RP_UNPACK(V_, lo, hi) do { lo = (f32x4){bflo(V_.x), bfhi(V_.x), bflo(V_.y), bfhi(V_.y)}; hi = (f32x4){bflo(V_.z), bfhi(V_.z), bflo(V_.w), bfhi(V_.w)}; } while (0)
#define RP_PACK(lo, hi) (u32x4){pk2(lo[0], lo[1]), pk2(lo[2], lo[3]), pk2(hi[0], hi[1]), pk2(hi[2], hi[3])}
#define RP_GLOAD(base, act, r1_, r2_) do { const bf16_t* p1_ = p + (base) + hs * 128 + c8; r1_ = (u32x4){0u, 0u, 0u, 0u}; r2_ = r1_; if (act) { r1_ = *(const u32x4*)p1_; r2_ = *(const u32x4*)(p1_ + 64); } } while (0)
#define RP_GROUP(base, NORM, w1a, w1b, w2a, w2b, scl, act, r1_, r2_) do { bf16_t* p1_ = p + (base) + hs * 128 + c8; \
        f32x4 x1a, x1b, x2a, x2b; RP_UNPACK(r1_, x1a, x1b); RP_UNPACK(r2_, x2a, x2b); \
        if (NORM) { f32x4 q_ = x1a * x1a + x1b * x1b + x2a * x2a + x2b * x2b; float ss_ = (q_[0] + q_[1]) + (q_[2] + q_[3]); ss_ += __shfl_xor(ss_, 1); ss_ += __shfl_xor(ss_, 2); ss_ += __shfl_xor(ss_, 4); \
            const float ri_ = rsqrtf(ss_ * (1.f / 128.f) + EPS); x1a = x1a * ri_ * w1a; x1b = x1b * ri_ * w1b; x2a = x2a * ri_ * w2a; x2b = x2b * ri_ * w2b; } \
        const f32x4 y1a = (x1a * ca - x2a * sa) * (scl), y1b = (x1b * cb - x2b * sb) * (scl), y2a = (x1a * sa + x2a * ca) * (scl), y2b = (x1b * sb + x2b * cb) * (scl); \
        if (act) { *(u32x4*)p1_ = RP_PACK(y1a, y1b); *(u32x4*)(p1_ + 64) = RP_PACK(y2a, y2b); } } while (0)
    for (int r = gw; r < MROWS; r += NGW) {
        const int b = r / TOK, tp = r - b * TOK; const bool is_ctx = tp < CTXL;
        { float cs = 1.f, sn = 0.f;
          if (!is_ctx) { const int t = tp - CTXL; const float pos = (lane < 32) ? (float)(t >> 6) : (float)(t & 63); sn = __sinf(pos * inv); cs = __cosf(pos * inv); }
          csl[lane] = cs; csl[64 + lane] = sn; LDS_WAIT(); }
        const f32x4 ca = *(const LAS f32x4*)(csl + c8), cb = *(const LAS f32x4*)(csl + c8 + 4), sa = *(const LAS f32x4*)(csl + 64 + c8), sb = *(const LAS f32x4*)(csl + 64 + c8 + 4);
        bf16_t* p = P + (size_t)r * PW;
        u32x4 gq1, gq2, gk1, gk2, gr1, gr2, cv[3][5]; float abv = 0.f, bbv = 0.f;
        RP_GLOAD(C_AQ, true, gq1, gq2); RP_GLOAD(C_AK, (hs < 2), gk1, gk2); RP_GLOAD(C_RQ, true, gr1, gr2);
#pragma unroll
        for (int j = 0; j < 3; ++j)
#pragma unroll
            for (int k = 0; k < 5; ++k) { const int rr = tp + k - 2; const bool valid = is_ctx ? (rr >= 0 && rr < CTXL) : (rr >= CTXL && rr < TOK);
                cv[j][k] = (u32x4){0u, 0u, 0u, 0u}; if (valid) cv[j][k] = *(const u32x4*)(P + (size_t)(r + k - 2) * PW + C_DQKV + 8 * (lane + 64 * j)); }
        if (lane < 8) { abv = AB[(size_t)r * 16 + lane]; bbv = AB[(size_t)r * 16 + 8 + lane]; }
        asm volatile("" ::: "memory");
        RP_GROUP(C_AQ, true, qn1a, qn1b, qn2a, qn2b, (0.088388347648318440f * 1.4426950408889634f), true, gq1, gq2);
        RP_GROUP(C_AK, true, kn1a, kn1b, kn2a, kn2b, 1.f, (hs < 2), gk1, gk2);
        RP_GROUP(C_RQ, false, qn1a, qn1b, qn2a, qn2b, (hs < 4 ? 1.f : 0.088388347648318440f), true, gr1, gr2);
        LDS_WAIT();
#pragma unroll
        for (int j = 0; j < 3; ++j) {
            const int c0 = 8 * (lane + 64 * j); float a[8];
#pragma unroll
            for (int e = 0; e < 8; ++e) a[e] = 0.f;
#pragma unroll
            for (int k = 0; k < 5; ++k) { const int rr = tp + k - 2; const bool valid = is_ctx ? (rr >= 0 && rr < CTXL) : (rr >= CTXL && rr < TOK);
                if (valid) { const u32x4 xv = cv[j][k]; const f32x4 w0 = *(const f32x4*)(cw + k * 1536 + c0), w1 = *(const f32x4*)(cw + k * 1536 + c0 + 4);
                    a[0] += w0[0] * bflo(xv.x); a[1] += w0[1] * bfhi(xv.x); a[2] += w0[2] * bflo(xv.y); a[3] += w0[3] * bfhi(xv.y);
                    a[4] += w1[0] * bflo(xv.z); a[5] += w1[1] * bfhi(xv.z); a[6] += w1[2] * bflo(xv.w); a[7] += w1[3] * bfhi(xv.w); } }
            float ss = 0.f;
#pragma unroll
            for (int e = 0; e < 8; ++e) { a[e] = silu_f(a[e]); ss += a[e] * a[e]; }
            if (j < 2) { const float sc = rsqrtf(sum16(ss) + EPS) * (j == 0 ? 0.088388347648318440f : 1.f);
#pragma unroll
                for (int e = 0; e < 8; ++e) a[e] *= sc; }
            u32x4 o; o.x = pk2(a[0], a[1]); o.y = pk2(a[2], a[3]); o.z = pk2(a[4], a[5]); o.w = pk2(a[6], a[7]);
            *(u32x4*)(DQ + (size_t)r * 1536 + c0) = o;
        }
        if (lane < 8) { const float av = abv, bv = bbv; const float xx = av + dtb; const float sp = xx > 20.f ? xx : log1pf(expf(xx));
            AB[(size_t)r * 16 + lane] = nega * sp; AB[(size_t)r * 16 + 8 + lane] = 1.f / (1.f + expf(-bv)); }
    }
#undef RP_UNPACK
#undef RP_PACK
#undef RP_GROUP
#undef RP_GLOAD
}

constexpr int DP_QS = 0, DP_KS = 17408, DP_KT = 36864, DP_VT = 55296, DP_AS = 73728, DP_GC = 108544;
__device__ __forceinline__ void dnprep_unit(Frame& F, int unit) {
    const bf16_t* DQ = (const bf16_t*)(F.ws + WS_DQ); const float* GB = (const float*)(F.ws + WS_AB);
    bf16_t* DNW = (bf16_t*)(F.ws + WS_DNW); bf16_t* DNKC = (bf16_t*)(F.ws + WS_DNKC); bf16_t* DNQG = (bf16_t*)(F.ws + WS_DNQG); bf16_t* DNKGT = (bf16_t*)(F.ws + WS_DNKGT); bf16_t* DNQK = (bf16_t*)(F.ws + WS_DNQK); float* DNGL = (float*)(F.ws + WS_DNGL);
    LAS unsigned char* L = F.lds; LAS float* gcs = (LAS float*)(L + DP_GC); LAS float* bes = gcs + 128; LAS float* AS = (LAS float*)(L + DP_AS);
    const int tid = opaque_tid(), lane = tid & 63, wave = __builtin_amdgcn_readfirstlane(tid >> 6), rr = lane & 15, kg = lane >> 4;
    const int h = unit & 3, cg = (unit >> 2) % DN_NCH, b = (unit >> 2) / DN_NCH, rbase = b * TOK + 64 * cg;
    const size_t pu0 = (size_t)((b * DN_NCH + cg) * 4 + h) * 2;
    if (wave < 2) { const int dir = wave, tok = dir ? 63 - lane : lane; const size_t row = rbase + tok;
        float s = GB[row * 16 + dir * 4 + h]; const float be = GB[row * 16 + 8 + dir * 4 + h];
#pragma unroll
        for (int o = 1; o < 64; o <<= 1) { const float t = __shfl_up(s, o); if (lane >= o) s += t; }
        gcs[dir * 64 + lane] = s; bes[dir * 64 + lane] = be; }
    { const int row = tid >> 3, seg = tid & 7; const bf16_t* src = DQ + (size_t)(rbase + row) * 1536 + h * 128 + seg * 16;
      const u32x4 q0 = *(const u32x4*)src, q1 = *(const u32x4*)(src + 8), k0 = *(const u32x4*)(src + 512), k1 = *(const u32x4*)(src + 520), v0 = *(const u32x4*)(src + 1024), v1 = *(const u32x4*)(src + 1032);
      *(LAS u32x4*)(L + DP_QS + row * 272 + seg * 32) = q0; *(LAS u32x4*)(L + DP_QS + row * 272 + seg * 32 + 16) = q1;
      *(LAS u32x4*)(L + DP_KS + row * 272 + seg * 32) = k0; *(LAS u32x4*)(L + DP_KS + row * 272 + seg * 32 + 16) = k1;
      const unsigned kw[8] = {k0.x, k0.y, k0.z, k0.w, k1.x, k1.y, k1.z, k1.w}, vw[8] = {v0.x, v0.y, v0.z, v0.w, v1.x, v1.y, v1.z, v1.w};
#pragma unroll
      for (int e = 0; e < 8; ++e) { const int d = seg * 16 + 2 * e;
          *(LAS bf16_t*)(L + DP_KT + (d * 72 + row) * 2) = (bf16_t)(kw[e] & 0xffffu); *(LAS bf16_t*)(L + DP_KT + ((d + 1) * 72 + row) * 2) = (bf16_t)(kw[e] >> 16);
          *(LAS bf16_t*)(L + DP_VT + (d * 72 + row) * 2) = (bf16_t)(vw[e] & 0xffffu); *(LAS bf16_t*)(L + DP_VT + ((d + 1) * 72 + row) * 2) = (bf16_t)(vw[e] >> 16); } }
    __syncthreads();
#pragma unroll
    for (int jj = 0; jj < 2; ++jj) {
        const int it = wave >> 1, jt = 2 * (wave & 1) + jj; f32x4 kk = {0.f, 0.f, 0.f, 0.f}, qk = {0.f, 0.f, 0.f, 0.f};
#pragma unroll
        for (int ks = 0; ks < 4; ++ks) { const bf16x8 aK = ldsfrag(L + DP_KS + (16 * jt + rr) * 272 + (32 * ks + 8 * kg) * 2), bK = ldsfrag(L + DP_KS + (16 * it + rr) * 272 + (32 * ks + 8 * kg) * 2), bQ = ldsfrag(L + DP_QS + (16 * it + rr) * 272 + (32 * ks + 8 * kg) * 2);
            kk = mfma16(aK, bK, kk); qk = mfma16(aK, bQ, qk); }
        const int i = 16 * it + rr, jb = 16 * jt + 4 * kg;
        { const float gi = gcs[i], bi = bes[i]; float av[4], qv[4];
#pragma unroll
          for (int r = 0; r < 4; ++r) { const int j = jb + r; const float e = (j <= i) ? __expf(gi - gcs[j]) : 0.f; av[r] = (j < i) ? bi * kk[r] * e : 0.f; qv[r] = qk[r] * e; }
          *(LAS f32x4*)(AS + i * 68 + jb) = (f32x4){av[0], av[1], av[2], av[3]};
          u32x2 w; w.x = pk2(qv[0], qv[1]); w.y = pk2(qv[2], qv[3]); *(u32x2*)(DNQK + (pu0 + 0) * 4096 + i * 64 + jb) = w; }
        { const int i1 = 63 - i; const float gi = gcs[64 + i1], bi = bes[64 + i1]; float av[4], qv[4];
#pragma unroll
          for (int r = 0; r < 4; ++r) { const int j1 = 63 - (jb + r); const float e = (j1 <= i1) ? __expf(gi - gcs[64 + j1]) : 0.f; av[r] = (j1 < i1) ? bi * kk[r] * e : 0.f; qv[r] = qk[r] * e; }
          const int jl = 60 - jb;
          *(LAS f32x4*)(AS + 64 * 68 + i1 * 68 + jl) = (f32x4){av[3], av[2], av[1], av[0]};
          u32x2 w; w.x = pk2(qv[3], qv[2]); w.y = pk2(qv[1], qv[0]); *(u32x2*)(DNQK + (pu0 + 1) * 4096 + i1 * 64 + jl) = w; }
    }
    { const int row = tid >> 3, seg = tid & 7;
#pragma unroll
      for (int dir = 0; dir < 2; ++dir) { const int tok = dir ? 63 - row : row; const float e = __expf(gcs[dir * 64 + row]);
          const u32x4 a0 = *(const LAS u32x4*)(L + DP_QS + tok * 272 + seg * 32), a1 = *(const LAS u32x4*)(L + DP_QS + tok * 272 + seg * 32 + 16);
          u32x4 o0, o1; o0.x = pk2(bflo(a0.x) * e, bfhi(a0.x) * e); o0.y = pk2(bflo(a0.y) * e, bfhi(a0.y) * e); o0.z = pk2(bflo(a0.z) * e, bfhi(a0.z) * e); o0.w = pk2(bflo(a0.w) * e, bfhi(a0.w) * e);
          o1.x = pk2(bflo(a1.x) * e, bfhi(a1.x) * e); o1.y = pk2(bflo(a1.y) * e, bfhi(a1.y) * e); o1.z = pk2(bflo(a1.z) * e, bfhi(a1.z) * e); o1.w = pk2(bflo(a1.w) * e, bfhi(a1.w) * e);
          bf16_t* dst = DNQG + (pu0 + dir) * 8192 + row * 128 + seg * 16; *(u32x4*)dst = o0; *(u32x4*)(dst + 8) = o1; } }
    { const int d = tid >> 2, sg = tid & 3;
#pragma unroll
      for (int dir = 0; dir < 2; ++dir) { const float gl = gcs[dir * 64 + 63]; unsigned ow[8];
#pragma unroll
          for (int e = 0; e < 8; ++e) { const int i0 = 16 * sg + 2 * e, i1 = i0 + 1; const int t0 = dir ? 63 - i0 : i0, t1 = dir ? 63 - i1 : i1;
              const float v0 = bf2f(*(const LAS bf16_t*)(L + DP_KT + (d * 72 + t0) * 2)) * __expf(gl - gcs[dir * 64 + i0]), v1 = bf2f(*(const LAS bf16_t*)(L + DP_KT + (d * 72 + t1) * 2)) * __expf(gl - gcs[dir * 64 + i1]);
              ow[e] = pk2(v0, v1); }
          bf16_t* dst = DNKGT + (pu0 + dir) * 8192 + d * 64 + 16 * sg; *(u32x4*)dst = (u32x4){ow[0], ow[1], ow[2], ow[3]}; *(u32x4*)(dst + 8) = (u32x4){ow[4], ow[5], ow[6], ow[7]}; } }
    if (tid < 2) DNGL[pu0 + tid] = __expf(gcs[tid * 64 + 63]);
    __syncthreads();
    if (wave < 2) { const int dir = wave; const LAS float* A = AS + dir * 64 * 68; f32x2 tp[32]; const int lane3 = opaque_tid() & 63;
#pragma unroll
        for (int i0 = 0; i0 < 64; i0 += 4) { f32x2 ac[4];
#pragma unroll
            for (int r = 0; r < 4; ++r) ac[r] = (f32x2){(i0 + r == lane3) ? 1.f : 0.f, 0.f};
#pragma unroll
            for (int j4 = 0; j4 < i0 / 4; ++j4) {
#pragma unroll
                for (int r = 0; r < 4; ++r) { const f32x4 v = *(const LAS f32x4*)(A + (i0 + r) * 68 + 4 * j4);
                    ac[r] -= (f32x2){v[0], v[1]} * tp[2 * j4]; ac[r] -= (f32x2){v[2], v[3]} * tp[2 * j4 + 1]; }
                asm volatile("" : "+v"(ac[0]), "+v"(ac[1]), "+v"(ac[2]), "+v"(ac[3]) :: "memory"); }
            const f32x4 v1 = *(const LAS f32x4*)(A + (i0 + 1) * 68 + i0), v2 = *(const LAS f32x4*)(A + (i0 + 2) * 68 + i0), v3 = *(const LAS f32x4*)(A + (i0 + 3) * 68 + i0);
            const float t0 = ac[0].x + ac[0].y;
            const float t1 = (ac[1].x + ac[1].y) - v1[0] * t0;
            const float t2 = (ac[2].x + ac[2].y) - v2[0] * t0 - v2[1] * t1;
            const float t3 = (ac[3].x + ac[3].y) - v3[0] * t0 - v3[1] * t1 - v3[2] * t2;
            tp[i0 / 2] = (f32x2){t0, t1}; tp[i0 / 2 + 1] = (f32x2){t2, t3}; }
        const float be = bes[dir * 64 + lane3], bg = be * __expf(gcs[dir * 64 + lane3]); const int tau = dir ? 63 - lane3 : lane3;
        LAS bf16_t* TP = (LAS bf16_t*)(L + (dir * 2 + 0) * 9216); LAS bf16_t* TPP = (LAS bf16_t*)(L + (dir * 2 + 1) * 9216);
#pragma unroll
        for (int k = 0; k < 32; ++k) { TP[(2 * k) * 72 + tau] = (bf16_t)f2bf(tp[k].x * be); TPP[(2 * k) * 72 + tau] = (bf16_t)f2bf(tp[k].x * bg); TP[(2 * k + 1) * 72 + tau] = (bf16_t)f2bf(tp[k].y * be); TPP[(2 * k + 1) * 72 + tau] = (bf16_t)f2bf(tp[k].y * bg); } }
    __syncthreads();
    { const int tid4 = opaque_tid(), lane4 = tid4 & 63, wave4 = __builtin_amdgcn_readfirstlane(tid4 >> 6), rr4 = lane4 & 15, kg4 = lane4 >> 4;
#pragma unroll
    for (int mat = 0; mat < 2; ++mat) { const LAS unsigned char* As_ = L + (mat ? DP_KT : DP_VT); bf16x8 a[2];
#pragma unroll
        for (int ks = 0; ks < 2; ++ks) a[ks] = ldsfrag(As_ + (16 * wave4 + rr4) * 144 + (32 * ks + 8 * kg4) * 2);
#pragma unroll
        for (int dir = 0; dir < 2; ++dir) { const LAS unsigned char* Bs_ = L + (dir * 2 + mat) * 9216; bf16_t* OUT = (mat ? DNKC : DNW) + (pu0 + dir) * 8192;
#pragma unroll
            for (int it = 0; it < 4; ++it) { f32x4 c = {0.f, 0.f, 0.f, 0.f};
#pragma unroll
                for (int ks = 0; ks < 2; ++ks) c = mfma16(a[ks], ldsfrag(Bs_ + (16 * it + rr4) * 144 + (32 * ks + 8 * kg4) * 2), c);
                u32x2 w; w.x = pk2(c[0], c[1]); w.y = pk2(c[2], c[3]); *(u32x2*)(OUT + (16 * it + rr4) * 128 + 16 * wave4 + 4 * kg4) = w; } } } }
    __syncthreads();
}

constexpr int DS_KC = 0, DS_QG = 17408, DS_KGT = 34816, DS_QK = 53248, DS_W = 62464, DS_SB = 79872, DS_VT = 114688;
__device__ __forceinline__ void dnscan_unit(Frame& F, int unit) {
    const bf16_t* DNW = (const bf16_t*)(F.ws + WS_DNW); const bf16_t* DNKC = (const bf16_t*)(F.ws + WS_DNKC); const bf16_t* DNQG = (const bf16_t*)(F.ws + WS_DNQG); const bf16_t* DNKGT = (const bf16_t*)(F.ws + WS_DNKGT); const bf16_t* DNQK = (const bf16_t*)(F.ws + WS_DNQK); const float* DNGL = (const float*)(F.ws + WS_DNGL);
    bf16_t* ODN = (bf16_t*)(F.ws + WS_ODN);
    LAS unsigned char* L = F.lds;
    const int tid = F.tid, lane = F.lane, wave = F.wave, rr = lane & 15, kg = lane >> 4;
    const int dir = unit & 1, h = (unit >> 1) & 3, b = unit >> 3;
    const int mt = wave >> 1, ng = wave & 1;
    f32x4 s[2][4];
#pragma unroll
    for (int di = 0; di < 2; ++di)
#pragma unroll
        for (int j = 0; j < 4; ++j) s[di][j] = (f32x4){0.f, 0.f, 0.f, 0.f};
    for (int i = tid; i < 34816 / 4; i += NWAVES * 64) ((LAS unsigned*)(L + DS_SB))[i] = 0u;
#define DS_CG(t) (dir ? ((t) < 4 ? 3 - (t) : 135 - (t)) : (t))
#define DS_DECL(S) u32x4 rKC##S[2], rQG##S[2], rKGT##S[2], rQK##S, rW##S[2]; float rGL##S = 0.f
#define DS_LOAD(t, S) do { const size_t pu_ = (size_t)((b * DN_NCH + DS_CG(t)) * 4 + h) * 2 + dir; \
        _Pragma("unroll") for (int q_ = 0; q_ < 2; ++q_) { const int id_ = tid + 512 * q_; \
            rKC##S[q_] = *(const u32x4*)(DNKC + pu_ * 8192 + (id_ >> 4) * 128 + (id_ & 15) * 8); rQG##S[q_] = *(const u32x4*)(DNQG + pu_ * 8192 + (id_ >> 4) * 128 + (id_ & 15) * 8); \
            rW##S[q_] = *(const u32x4*)(DNW + pu_ * 8192 + (id_ >> 4) * 128 + (id_ & 15) * 8); \
            rKGT##S[q_] = *(const u32x4*)(DNKGT + pu_ * 8192 + (id_ >> 3) * 64 + (id_ & 7) * 8); } \
        rQK##S = *(const u32x4*)(DNQK + pu_ * 4096 + (tid >> 3) * 64 + (tid & 7) * 8); \
        rGL##S = DNGL[pu_]; } while (0)
#define DS_STORE(S) do { _Pragma("unroll") for (int q_ = 0; q_ < 2; ++q_) { const int id_ = tid + 512 * q_; \
            *(LAS u32x4*)(L + DS_KC + (id_ >> 4) * 272 + (id_ & 15) * 16) = rKC##S[q_]; *(LAS u32x4*)(L + DS_QG + (id_ >> 4) * 272 + (id_ & 15) * 16) = rQG##S[q_]; \
            *(LAS u32x4*)(L + DS_W + (id_ >> 4) * 272 + (id_ & 15) * 16) = rW##S[q_]; \
            *(LAS u32x4*)(L + DS_KGT + (id_ >> 3) * 144 + (id_ & 7) * 16) = rKGT##S[q_]; } \
        *(LAS u32x4*)(L + DS_QK + (tid >> 3) * 144 + (tid & 7) * 16) = rQK##S; gl = rGL##S; } while (0)
#define DS_STEP(t) do { const int cg = DS_CG(t); \
        f32x4 av[4], ao[4]; \
        _Pragma("unroll") for (int j = 0; j < 4; ++j) { av[j] = (f32x4){0.f, 0.f, 0.f, 0.f}; ao[j] = av[j]; } \
        _Pragma("unroll") for (int ks = 0; ks < 4; ++ks) { const bf16x8 akc = ldsfrag(L + DS_KC + (16 * mt + rr) * 272 + (32 * ks + 8 * kg) * 2), aqg = ldsfrag(L + DS_QG + (16 * mt + rr) * 272 + (32 * ks + 8 * kg) * 2); \
            _Pragma("unroll") for (int j = 0; j < 4; ++j) { const bf16x8 bs = ldsfrag(L + DS_SB + (64 * ng + 16 * j + rr) * 272 + (32 * ks + 8 * kg) * 2); av[j] = mfma16(akc, bs, av[j]); ao[j] = mfma16(aqg, bs, ao[j]); } } \
        _Pragma("unroll") for (int j = 0; j < 4; ++j) { float vn[4]; \
            _Pragma("unroll") for (int r = 0; r < 4; ++r) vn[r] = bf2f(*(const LAS bf16_t*)(L + DS_W + (16 * mt + 4 * kg + r) * 272 + (64 * ng + 16 * j + rr) * 2)) - av[j][r]; \
            u32x2 w; w.x = pk2(vn[0], vn[1]); w.y = pk2(vn[2], vn[3]); *(LAS u32x2*)(L + DS_VT + (64 * ng + 16 * j + rr) * 144 + (16 * mt + 4 * kg) * 2) = w; } \
        __syncthreads(); \
        bf16x8 bV[4][2]; \
        _Pragma("unroll") for (int ks = 0; ks < 2; ++ks) { const bf16x8 aqk = ldsfrag(L + DS_QK + (16 * mt + rr) * 144 + (32 * ks + 8 * kg) * 2); \
            _Pragma("unroll") for (int j = 0; j < 4; ++j) { bV[j][ks] = ldsfrag(L + DS_VT + (64 * ng + 16 * j + rr) * 144 + (32 * ks + 8 * kg) * 2); ao[j] = mfma16(aqk, bV[j][ks], ao[j]); } } \
        _Pragma("unroll") for (int j = 0; j < 4; ++j) \
            _Pragma("unroll") for (int r = 0; r < 4; ++r) { const int i = 16 * mt + 4 * kg + r, tok = dir ? 63 - i : i; \
                ODN[((size_t)dir * MROWS + (size_t)(b * TOK + 64 * cg + tok)) * 512 + h * 128 + 64 * ng + 16 * j + rr] = (bf16_t)f2bf(ao[j][r]); } \
        _Pragma("unroll") for (int di = 0; di < 2; ++di) \
            _Pragma("unroll") for (int j = 0; j < 4; ++j) s[di][j] = s[di][j] * gl; \
        _Pragma("unroll") for (int ks = 0; ks < 2; ++ks) \
            _Pragma("unroll") for (int di = 0; di < 2; ++di) { const bf16x8 akg = ldsfrag(L + DS_KGT + (32 * mt + 16 * di + rr) * 144 + (32 * ks + 8 * kg) * 2); \
                _Pragma("unroll") for (int j = 0; j < 4; ++j) s[di][j] = mfma16(akg, bV[j][ks], s[di][j]); } \
        __syncthreads(); \
        _Pragma("unroll") for (int di = 0; di < 2; ++di) \
            _Pragma("unroll") for (int j = 0; j < 4; ++j) { u32x2 w; w.x = pk2(s[di][j][0], s[di][j][1]); w.y = pk2(s[di][j][2], s[di][j][3]); \
                *(LAS u32x2*)(L + DS_SB + (64 * ng + 16 * j + rr) * 272 + (32 * mt + 16 * di + 4 * kg) * 2) = w; } } while (0)
    DS_DECL(A); DS_DECL(B); float gl = 0.f;
    DS_LOAD(0, A); DS_LOAD(1, B); DS_STORE(A);
    __syncthreads();
    for (int t = 0; t < DN_NCH; t += 2) {
        if (t + 2 < DN_NCH) DS_LOAD(t + 2, A);
        DS_STEP(t);
        DS_STORE(B);
        __syncthreads();
        if (t + 3 < DN_NCH) DS_LOAD(t + 3, B);
        DS_STEP(t + 1);
        if (t + 2 < DN_NCH) DS_STORE(A);
        __syncthreads();
    }
#undef DS_CG
#undef DS_DECL
#undef DS_LOAD
#undef DS_STORE
#undef DS_STEP
}

__device__ __forceinline__ float log_sigmoid_f(float x) { return -log1pf(expf(-x)); }
constexpr int RP_QS = 0, RP_KS = 34816;
__device__ __forceinline__ void retprep_unit(Frame& F, int l, int unit) {
    const bf16_t* P = (const bf16_t*)(F.ws + WS_P); bf16_t* RQKD = (bf16_t*)(F.ws + WS_RQKD); bf16_t* RKDT = (bf16_t*)(F.ws + WS_RKDT);
    LAS unsigned char* L = F.lds;
    const int tid = F.tid, lane = F.lane, wave = F.wave, rr = lane & 15, kg = lane >> 4;
    const int h = unit & 3, c = (unit >> 2) % RET_NCH, b = (unit >> 2) / RET_NCH, rbase = b * TOK + 128 * c;
    const size_t pu0 = (size_t)((b * RET_NCH + c) * 4 + h) * 2;
    const float lg0 = log_sigmoid_f(inp(F, I_ret_decay)[l * 8 + h]), lg1 = log_sigmoid_f(inp(F, I_ret_decay)[l * 8 + 4 + h]);
    { const int row = tid >> 2, seg = tid & 3; const bf16_t* src = P + (size_t)(rbase + row) * PW + h * 128 + seg * 32;
#pragma unroll
      for (int q = 0; q < 4; ++q) { *(LAS u32x4*)(L + RP_QS + row * 272 + seg * 64 + q * 16) = *(const u32x4*)(src + C_RQ + q * 8); *(LAS u32x4*)(L + RP_KS + row * 272 + seg * 64 + q * 16) = *(const u32x4*)(src + C_RK + q * 8); } }
    __syncthreads();
    { bf16x8 bQ[4];
#pragma unroll
      for (int ks = 0; ks < 4; ++ks) bQ[ks] = ldsfrag(L + RP_QS + (16 * wave + rr) * 272 + (32 * ks + 8 * kg) * 2);
      const int i = 16 * wave + rr;
      for (int jt = 0; jt < 8; ++jt) { f32x4 cc = {0.f, 0.f, 0.f, 0.f};
#pragma unroll
          for (int ks = 0; ks < 4; ++ks) cc = mfma16(ldsfrag(L + RP_KS + (16 * jt + rr) * 272 + (32 * ks + 8 * kg) * 2), bQ[ks], cc);
          const int jb = 16 * jt + 4 * kg; float v0[4], v1[4];
#pragma unroll
          for (int r = 0; r < 4; ++r) { const int j = jb + r; v0[r] = (j <= i) ? cc[r] * __expf((float)(i - j) * lg0) : 0.f; v1[r] = (j >= i) ? cc[r] * __expf((float)(j - i) * lg1) : 0.f; }
          u32x2 w; w.x = pk2(v0[0], v0[1]); w.y = pk2(v0[2], v0[3]); *(u32x2*)(RQKD + (pu0 + 0) * 16384 + i * 128 + jb) = w;
          w.x = pk2(v1[3], v1[2]); w.y = pk2(v1[1], v1[0]); *(u32x2*)(RQKD + (pu0 + 1) * 16384 + (127 - i) * 128 + (124 - jb)) = w; } }
    { const int d = tid >> 2, sg = tid & 3;
#pragma unroll
      for (int dir = 0; dir < 2; ++dir) { const float lg = dir ? lg1 : lg0;
#pragma unroll
          for (int q = 0; q < 4; ++q) { unsigned ow[4];
#pragma unroll
              for (int e = 0; e < 4; ++e) { const int j0 = 32 * sg + 8 * q + 2 * e, j1 = j0 + 1; const int t0 = dir ? 127 - j0 : j0, t1 = dir ? 127 - j1 : j1;
                  const float a0 = bf2f(*(const LAS bf16_t*)(L + RP_KS + t0 * 272 + d * 2)) * __expf((float)(127 - j0) * lg), a1 = bf2f(*(const LAS bf16_t*)(L + RP_KS + t1 * 272 + d * 2)) * __expf((float)(127 - j1) * lg);
                  ow[e] = pk2(a0, a1); }
              *(u32x4*)(RKDT + (pu0 + dir) * 16384 + d * 128 + 32 * sg + 8 * q) = (u32x4){ow[0], ow[1], ow[2], ow[3]}; } } }
    __syncthreads();
}

constexpr int RS_VS = 0, RS_SB = 36864;
__device__ __forceinline__ s16x4 rs_tr_read(unsigned addr) { s16x4 r; asm volatile("ds_read_b64_tr_b16 %0, %1" : "=&v"(r) : "v"(addr) : "memory"); return r; }
__device__ __forceinline__ bf16x8 rs_scale_frag(bf16x8 f, float sc) { u32x4 w = __builtin_bit_cast(u32x4, f);
    w.x = pk2(bflo(w.x) * sc, bfhi(w.x) * sc); w.y = pk2(bflo(w.y) * sc, bfhi(w.y) * sc); w.z = pk2(bflo(w.z) * sc, bfhi(w.z) * sc); w.w = pk2(bflo(w.w) * sc, bfhi(w.w) * sc); return __builtin_bit_cast(bf16x8, w); }
__device__ __forceinline__ void retscan_unit(Frame& F, int l, int unit) {
    const bf16_t* P = (const bf16_t*)(F.ws + WS_P); const bf16_t* RQKD = (const bf16_t*)(F.ws + WS_RQKD); const bf16_t* RKDT = (const bf16_t*)(F.ws + WS_RKDT); bf16_t* ORET = (bf16_t*)(F.ws + WS_ORET);
    LAS unsigned char* L = F.lds;
    const int tid = F.tid, lane = F.lane, wave = F.wave, rr = lane & 15, kg = lane >> 4;
    const int dir = unit & 1, h = (unit >> 1) & 3, b = unit >> 3;
    const float lg = log_sigmoid_f(inp(F, I_ret_decay)[l * 8 + dir * 4 + h]), gC = __expf(128.f * lg);
    const int irow = 16 * wave + rr;
    const unsigned vtr = (unsigned)(uintptr_t)L + (unsigned)(RS_VS + (8 * kg + (rr >> 2)) * 288 + (4 * (rr & 3)) * 2);
    f32x4 s[8];
#pragma unroll
    for (int j = 0; j < 8; ++j) s[j] = (f32x4){0.f, 0.f, 0.f, 0.f};
    for (int i = tid; i < 34816 / 4; i += NWAVES * 64) ((LAS unsigned*)(L + RS_SB))[i] = 0u;
#define RS_C(t) (dir ? ((t) < 2 ? 1 - (t) : 67 - (t)) : (t))
    bf16x8 fQ[4], fD[4], fK[4]; u32x4 rV[4];
#define RS_FLOAD(t) do { const int c_ = RS_C(t); const size_t pu_ = (size_t)((b * RET_NCH + c_) * 4 + h) * 2 + dir; const size_t rb_ = (size_t)b * TOK + 128 * c_; \
        const bf16_t* q_ = P + (rb_ + (dir ? 127 - irow : irow)) * PW + C_RQ + h * 128 + 8 * kg; const bf16_t* d_ = RQKD + pu_ * 16384 + irow * 128 + 8 * kg; const bf16_t* k_ = RKDT + pu_ * 16384 + irow * 128 + 8 * kg; \
        _Pragma("unroll") for (int ks = 0; ks < 4; ++ks) { fQ[ks] = *(const bf16x8*)(q_ + 32 * ks); fD[ks] = *(const bf16x8*)(d_ + 32 * ks); fK[ks] = *(const bf16x8*)(k_ + 32 * ks); } } while (0)
#define RS_VLOAD(t) do { const size_t rb_ = (size_t)b * TOK + 128 * RS_C(t); \
        _Pragma("unroll") for (int q4 = 0; q4 < 4; ++q4) { const int id_ = tid + 512 * q4, row_ = id_ >> 4; rV[q4] = *(const u32x4*)(P + (rb_ + (dir ? 127 - row_ : row_)) * PW + C_RV + h * 128 + (id_ & 15) * 8); } } while (0)
#define RS_VSTORE() do { _Pragma("unroll") for (int q4 = 0; q4 < 4; ++q4) { const int id_ = tid + 512 * q4; *(LAS u32x4*)(L + RS_VS + (id_ >> 4) * 288 + (id_ & 15) * 16) = rV[q4]; } } while (0)
    float rsc[4];
#pragma unroll
    for (int r = 0; r < 4; ++r) rsc[r] = __expf((float)(16 * wave + 4 * kg + r + 1) * lg);
    RS_FLOAD(0); RS_VLOAD(0); RS_VSTORE(); if (1 < RET_NCH) RS_VLOAD(1);
    __syncthreads();
    for (int t = 0; t < RET_NCH; ++t) {
        const int c = RS_C(t);
#pragma unroll
        for (int nt = 0; nt < 8; ++nt) { bf16x8 bS[4]; s16x4 vl[4], vh[4];
#pragma unroll
            for (int ks = 0; ks < 4; ++ks) { bS[ks] = ldsfrag(L + RS_SB + (16 * nt + rr) * 272 + (32 * ks + 8 * kg) * 2);
                vl[ks] = rs_tr_read(vtr + (unsigned)((32 * ks) * 288 + 32 * nt)); vh[ks] = rs_tr_read(vtr + (unsigned)((32 * ks + 4) * 288 + 32 * nt)); }
            asm volatile("s_waitcnt lgkmcnt(0)" ::: "memory"); __builtin_amdgcn_sched_barrier(0);
            f32x4 o1 = {0.f, 0.f, 0.f, 0.f}, o2 = {0.f, 0.f, 0.f, 0.f}; s[nt] = s[nt] * gC;
#pragma unroll
            for (int ks = 0; ks < 4; ++ks) { const bf16x8 bv = (bf16x8){vl[ks][0], vl[ks][1], vl[ks][2], vl[ks][3], vh[ks][0], vh[ks][1], vh[ks][2], vh[ks][3]};
                o1 = mfma16(fQ[ks], bS[ks], o1); o2 = mfma16(fD[ks], bv, o2); s[nt] = mfma16(fK[ks], bv, s[nt]); }
#pragma unroll
            for (int r = 0; r < 4; ++r) { const int i = 16 * wave + 4 * kg + r, tok = dir ? 127 - i : i;
                ORET[((size_t)dir * MROWS + (size_t)(b * TOK + 128 * c + tok)) * 512 + h * 128 + 16 * nt + rr] = (bf16_t)f2bf(o1[r] * rsc[r] + o2[r]); } }
        if (t + 1 < RET_NCH) RS_FLOAD(t + 1);
        __syncthreads();
#pragma unroll
        for (int nt = 0; nt < 8; ++nt) { u32x2 w; w.x = pk2(s[nt][0], s[nt][1]); w.y = pk2(s[nt][2], s[nt][3]); *(LAS u32x2*)(L + RS_SB + (16 * nt + rr) * 272 + (16 * wave + 4 * kg) * 2) = w; }
        if (t + 1 < RET_NCH) RS_VSTORE();
        __syncthreads();
        if (t + 2 < RET_NCH) RS_VLOAD(t + 2);
    }
#undef RS_C
#undef RS_FLOAD
#undef RS_VLOAD
#undef RS_VSTORE
}

constexpr int ATT_SPLIT = 2304;
__device__ __forceinline__ void attention_phase(Frame& F, int l, bool keep_ctx) {
    const bf16_t* P = (const bf16_t*)(F.ws + WS_P); bf16_t* Y = (bf16_t*)(F.ws + WS_Y); bf16_t* OPART = (bf16_t*)(F.ws + WS_OPART); float* ASTAT = (float*)(F.ws + WS_ASTAT);
    unsigned* qhead = F.ctl + CW_ATTQ + 64 * l; volatile LAS unsigned* slot = F.MISC + 4;
    const unsigned nunits = 1024u + (keep_ctx ? 16u : 0u);
    float mraw; { const float* qn = inp(F, I_att_qn_w) + l * 128; const float* kn = inp(F, I_att_kn_w) + l * 128; float a = fmaxf(fabsf(qn[F.lane]), fabsf(qn[64 + F.lane])), b = fmaxf(fabsf(kn[F.lane]), fabsf(kn[64 + F.lane]));
#pragma unroll
      for (int o = 32; o > 0; o >>= 1) { a = fmaxf(a, __shfl_xor(a, o)); b = fmaxf(b, __shfl_xor(b, o)); }
      mraw = __int_as_float(__builtin_amdgcn_readfirstlane(__float_as_int(128.f * 1.01f * a * b))); }
    const bool fixm = mraw * att::SCALE <= 40.f;
    for (;;) {
        __syncthreads();
        if (F.tid == 0) *slot = __hip_atomic_fetch_add(qhead, 1u, __ATOMIC_RELAXED, __HIP_MEMORY_SCOPE_AGENT);
        __syncthreads();
        const unsigned idx = *slot;
        if (idx >= nunits) break;
        if (idx < 1024u) { const int qb = idx & 31, g = (idx >> 5) & 3, kvh = (idx >> 7) & 1, b = (idx >> 8) & 1, part = 1 - (int)(idx >> 9), hq = kvh * 4 + g;
            const size_t qrow0 = (size_t)b * TOK + CTXL + 256 * qb, krow0 = (size_t)b * TOK + (size_t)part * ATT_SPLIT; const int nkeys = part ? TOK - ATT_SPLIT : ATT_SPLIT;
            if (fixm) att::attn_dense_body<att::bf16, 1024, true>((const att::bf16*)(P + qrow0 * PW + C_AQ + hq * 128), (const att::bf16*)(P + krow0 * PW + C_AK + kvh * 128), (const att::bf16*)(P + krow0 * PW + C_AV + kvh * 128),
                                                  OPART + ((size_t)part * MROWS + qrow0) * 1024 + hq * 128, ASTAT + (((size_t)part * MROWS + qrow0) * 8 + hq) * 2, nkeys, (char*)F.ldsg, 0.f);
            else att::attn_dense_body<att::bf16, 1024, false>((const att::bf16*)(P + qrow0 * PW + C_AQ + hq * 128), (const att::bf16*)(P + krow0 * PW + C_AK + kvh * 128), (const att::bf16*)(P + krow0 * PW + C_AV + kvh * 128),
                                                  OPART + ((size_t)part * MROWS + qrow0) * 1024 + hq * 128, ASTAT + (((size_t)part * MROWS + qrow0) * 8 + hq) * 2, nkeys, (char*)F.ldsg, 0.f); }
        else { const int j = idx - 1024, hq = j & 7, b = j >> 3, kvh = hq >> 2; const size_t qrow0 = (size_t)b * TOK;
            att::attn_dense_body<att::bf16, YW, false>((const att::bf16*)(P + qrow0 * PW + C_AQ + hq * 128), (const att::bf16*)(P + qrow0 * PW + C_AK + kvh * 128), (const att::bf16*)(P + qrow0 * PW + C_AV + kvh * 128),
                                                Y + qrow0 * YW + 1024 + hq * 128, nullptr, CTXL, (char*)F.ldsg, 0.f); }
    }
}

__device__ __forceinline__ void mixepi_phase(Frame& F, int l, bool keep_ctx) {
    const bf16_t* P = (const bf16_t*)(F.ws + WS_P); bf16_t* Y = (bf16_t*)(F.ws + WS_Y); const bf16_t* ORET = (const bf16_t*)(F.ws + WS_ORET); const bf16_t* ODN = (const bf16_t*)(F.ws + WS_ODN);
    const bf16_t* OPART = (const bf16_t*)(F.ws + WS_OPART); const float* ASTAT = (const float*)(F.ws + WS_ASTAT);
    const int lane = F.lane, gw = F.vcu * NWAVES + F.wave, NGW = F.G * NWAVES, c0 = 8 * lane;
    const f32x4 nw0 = *(const f32x4*)(inp(F, I_dn_norm_w) + l * 128 + (c0 & 127)), nw1 = *(const f32x4*)(inp(F, I_dn_norm_w) + l * 128 + (c0 & 127) + 4);
    struct RowIn { u32x4 fa[2], fb[2], gz[2], o1[2], o2[2]; f32x2 s1[2], s2[2]; };
#define MX_VALID(r) ((r) < MROWS && (keep_ctx || ((r) % TOK) >= CTXL))
#define MX_NEXT(r) do { r += NGW; } while ((r) < MROWS && !MX_VALID(r))
#define MX_LOAD(S, r) do { const size_t r_ = (size_t)(r); const bool lat_ = ((r) % TOK) >= CTXL; \
        S.fa[0] = *(const u32x4*)(ORET + r_ * 512 + c0); S.fb[0] = *(const u32x4*)(ORET + ((size_t)MROWS + r_) * 512 + c0); S.gz[0] = *(const u32x4*)(P + r_ * PW + C_RG + c0); \
        S.fa[1] = *(const u32x4*)(ODN + r_ * 512 + c0); S.fb[1] = *(const u32x4*)(ODN + ((size_t)MROWS + r_) * 512 + c0); S.gz[1] = *(const u32x4*)(P + r_ * PW + C_DZ + c0); \
        if (lat_) { _Pragma("unroll") for (int q = 0; q < 2; ++q) { const int ch = lane + 64 * q, hq = ch >> 4; \
            S.s1[q] = *(const f32x2*)(ASTAT + (r_ * 8 + hq) * 2); S.s2[q] = *(const f32x2*)(ASTAT + (((size_t)MROWS + r_) * 8 + hq) * 2); \
            S.o1[q] = *(const u32x4*)(OPART + r_ * 1024 + ch * 8); S.o2[q] = *(const u32x4*)(OPART + ((size_t)MROWS + r_) * 1024 + ch * 8); } } } while (0)
#define MX_PROC(S, r) do { const size_t r_ = (size_t)(r); const bool lat_ = ((r) % TOK) >= CTXL; \
        _Pragma("unroll") for (int grp = 0; grp < 2; ++grp) { const u32x4 fa = S.fa[grp], fb = S.fb[grp], gz = S.gz[grp]; \
            f32x4 o0 = (f32x4){bflo(fa.x) + bflo(fb.x), bfhi(fa.x) + bfhi(fb.x), bflo(fa.y) + bflo(fb.y), bfhi(fa.y) + bfhi(fb.y)}, o1 = (f32x4){bflo(fa.z) + bflo(fb.z), bfhi(fa.z) + bfhi(fb.z), bflo(fa.w) + bflo(fb.w), bfhi(fa.w) + bfhi(fb.w)}; \
            float ss = (o0[0] * o0[0] + o0[1] * o0[1]) + (o0[2] * o0[2] + o0[3] * o0[3]) + (o1[0] * o1[0] + o1[1] * o1[1]) + (o1[2] * o1[2] + o1[3] * o1[3]); \
            const float ri = rsqrtf(sum16(ss) * (1.f / 128.f) + EPS); \
            o0 = o0 * ri; o1 = o1 * ri; if (grp) { o0 = o0 * nw0; o1 = o1 * nw1; } \
            u32x4 w; w.x = pk2(o0[0] * silu_f(bflo(gz.x)), o0[1] * silu_f(bfhi(gz.x))); w.y = pk2(o0[2] * silu_f(bflo(gz.y)), o0[3] * silu_f(bfhi(gz.y))); \
            w.z = pk2(o1[0] * silu_f(bflo(gz.z)), o1[1] * silu_f(bfhi(gz.z))); w.w = pk2(o1[2] * silu_f(bflo(gz.w)), o1[3] * silu_f(bfhi(gz.w))); \
            *(u32x4*)(Y + r_ * YW + grp * 512 + c0) = w; } \
        if (lat_) { constexpr float C = 1.f;     \
            _Pragma("unroll") for (int q = 0; q < 2; ++q) { const int ch = lane + 64 * q; const f32x2 s1 = S.s1[q], s2 = S.s2[q]; const u32x4 o1 = S.o1[q], o2 = S.o2[q]; \
                const float m = fmaxf(s1.x, s2.x), a1 = s1.y * __builtin_amdgcn_exp2f((s1.x - m) * C), a2 = s2.y * __builtin_amdgcn_exp2f((s2.x - m) * C), inv = 1.f / (a1 + a2), w1 = a1 * inv, w2 = a2 * inv; \
                u32x4 w; w.x = pk2(w1 * bflo(o1.x) + w2 * bflo(o2.x), w1 * bfhi(o1.x) + w2 * bfhi(o2.x)); w.y = pk2(w1 * bflo(o1.y) + w2 * bflo(o2.y), w1 * bfhi(o1.y) + w2 * bfhi(o2.y)); \
                w.z = pk2(w1 * bflo(o1.z) + w2 * bflo(o2.z), w1 * bfhi(o1.z) + w2 * bfhi(o2.z)); w.w = pk2(w1 * bflo(o1.w) + w2 * bflo(o2.w), w1 * bfhi(o1.w) + w2 * bfhi(o2.w)); \
                *(u32x4*)(Y + r_ * YW + 1024 + ch * 8) = w; } } } while (0)
    RowIn A, B;
    int r = gw; if (!MX_VALID(r) && r < MROWS) MX_NEXT(r);
    if (r < MROWS) MX_LOAD(A, r);
    while (r < MROWS) {
        int rn = r; MX_NEXT(rn); if (rn < MROWS) MX_LOAD(B, rn);
        MX_PROC(A, r); r = rn; if (r >= MROWS) break;
        rn = r; MX_NEXT(rn); if (rn < MROWS) MX_LOAD(A, rn);
        MX_PROC(B, r); r = rn;
    }
#undef MX_VALID
#undef MX_NEXT
#undef MX_LOAD
#undef MX_PROC
}
constexpr int NSTEPS = 2 + 10 * DEPTH;
#ifndef PH_MASK
#define PH_MASK 0xFFFFF
#endif
#define PH(k) (((PH_MASK) >> (k)) & 1)
struct Args { const float* in[21]; float* out; unsigned char* ws; int s_lo, s_hi; };
__global__ void __launch_bounds__(NWAVES * 64, 2) fwd(Args a) {
    extern __shared__ __attribute__((aligned(16))) unsigned char lds_raw[];
    Frame F;
    F.lds = (LAS unsigned char*)lds_raw; F.ldsg = lds_raw;
    F.MISC = (volatile LAS unsigned*)(F.lds + MISC_OFF);
    F.tid = threadIdx.x; F.lane = F.tid & 63; F.wave = __builtin_amdgcn_readfirstlane(F.tid >> 6);
    F.G = gridDim.x; { const int bx = blockIdx.x; F.vcu = (F.G % 8 == 0) ? (bx % 8) * (F.G / 8) + bx / 8 : bx; }
    F.ws = a.ws; F.ctl = (unsigned*)(a.ws + WS_CTL);
    for (int u = F.tid; u < (LDS_BYTES - RING_BYTES) / 4; u += NWAVES * 64) ((LAS unsigned*)(F.lds + RING_BYTES))[u] = 0u;
    __syncthreads();
    if (F.tid == 0) {
#define PUTP(k, p) do { const unsigned long long v_ = (unsigned long long)(p); F.MISC[16 + 2 * (k)] = (unsigned)v_; F.MISC[17 + 2 * (k)] = (unsigned)(v_ >> 32); } while (0)
        PUTP(0, a.in[0]); PUTP(1, a.in[1]); PUTP(2, a.in[2]); PUTP(3, a.in[3]); PUTP(4, a.in[4]); PUTP(5, a.in[5]); PUTP(6, a.in[6]); PUTP(7, a.in[7]); PUTP(8, a.in[8]); PUTP(9, a.in[9]); PUTP(10, a.in[10]);
        PUTP(11, a.in[11]); PUTP(12, a.in[12]); PUTP(13, a.in[13]); PUTP(14, a.in[14]); PUTP(15, a.in[15]); PUTP(16, a.in[16]); PUTP(17, a.in[17]); PUTP(18, a.in[18]); PUTP(19, a.in[19]); PUTP(20, a.in[20]); PUTP(21, a.out);
#undef PUTP
    }
    __syncthreads();
    XcdBarrier bar; bar.bar = F.ctl + CW_BAR; bar.x = 0; bar.st = nullptr;
    if (MK_ONE_LAUNCH) bar = xcd_barrier_post(F.ctl + CW_BAR, F.MISC + 8);
    const int lo = a.s_lo, hi = a.s_hi;
#define IN(k) (lo <= (k) && (k) < hi)
#define ENTER() do { F.tid = opaque_tid(); F.lane = F.tid & 63; F.wave = __builtin_amdgcn_readfirstlane(F.tid >> 6); F.ws = opaque_ptr(a.ws); F.ctl = (unsigned*)F.ws; } while (0)
#define SEAM(k) do { if (MK_ONE_LAUNCH && IN(k) && IN((k) + 1)) xcd_barrier(bar); } while (0)
#define Hb ((bf16_t*)(F.ws + WS_H))
#define Pb ((bf16_t*)(F.ws + WS_P))
#define Yb ((bf16_t*)(F.ws + WS_Y))
#define Xf ((float*)(F.ws + WS_X))
#define ABf ((float*)(F.ws + WS_AB))
#define MOD ((const float*)(F.ws + WS_MOD))

#ifdef PROBE_MASK
#define PROBE_T0() const unsigned long long t0_ = __builtin_amdgcn_s_memrealtime()
#define PROBE_DELAY(cls) do { if (((PROBE_MASK) >> (cls)) & 1) { const unsigned long long t1_ = __builtin_amdgcn_s_memrealtime(), d_ = t1_ - t0_; while (__builtin_amdgcn_s_memrealtime() - t1_ < d_) __builtin_amdgcn_s_sleep(8); } } while (0)
#else
#define PROBE_T0() do { } while (0)
#define PROBE_DELAY(cls) do { } while (0)
#endif
#define STEP(k, cls, ...) do { if (IN(k)) { PROBE_T0(); { __VA_ARGS__ } SEAM(k); PROBE_DELAY(cls); } } while (0)

    STEP(0, 0, if (PH(0)) { ENTER(); prologue_phase(F); });
    STEP(1, 0, if (PH(1)) { ENTER(); ln_mod_phase<0>(F, 0, false); });
    for (int l = 0; l < DEPTH; ++l) {
        const int sb = 2 + 10 * l; if (sb + 10 <= lo || sb >= hi) continue;
        const bool keep_ctx = l < DEPTH - 1; const int skip = keep_ctx ? 0 : 1;
        STEP(sb + 0, 1, if (PH(2)) { ENTER();
            pg8::Gemm g{Hb, (const bf16_t*)(F.ws + WS_WIN) + (size_t)l * PWPAD * DM, MROWS, PWPAD, DM}; pg8::RowOrder S; S.init(PWPAD / 256, F.G, (int)blockIdx.x, 0);
            pg8::EpiProj E{Pb, ABf};
            pg8::gemm_phase<pg8::EpiProj, pg8::RowOrder, true, true>(F.lds, g, S, E); });
        STEP(sb + 1, 2, if (PH(3)) { ENTER(); rowprep_phase(F, l); });
        STEP(sb + 2, 3,
            if (PH(4)) { ENTER(); for (int u = F.vcu; u < NBATCH * DN_NCH * 4; u += F.G) dnprep_unit(F, u); }
            if (PH(13)) { ENTER(); const int nfive = (NBATCH * DN_NCH * 4) % F.G;
                if (F.vcu >= nfive) for (int u = F.vcu - nfive; u < NBATCH * RET_NCH * 4; u += F.G - nfive) retprep_unit(F, l, u); });
        STEP(sb + 3, 4,
            if (PH(5)) { ENTER(); for (int u = (int)blockIdx.x; u < 16; u += F.G) dnscan_unit(F, u); }
            if (PH(14)) { ENTER(); for (int u = (int)blockIdx.x - 16; u < 16; u += F.G) { if (u >= 0) retscan_unit(F, l, u); } }
            if (PH(6)) { ENTER(); attention_phase(F, l, keep_ctx); });
        STEP(sb + 4, 5, if (PH(7)) { ENTER(); mixepi_phase(F, l, keep_ctx); });
        STEP(sb + 5, 6, if (PH(8)) { ENTER();
            pg8::Gemm g{Yb, (const bf16_t*)(F.ws + WS_WO) + (size_t)l * DM * DM, MROWS, DM, DM}; pg8::RowOrder S; S.init(DM / 256, F.G, (int)blockIdx.x, 1);
            const float* lnw_ = inp(F, I_ln2_w) + (l > 0 ? l - 1 : 0) * DM; const float* lnb_ = inp(F, I_ln2_b) + (l > 0 ? l - 1 : 0) * DM; const float* lns_ = (const float*)(F.ws + WS_LNS);
            pg8::EpiResid E{Xf, MOD + (size_t)(l * 3) * 12288 + 2 * DM, ALPHA, lns_, lnw_, lnb_, l > 0 ? 1 : 0};
            pg8::gemm_phase<pg8::EpiResid, pg8::RowOrder, false, true>(F.lds, g, S, E);
            if (keep_ctx) { ENTER(); ctx_gemm_resid(F, Yb, (const bf16_t*)(F.ws + WS_WO) + (size_t)l * DM * DM, DM, Xf, MOD + (size_t)(l * 3 + 2) * 12288 + 2 * DM, ALPHA, (const float*)(F.ws + WS_LNS), inp(F, I_ln2_w) + (l > 0 ? l - 1 : 0) * DM, inp(F, I_ln2_b) + (l > 0 ? l - 1 : 0) * DM, l > 0 ? 1 : 0); } });
        STEP(sb + 6, 7, if (PH(9)) { ENTER(); ln_mod_phase<1>(F, l, !keep_ctx); });
        STEP(sb + 7, 8, if (PH(10)) { ENTER();
            pg8::Gemm g{Hb, (const bf16_t*)(F.ws + WS_WFI) + (size_t)l * 2 * DFF * DM, MROWS, 2 * DFF, DM}; pg8::RowOrder S; S.init(2 * DFF / 256, F.G, (int)blockIdx.x, skip);
            pg8::EpiSwiglu E{Pb};
            pg8::gemm_phase<pg8::EpiSwiglu, pg8::RowOrder, true, true>(F.lds, g, S, E); });
        STEP(sb + 8, 9, if (PH(11)) { ENTER();
            pg8::Gemm g{Pb, (const bf16_t*)(F.ws + WS_WFO) + (size_t)l * DM * DFF, MROWS, DM, DFF}; pg8::RowOrder S; S.init(DM / 256, F.G, (int)blockIdx.x, 1);
            const float* lnw_ = inp(F, I_ln1_w) + l * DM; const float* lnb_ = inp(F, I_ln1_b) + l * DM; const float* lns_ = (const float*)(F.ws + WS_LNS);
            pg8::EpiResid E{Xf, MOD + (size_t)(l * 3) * 12288 + 5 * DM, ALPHA, lns_, lnw_, lnb_, 1};
            pg8::gemm_phase<pg8::EpiResid, pg8::RowOrder, false, true>(F.lds, g, S, E);
            if (keep_ctx) { ENTER(); ctx_gemm_resid(F, Pb, (const bf16_t*)(F.ws + WS_WFO) + (size_t)l * DM * DFF, DFF, Xf, MOD + (size_t)(l * 3 + 2) * 12288 + 5 * DM, ALPHA, (const float*)(F.ws + WS_LNS), inp(F, I_ln1_w) + l * DM, inp(F, I_ln1_b) + l * DM, 1); } });
        STEP(sb + 9, 10, if (PH(12)) { ENTER(); if (keep_ctx) ln_mod_phase<2>(F, l, false); else ln_mod_phase<3>(F, l, true); });
    }
#undef STEP
#undef PROBE_T0
#undef PROBE_DELAY
#undef IN
#undef SEAM
#undef ENTER
#undef Hb
#undef Pb
#undef Yb
#undef Xf
#undef ABf
#undef MOD
}

extern "C" void kernel_launch(void* const* d_in, const int* in_sizes, int n_in, void* d_out, int out_size, void* d_ws, size_t ws_size, hipStream_t stream) {
    static int grid = 0;
    if (grid == 0) {
        if (n_in != 21 || in_sizes[0] != NBATCH * SEQ * DM || out_size != NBATCH * SEQ * DM || ws_size < WS_END) {
            fprintf(stderr, "kernel_launch: shape mismatch: n_in %d in0 %d out %d ws %zu (need >= %zu)\n", n_in, n_in > 0 ? in_sizes[0] : -1, out_size, ws_size, (size_t)WS_END); grid = -1; return; }
        int dev = 0, cus = 0, per_cu = 0;
        if (hipGetDevice(&dev) != hipSuccess || hipDeviceGetAttribute(&cus, hipDeviceAttributeMultiprocessorCount, dev) != hipSuccess) { fprintf(stderr, "kernel_launch: device query failed\n"); grid = -1; return; }
        if (hipFuncSetAttribute((const void*)fwd, hipFuncAttributeMaxDynamicSharedMemorySize, LDS_BYTES) != hipSuccess) { fprintf(stderr, "kernel_launch: hipFuncSetAttribute failed\n"); grid = -1; return; }
        if (hipOccupancyMaxActiveBlocksPerMultiprocessor(&per_cu, (const void*)fwd, NWAVES * 64, LDS_BYTES) != hipSuccess || per_cu < 1)
            fprintf(stderr, "kernel_launch: note: occupancy query reports %d workgroups per CU\n", per_cu);
        (void)hipGetLastError();
        grid = cus;
    }
    if (grid < 0) return;
    if (hipMemsetAsync((char*)d_ws + WS_CTL, 0, CTL_ZERO_BYTES, stream) != hipSuccess) { fprintf(stderr, "kernel_launch: memset failed\n"); return; }
    Args a{};
    for (int i = 0; i < 21; ++i) a.in[i] = (const float*)d_in[i];
    a.out = (float*)d_out; a.ws = (unsigned char*)d_ws;
#if MK_ONE_LAUNCH
    a.s_lo = 0; a.s_hi = NSTEPS;
    hipLaunchKernelGGL(fwd, dim3(grid), dim3(NWAVES * 64), LDS_BYTES, stream, a);
#else
    for (int s = 0; s < NSTEPS; ++s) { a.s_lo = s; a.s_hi = s + 1; hipLaunchKernelGGL(fwd, dim3(grid), dim3(NWAVES * 64), LDS_BYTES, stream, a); }
#endif
    const hipError_t le = hipPeekAtLastError();
    if (le != hipSuccess) fprintf(stderr, "kernel_launch: launch failed: %s\n", hipGetErrorName(le));
}
```

```cpp
#include <hip/hip_runtime.h>
#include <hip/hip_bf16.h>
#include <cstdio>
#include <cstdint>

#ifndef MK_ONE_LAUNCH
#define MK_ONE_LAUNCH 1
#endif

constexpr int DM = 2048, NBATCH = 2, SEQ = 8192, CTXL = 256, TOK = CTXL + SEQ  , MROWS = NBATCH * TOK  , DEPTH = 4;
constexpr int HD = 128, DFF = 5632, PW = 5632  , PWPAD = 5888, PROJ_SRC = 5648;
constexpr int C_RQ = 0, C_RK = 512, C_RV = 1024, C_RG = 1536, C_DQKV = 2048, C_DZ = 3584, C_AQ = 4096, C_AK = 5120, C_AV = 5376;
constexpr int YW = 2048;
constexpr float ALPHA = 1.6817928305074292f;
constexpr float EPS = 1e-6f;
constexpr int DN_NCH = TOK / 64  , RET_NCH = TOK / 128  ;
constexpr int DN_PU = NBATCH * DN_NCH * 4 * 2  , RET_PU = NBATCH * RET_NCH * 4 * 2  ;

constexpr size_t MiB = 1u << 20;
constexpr size_t WS_CTL = 0, CTL_ZERO_BYTES = 1 * MiB;
constexpr size_t WS_MOD = 1 * MiB;
constexpr size_t WS_WIN = 2 * MiB;
constexpr size_t WS_WO = 94 * MiB;
constexpr size_t WS_WFI = 126 * MiB;
constexpr size_t WS_WFO = 302 * MiB;
constexpr size_t WS_X = 390 * MiB;
constexpr size_t WS_H = 522 * MiB;
constexpr size_t WS_P = 588 * MiB;
constexpr size_t WS_AB = 770 * MiB;
constexpr size_t WS_Y = 772 * MiB;
constexpr size_t WS_DQ = 838 * MiB;
constexpr size_t WS_DNW = 888 * MiB, WS_DNKC = 921 * MiB, WS_DNQG = 954 * MiB, WS_DNKGT = 987 * MiB;
constexpr size_t WS_DNQK = 1020 * MiB;
constexpr size_t WS_DNGL = 1037 * MiB;
constexpr size_t WS_ODN = 1038 * MiB;
constexpr size_t WS_ORET = 1104 * MiB;
constexpr size_t WS_RQKD = 1170 * MiB, WS_RKDT = 1203 * MiB;
constexpr size_t WS_OPART = 1236 * MiB;
constexpr size_t WS_ASTAT = 1302 * MiB;
constexpr size_t WS_LNS = 1305 * MiB;
constexpr size_t WS_END = 1306 * MiB;
static_assert(WS_WIN + (size_t)DEPTH * PWPAD * DM * 2 <= WS_WO && WS_WO + (size_t)DEPTH * DM * DM * 2 <= WS_WFI && WS_WFI + (size_t)DEPTH * 2 * DFF * DM * 2 <= WS_WFO && WS_WFO + (size_t)DEPTH * DM * DFF * 2 <= WS_X, "ws map (weights)");
static_assert(WS_X + (size_t)MROWS * DM * 4 <= WS_H && WS_H + (size_t)MROWS * DM * 2 <= WS_P && WS_P + (size_t)MROWS * PW * 2 <= WS_AB && WS_AB + (size_t)MROWS * 64 <= WS_Y && WS_Y + (size_t)MROWS * YW * 2 <= WS_DQ && WS_DQ + (size_t)MROWS * 1536 * 2 <= WS_DNW, "ws map (activations)");
static_assert(WS_DNW + (size_t)DN_PU * 16384 <= WS_DNKC && WS_DNQK + (size_t)DN_PU * 8192 <= WS_DNGL && WS_ODN + (size_t)2 * MROWS * 512 * 4 <= WS_ORET && WS_ORET + (size_t)2 * MROWS * 512 * 4 <= WS_RQKD && WS_RQKD + (size_t)RET_PU * 32768 <= WS_RKDT && WS_RKDT + (size_t)RET_PU * 32768 <= WS_END, "ws map (mixers)");
constexpr int CW_BAR = 4096;
constexpr int CW_ATTQ = 16384;

constexpr int RING_BYTES = 143360;
constexpr int MISC_OFF = RING_BYTES + 320;
constexpr int LDS_BYTES = 147456;
constexpr int NWAVES = 8;

#define GAS __attribute__((address_space(1)))
#define LAS __attribute__((address_space(3)))
typedef unsigned short bf16_t;
typedef short bf16x8 __attribute__((ext_vector_type(8)));
typedef short s16x4 __attribute__((ext_vector_type(4)));
typedef float f32x4 __attribute__((ext_vector_type(4)));
typedef float f32x2 __attribute__((ext_vector_type(2)));
typedef unsigned u32x4 __attribute__((ext_vector_type(4)));
typedef unsigned u32x2 __attribute__((ext_vector_type(2)));
#define LDS_WAIT() asm volatile("s_waitcnt lgkmcnt(0)" ::: "memory")
#define VM_WAIT() asm volatile("s_waitcnt vmcnt(0)" ::: "memory")
typedef float f32x2_cv __attribute__((ext_vector_type(2))); typedef __bf16 bf16x2_cv __attribute__((ext_vector_type(2)));
__device__ __forceinline__ unsigned pk2(float lo, float hi) { const bf16x2_cv r = __builtin_convertvector((f32x2_cv){lo, hi}, bf16x2_cv); return __builtin_bit_cast(unsigned, r); }
__device__ __forceinline__ unsigned f2bf(float f) { return pk2(f, 0.f) & 0xffffu; }
__device__ __forceinline__ float bf2f(unsigned short b) { return __builtin_bit_cast(float, ((unsigned)b) << 16); }
__device__ __forceinline__ float bflo(unsigned w) { return __builtin_bit_cast(float, w << 16); }
__device__ __forceinline__ float bfhi(unsigned w) { return __builtin_bit_cast(float, w & 0xffff0000u); }
__device__ __forceinline__ int opaque_tid() { int t = (int)threadIdx.x; asm volatile("" : "+v"(t)); return t; }
__device__ __forceinline__ unsigned char* opaque_ptr(unsigned char* p) { unsigned long long v = (unsigned long long)p; asm volatile("" : "+s"(v)); return (unsigned char*)(GAS unsigned char*)v; }
__device__ __forceinline__ float wave_sum(float v) {
#pragma unroll
    for (int o = 1; o < 64; o <<= 1) v += __shfl_xor(v, o);
    return v;
}
__device__ __forceinline__ float sum16(float v) { v += __shfl_xor(v, 1); v += __shfl_xor(v, 2); v += __shfl_xor(v, 4); v += __shfl_xor(v, 8); return v; }
__device__ __forceinline__ float silu_f(float x) { return x * __builtin_amdgcn_rcpf(1.f + __expf(-x)); }
__device__ __forceinline__ f32x4 mfma16(bf16x8 a, bf16x8 b, f32x4 c) { return __builtin_amdgcn_mfma_f32_16x16x32_bf16(a, b, c, 0, 0, 0); }
__device__ __forceinline__ bf16x8 ldsfrag(const LAS unsigned char* p) { return *(const LAS bf16x8*)p; }

#define XB_TMO      128
#define XB_XCNT(j)  (256  + 64 * (j))
#define XB_XSUB(j)  (1280 + 64 * (j))
#define XB_XGEN(j)  (2304 + 64 * (j))
#define XB_TOP      3328
#define XB_TOPGEN   3392
#define XCD_BAR_WORDS 3456
#define XB_SPIN_CAP (1u << 18)
__device__ __forceinline__ unsigned xb_ld(unsigned* p)              { return __hip_atomic_load(p, __ATOMIC_RELAXED, __HIP_MEMORY_SCOPE_AGENT); }
__device__ __forceinline__ unsigned xb_add(unsigned* p, unsigned v) { return __hip_atomic_fetch_add(p, v, __ATOMIC_RELAXED, __HIP_MEMORY_SCOPE_AGENT); }
__device__ __forceinline__ unsigned xb_xcc_id() { return (unsigned)__builtin_amdgcn_s_getreg((3 << 11) | 20) & 0xFu; }
#define XB_SPIN(cond, bar) do { unsigned _sp = 0; while (cond) { __builtin_amdgcn_s_sleep(1); \
    if ((++_sp & 255u) == 0u) { if (xb_ld(&(bar)[XB_TMO])) break; if (_sp > XB_SPIN_CAP) { atomicAdd(&(bar)[XB_TMO], 1u); break; } } } } while (0)
struct XcdBarrier { unsigned* bar; unsigned x; volatile LAS unsigned* st; };
__device__ __forceinline__ XcdBarrier xcd_barrier_post(unsigned* bar, volatile LAS unsigned* st) {
    XcdBarrier b; b.bar = bar; b.x = xb_xcc_id(); b.st = st;
    if (threadIdx.x == 0) (void)xb_add(&bar[XB_XCNT(b.x)], 1u);
    return b;
}
__device__ __forceinline__ void xcd_barrier_complete(unsigned* bar, unsigned x, unsigned& nloc, unsigned& nx) {
    const unsigned G = gridDim.x * gridDim.y * gridDim.z;
    unsigned sum, cnt, mine, sp = 0u;
    for (;;) {
        sum = 0u; cnt = 0u; mine = 0u;
#pragma unroll
        for (unsigned j = 0; j < 16; ++j) { const unsigned c = xb_ld(&bar[XB_XCNT(j)]); sum += c; cnt += (c > 0u) ? 1u : 0u; mine = (j == x) ? c : mine; }
        if (sum == G) break;
        __builtin_amdgcn_s_sleep(1);
        if ((++sp & 255u) == 0u) { if (xb_ld(&bar[XB_TMO])) break; if (sp > XB_SPIN_CAP) { atomicAdd(&bar[XB_TMO], 1u); break; } }
    }
    nloc = mine > 0u ? mine : 1u; nx = cnt > 0u ? cnt : 1u;
}
__device__ __forceinline__ void xcd_barrier(const XcdBarrier& b) {
    asm volatile("s_waitcnt vmcnt(0)" ::: "memory");
    __syncthreads();
    if (threadIdx.x == 0) {
        unsigned* bar = b.bar;
        __builtin_amdgcn_s_waitcnt(0);
        unsigned nloc = b.st[0], nx = b.st[1];
        if (nloc == 0u) { xcd_barrier_complete(bar, b.x, nloc, nx); b.st[0] = nloc; b.st[1] = nx; }
        const unsigned old = xb_add(&bar[XB_XSUB(b.x)], 1u);
        const unsigned gen = old / nloc;
        if (old + 1u == (gen + 1u) * nloc) {
            __builtin_amdgcn_fence(__ATOMIC_RELEASE, "agent");
            asm volatile("s_waitcnt vmcnt(0)" ::: "memory");
            const unsigned og = xb_add(&bar[XB_TOP], 1u);
            const unsigned tg = og / nx;
            if (og + 1u == (tg + 1u) * nx) xb_add(&bar[XB_TOPGEN], 1u);
            else XB_SPIN(xb_ld(&bar[XB_TOPGEN]) == tg, bar);
            __builtin_amdgcn_fence(__ATOMIC_ACQUIRE, "agent");
            xb_add(&bar[XB_XGEN(b.x)], 1u);
            asm volatile("s_waitcnt vmcnt(0)" ::: "memory");
        } else {
            XB_SPIN(xb_ld(&bar[XB_XGEN(b.x)]) == gen, bar);
            __builtin_amdgcn_fence(__ATOMIC_ACQUIRE, "agent");
            asm volatile("s_waitcnt vmcnt(0)" ::: "memory");
        }
    }
    __syncthreads();
}
namespace pg8 {
#define PG8_LAS __attribute__((address_space(3)))
typedef unsigned short bf16_t;
typedef short bf16x8 __attribute__((ext_vector_type(8)));
typedef float f32x4 __attribute__((ext_vector_type(4)));
typedef unsigned u32x4 __attribute__((ext_vector_type(4)));
constexpr int BM = 256, BK = 64, HALF = 128, HTB = HALF * BK * 2  , STAGE_BYTES = 8 * HTB, NXCD = 8, WGM = 8;

__host__ __device__ __forceinline__ int lds_byte(int r, int c) { const int st = (r >> 4) * 2 + (c >> 5), rr = r & 15, cc = c & 31, ob = rr * 64 + cc * 2; return st * 1024 + (ob ^ (((ob >> 9) & 1) << 5)); }
__host__ __device__ __forceinline__ void stage_rc(int b, int& R, int& C) { const int st = b / 1024, sb = b % 1024, swz = sb ^ (((sb >> 9) & 1) << 5); R = (st >> 1) * 16 + swz / 64; C = (st & 1) * 32 + (swz % 64) / 2; }
__host__ __device__ __forceinline__ int perm32(int rho) { const int n = rho >> 4, i = rho & 15; return 8 * (i >> 2) + 4 * n + (i & 3); }

struct Unit { int pm, pn; };
struct Gemm { const bf16_t* A; const bf16_t* Bt; int M, N, K; };

struct StaticOrder {
    int nM, nN, nwg, G, c;
    __host__ __device__ void init(int M, int N, int G_, int c_) { nM = M / BM; nN = N / BM; nwg = nM * nN; G = G_; c = c_; }
    __host__ __device__ bool next(int i, Unit& u) const {
        const long L = (long)i * G + c; if (L >= nwg) return false;
        int wgid = (int)L; { const int q = nwg / NXCD, r = nwg % NXCD, xcd = wgid % NXCD, off = wgid / NXCD; wgid = (xcd < r ? xcd * (q + 1) : r * (q + 1) + (xcd - r) * q) + off; }
        const int nig = WGM * nN, gid = wgid / nig, fm = gid * WGM, gsz = (nM - fm) < WGM ? (nM - fm) : WGM;
        u.pm = fm + ((wgid % nig) % gsz); u.pn = (wgid % nig) / gsz; return true;
    }
    __device__ __forceinline__ void a_ready(const Unit&) const {}
    __device__ __forceinline__ void done(const Unit&) const {}
};

__device__ __forceinline__ unsigned cvt_pk_bf16(float lo, float hi) { return ::pk2(lo, hi); }
typedef float f32x2 __attribute__((ext_vector_type(2)));
struct RowOrder {
    int nM, nN, nwg, G, c, skip;
    __device__ __forceinline__ void init(int nN_, int G_, int c_, int skip_) { skip = skip_; nM = skip_ ? 64 : 66; nN = nN_; nwg = nM * nN; G = G_; c = c_; }
    __device__ __forceinline__ bool next(int i, Unit& u) const {
        const long L = (long)i * G + c; if (L >= nwg) return false;
        int wgid = (int)L; { const int q = nwg / NXCD, r = nwg % NXCD, xcd = wgid % NXCD, off = wgid / NXCD; wgid = (xcd < r ? xcd * (q + 1) : r * (q + 1) + (xcd - r) * q) + off; }
        const int nig = WGM * nN, gid = wgid / nig, fm = gid * WGM, gsz = (nM - fm) < WGM ? (nM - fm) : WGM;
        int pm = fm + ((wgid % nig) % gsz); u.pn = (wgid % nig) / gsz;
        if (skip) pm = pm + 1 + (pm >= 32 ? 1 : 0);
        u.pm = pm; return true;
    }
    __device__ __forceinline__ void a_ready(const Unit&) const {}
    __device__ __forceinline__ void done(const Unit&) const {}
};
struct EpiProj {
    static constexpr bool PERM = true, AFTER_DRAIN = false;
    bf16_t* P; float* AB;
    __device__ __forceinline__ void operator()(const f32x4 (&acc)[2][2][4][2], const Unit& u, int wr, int wc, int fr, int fq) const {
        const int row0 = u.pm * BM + wr * 64 + fr;
        if (u.pn < 22) {
            const int col0 = u.pn * BM + wc * 32 + 8 * fq;
#pragma unroll
            for (int ai = 0; ai < 2; ++ai)
#pragma unroll
                for (int m = 0; m < 4; ++m) { bf16_t* rowp = P + (size_t)(row0 + ai * HALF + m * 16) * 5632 + col0;
#pragma unroll
                    for (int bj = 0; bj < 2; ++bj) { const f32x4 v0 = acc[ai][bj][m][0], v1 = acc[ai][bj][m][1];
                        u32x4 w; w.x = cvt_pk_bf16(v0[0], v0[1]); w.y = cvt_pk_bf16(v0[2], v0[3]); w.z = cvt_pk_bf16(v1[0], v1[1]); w.w = cvt_pk_bf16(v1[2], v1[3]);
                        *(u32x4*)(rowp + bj * HALF) = w; } }
        } else if (wc == 0 && fq < 2) {
#pragma unroll
            for (int ai = 0; ai < 2; ++ai)
#pragma unroll
                for (int m = 0; m < 4; ++m) { float* rp = AB + (size_t)(row0 + ai * HALF + m * 16) * 16 + 8 * fq;
                    *(f32x4*)rp = acc[ai][0][m][0]; *(f32x4*)(rp + 4) = acc[ai][0][m][1]; }
        }
    }
};
struct EpiResid {
    static constexpr bool PERM = false, AFTER_DRAIN = false;
    float* X; const float* gate; float alpha; const float* stats; const float* lnw; const float* lnb; int ln;
    __device__ __forceinline__ void operator()(const f32x4 (&acc)[2][2][4][2], const Unit& u, int wr, int wc, int fr, int fq) const {
        const int s = (u.pm % 33 == 0) ? 2 : u.pm / 33; const float* g = gate + (size_t)s * 12288;
        const int row0 = u.pm * BM + wr * 64 + fr, col0 = u.pn * BM + wc * 32 + 4 * fq;
        f32x2 st[2][4];
#pragma unroll
        for (int ai = 0; ai < 2; ++ai)
#pragma unroll
            for (int m = 0; m < 4; ++m) st[ai][m] = ln ? *(const f32x2*)(stats + (size_t)(row0 + ai * HALF + m * 16) * 2) : (f32x2){0.f, 1.f};
#pragma unroll
        for (int bj = 0; bj < 2; ++bj)
#pragma unroll
            for (int n = 0; n < 2; ++n) { const int cc = col0 + bj * HALF + n * 16; const f32x4 gv = *(const f32x4*)(g + cc);
                const f32x4 w4 = ln ? *(const f32x4*)(lnw + cc) : (f32x4){1.f, 1.f, 1.f, 1.f}, b4 = ln ? *(const f32x4*)(lnb + cc) : (f32x4){0.f, 0.f, 0.f, 0.f};
#pragma unroll
                for (int ai = 0; ai < 2; ++ai) { f32x4 xr[4];
#pragma unroll
                    for (int m = 0; m < 4; ++m) xr[m] = *(const f32x4*)(X + (size_t)(row0 + ai * HALF + m * 16) * 2048 + cc);
                    asm volatile("" ::: "memory");
#pragma unroll
                    for (int m = 0; m < 4; ++m) { const f32x4 xl = (xr[m] - st[ai][m].x) * st[ai][m].y * w4 + b4;
                        *(f32x4*)(X + (size_t)(row0 + ai * HALF + m * 16) * 2048 + cc) = xl * alpha + gv * acc[ai][bj][m][n]; }
                    asm volatile("" ::: "memory"); } }
    }
};
__device__ __forceinline__ float silu_mul(float g, float u) { return g * u * __builtin_amdgcn_rcpf(1.f + __expf(-g)); }
struct EpiSwiglu {
    static constexpr bool PERM = true, AFTER_DRAIN = false;
    bf16_t* G;
    __device__ __forceinline__ void operator()(const f32x4 (&acc)[2][2][4][2], const Unit& u, int wr, int wc, int fr, int fq) const {
        const int row0 = u.pm * BM + wr * 64 + fr, col0 = u.pn * HALF + wc * 32 + 8 * fq;
#pragma unroll
        for (int ai = 0; ai < 2; ++ai)
#pragma unroll
            for (int m = 0; m < 4; ++m) { bf16_t* rowp = G + (size_t)(row0 + ai * HALF + m * 16) * 5632 + col0;
                const f32x4 g0 = acc[ai][0][m][0], g1 = acc[ai][0][m][1], u0 = acc[ai][1][m][0], u1 = acc[ai][1][m][1];
                u32x4 w; w.x = cvt_pk_bf16(silu_mul(g0[0], u0[0]), silu_mul(g0[1], u0[1])); w.y = cvt_pk_bf16(silu_mul(g0[2], u0[2]), silu_mul(g0[3], u0[3]));
                w.z = cvt_pk_bf16(silu_mul(g1[0], u1[0]), silu_mul(g1[1], u1[1])); w.w = cvt_pk_bf16(silu_mul(g1[2], u1[2]), silu_mul(g1[3], u1[3]));
                *(u32x4*)rowp = w; }
    }
};
template <class Epi, class Sched, bool ALIGN_EPI = false, bool SP2 = false>
__device__ __forceinline__ void gemm_phase(PG8_LAS unsigned char* lds, const Gemm g, const Sched& S, const Epi& E) {
    const int tid = opaque_tid(), wid = __builtin_amdgcn_readfirstlane(tid >> 6), lane = tid & 63, wr = wid >> 2, wc = wid & 3, fr = lane & 15, fq = lane >> 4;
    const int K = g.K, nt = K / BK;
    unsigned voffA[2], voffB[2];
#pragma unroll
    for (int i = 0; i < 2; ++i) { int R, C; stage_rc(tid * 16 + i * 8192, R, C); const int Rb = Epi::PERM ? ((R & ~31) + perm32(R & 31)) : R;
        voffA[i] = (unsigned)(R * K + C) * 2u; voffB[i] = (unsigned)(Rb * K + C) * 2u; }
    const size_t kstep = (size_t)(BK * 2);
    const size_t hstep = (size_t)HALF * K * 2;
    const size_t tstep = 2 * hstep;
    const unsigned ldsw = (unsigned)wid * 1024u;
    const int aoff = lds_byte(wr * 64 + fr, fq * 8), boff = lds_byte(wc * 32 + fr, fq * 8);
#define PG8_SA(b, h) (((b) * 2 + (h)) * HTB)
#define PG8_SB(b, h) ((4 + (b) * 2 + (h)) * HTB)
#define PG8_STAGE(bufoff, gbase, voff) do { _Pragma("unroll") for (int _i = 0; _i < 2; ++_i) \
        __builtin_amdgcn_global_load_lds((const unsigned*)((const char*)(gbase) + (voff)[_i]), (PG8_LAS unsigned*)(lds + (bufoff) + ldsw + _i * 8192), 16, 0, 0); } while (0)
#define PG8_LDA(dst, b, h) do { _Pragma("unroll") for (int m = 0; m < 4; ++m) _Pragma("unroll") for (int k = 0; k < 2; ++k) dst[m][k] = *(const PG8_LAS bf16x8*)(lds + PG8_SA(b, h) + aoff + m * 2048 + k * 1024); } while (0)
#define PG8_LDB(dst, b, h) do { _Pragma("unroll") for (int n = 0; n < 2; ++n) _Pragma("unroll") for (int k = 0; k < 2; ++k) dst[n][k] = *(const PG8_LAS bf16x8*)(lds + PG8_SB(b, h) + boff + n * 2048 + k * 1024); } while (0)
#define PG8_MMA(ai, bj, At, Bt) do { __builtin_amdgcn_s_setprio(1); _Pragma("unroll") for (int m = 0; m < 4; ++m) _Pragma("unroll") for (int n = 0; n < 2; ++n) _Pragma("unroll") for (int k = 0; k < 2; ++k) \
        acc[ai][bj][m][n] = __builtin_amdgcn_mfma_f32_16x16x32_bf16(Bt[n][k], At[m][k], acc[ai][bj][m][n], 0, 0, 0); __builtin_amdgcn_s_setprio(0); } while (0)
#define PG8_WAIT_V(n) asm volatile("s_waitcnt vmcnt(" #n ")" ::: "memory")
#define PG8_WAIT_L(n) asm volatile("s_waitcnt lgkmcnt(" #n ")" ::: "memory")
#define PG8_BAR __builtin_amdgcn_s_barrier()
#define PG8_SCHED __builtin_amdgcn_sched_barrier(0)
    Unit cur, nxt; int ui = 0;
    if (!S.next(0, cur)) return;
    f32x4 acc[2][2][4][2];
#pragma unroll
    for (int a = 0; a < 2; ++a)
#pragma unroll
        for (int b = 0; b < 2; ++b)
#pragma unroll
            for (int m = 0; m < 4; ++m)
#pragma unroll
                for (int n = 0; n < 2; ++n) acc[a][b][m][n] = (f32x4){0.f, 0.f, 0.f, 0.f};
    bf16x8 At[4][2], B0[2][2], B1[2][2];
    const char* cA = (const char*)g.A + (size_t)cur.pm * tstep; const char* cB = (const char*)g.Bt + (size_t)cur.pn * tstep;
    S.a_ready(cur);
    if constexpr (SP2) {
        PG8_STAGE(PG8_SB(0, 0), cB, voffB); PG8_STAGE(PG8_SB(0, 1), cB + hstep, voffB); PG8_STAGE(PG8_SA(0, 0), cA, voffA); PG8_STAGE(PG8_SA(0, 1), cA + hstep, voffA);
        if (wr == 1) PG8_BAR;
        PG8_WAIT_V(2); PG8_BAR;
        PG8_STAGE(PG8_SB(1, 0), cB + kstep, voffB); PG8_STAGE(PG8_SA(1, 0), cA + kstep, voffA); PG8_STAGE(PG8_SB(1, 1), cB + hstep + kstep, voffB);
        PG8_WAIT_V(6); PG8_BAR;
    } else {
        PG8_STAGE(PG8_SB(0, 0), cB, voffB); PG8_STAGE(PG8_SA(0, 0), cA, voffA); PG8_STAGE(PG8_SB(0, 1), cB + hstep, voffB); PG8_STAGE(PG8_SA(0, 1), cA + hstep, voffA);
        if (wr == 1) PG8_BAR;
        PG8_WAIT_V(4); PG8_BAR;
        PG8_STAGE(PG8_SB(1, 0), cB + kstep, voffB); PG8_STAGE(PG8_SA(1, 0), cA + kstep, voffA); PG8_STAGE(PG8_SB(1, 1), cB + hstep + kstep, voffB);
        PG8_WAIT_V(6); PG8_BAR;
    }
    for (;;) {
        const bool has_next = S.next(ui + 1, nxt);
        const char* nA = has_next ? (const char*)g.A + (size_t)nxt.pm * tstep : cA; const char* nB = has_next ? (const char*)g.Bt + (size_t)nxt.pn * tstep : cB;
        for (int t = 0; t < nt; t += 2) {
            const bool last = (t == nt - 2);
            const char* a1 = cA + (size_t)(t + 1) * kstep;
            const char* a2 = last ? nA : cA + (size_t)(t + 2) * kstep; const char* b2 = last ? nB : cB + (size_t)(t + 2) * kstep;
            const char* a3 = a2 + kstep; const char* b3 = b2 + kstep;
            if (last && has_next) S.a_ready(nxt);
            if constexpr (SP2) {
            PG8_LDB(B0, 0, 0); PG8_LDB(B1, 0, 1); PG8_SCHED; PG8_LDA(At, 0, 0); PG8_STAGE(PG8_SA(1, 1), a1 + hstep, voffA);
            PG8_WAIT_V(8); PG8_WAIT_L(0); PG8_BAR; PG8_MMA(0, 0, At, B0); PG8_MMA(0, 1, At, B1); PG8_BAR; PG8_SCHED;
            PG8_LDA(At, 0, 1); PG8_STAGE(PG8_SB(0, 0), b2, voffB); PG8_STAGE(PG8_SB(0, 1), b2 + hstep, voffB); PG8_STAGE(PG8_SA(0, 0), a2, voffA);
            PG8_WAIT_V(8); PG8_WAIT_L(0); PG8_BAR; PG8_MMA(1, 0, At, B0); PG8_MMA(1, 1, At, B1); PG8_BAR; PG8_SCHED;
            PG8_LDB(B0, 1, 0); PG8_LDB(B1, 1, 1); PG8_SCHED; PG8_LDA(At, 1, 0); PG8_STAGE(PG8_SA(0, 1), a2 + hstep, voffA);
            PG8_WAIT_V(8); PG8_WAIT_L(0); PG8_BAR; PG8_MMA(0, 0, At, B0); PG8_MMA(0, 1, At, B1); PG8_BAR; PG8_SCHED;
            PG8_LDA(At, 1, 1); PG8_STAGE(PG8_SB(1, 0), b3, voffB); PG8_STAGE(PG8_SB(1, 1), b3 + hstep, voffB); PG8_STAGE(PG8_SA(1, 0), a3, voffA);
            PG8_WAIT_V(8); PG8_WAIT_L(0); PG8_BAR; PG8_MMA(1, 0, At, B0); PG8_MMA(1, 1, At, B1); PG8_BAR; PG8_SCHED;
            } else {
            PG8_LDB(B0, 0, 0); PG8_SCHED; PG8_LDA(At, 0, 0); PG8_STAGE(PG8_SA(1, 1), a1 + hstep, voffA);
            PG8_WAIT_L(8); PG8_BAR; PG8_WAIT_L(0); PG8_MMA(0, 0, At, B0); PG8_BAR; PG8_SCHED;
            PG8_LDB(B1, 0, 1); PG8_STAGE(PG8_SB(0, 0), b2, voffB);
            PG8_BAR; PG8_WAIT_L(0); PG8_MMA(0, 1, At, B1); PG8_BAR;
            PG8_LDA(At, 0, 1); PG8_STAGE(PG8_SA(0, 0), a2, voffA);
            PG8_BAR; PG8_WAIT_L(0); PG8_MMA(1, 0, At, B0); PG8_BAR; PG8_SCHED;
            PG8_STAGE(PG8_SB(0, 1), b2 + hstep, voffB);
            PG8_WAIT_V(6); PG8_BAR; PG8_MMA(1, 1, At, B1); PG8_BAR;
            PG8_LDB(B0, 1, 0); PG8_SCHED; PG8_LDA(At, 1, 0); PG8_STAGE(PG8_SA(0, 1), a2 + hstep, voffA);
            PG8_WAIT_L(8); PG8_BAR; PG8_WAIT_L(0); PG8_MMA(0, 0, At, B0); PG8_BAR; PG8_SCHED;
            PG8_LDB(B1, 1, 1); PG8_STAGE(PG8_SB(1, 0), b3, voffB);
            PG8_BAR; PG8_WAIT_L(0); PG8_MMA(0, 1, At, B1); PG8_BAR;
            PG8_LDA(At, 1, 1); PG8_STAGE(PG8_SA(1, 0), a3, voffA);
            PG8_BAR; PG8_WAIT_L(0); PG8_MMA(1, 0, At, B0); PG8_BAR; PG8_SCHED;
            PG8_STAGE(PG8_SB(1, 1), b3 + hstep, voffB);
            PG8_WAIT_V(6); PG8_BAR; PG8_MMA(1, 1, At, B1); PG8_BAR;
            }
        }
        if constexpr (ALIGN_EPI) { if (wr == 0) PG8_BAR; }
        if constexpr (!Epi::AFTER_DRAIN) { E(acc, cur, wr, wc, fr, fq); S.done(cur); }
        if (!has_next) break;
#pragma unroll
        for (int a = 0; a < 2; ++a)
#pragma unroll
            for (int b = 0; b < 2; ++b)
#pragma unroll
                for (int m = 0; m < 4; ++m)
#pragma unroll
                    for (int n = 0; n < 2; ++n) acc[a][b][m][n] = (f32x4){0.f, 0.f, 0.f, 0.f};
        cur = nxt; cA = nA; cB = nB; ++ui;
        if constexpr (ALIGN_EPI) { if (wr == 1) PG8_BAR; }
    }
    PG8_WAIT_V(0);
    if constexpr (!ALIGN_EPI) { if (wr == 0) PG8_BAR; }
    PG8_BAR;
    if constexpr (Epi::AFTER_DRAIN) { E.fused(acc, cur, wr, wc, fr, fq, lds, wid, lane); S.done(cur); }
#undef PG8_SA
#undef PG8_SB
#undef PG8_STAGE
#undef PG8_LDA
#undef PG8_LDB
#undef PG8_MMA
#undef PG8_WAIT_V
#undef PG8_WAIT_L
#undef PG8_BAR
#undef PG8_SCHED
}
}
namespace att {
using bf16 = __hip_bfloat16;
constexpr int D = 128, NW = 8, QBLK = 32, KVBLK = 64;
constexpr float SCALE = 0.088388347648318440f;
constexpr float THR = 8.f;
constexpr int SDEPTH = 2;
constexpr int LDQ = PW, LDK = PW, LDO = YW;
constexpr size_t SHM_V = KVBLK * D * 2, SHM_K = KVBLK * D * 2, SHM_ATTN = 3 * SHM_V + 3 * SHM_K + NW * 64 * 4;
using bf16x8 = __attribute__((ext_vector_type(8))) short;
using s16x4  = __attribute__((ext_vector_type(4))) short;
using f32x16 = __attribute__((ext_vector_type(16))) float;
using f32x8  = __attribute__((ext_vector_type(8))) float;
using u32x4  = __attribute__((ext_vector_type(4))) unsigned;
#define KSWZ(row, colB) ((row) * 256 + ((colB) ^ (((row) & 7) << 4)))
#define SBAR() __builtin_amdgcn_sched_barrier(0)
__device__ __forceinline__ int crow(int r, int hi) { return (r & 3) + 8 * (r >> 2) + 4 * hi; }
__device__ __forceinline__ unsigned cvtpk(float lo, float hi) {
  unsigned r; asm volatile("v_cvt_pk_bf16_f32 %0, %1, %2" : "=v"(r) : "v"(lo), "v"(hi)); return r;
}
template <typename TIn> struct Stage;
template <> struct Stage<bf16>  { using T = bf16x8;
  __device__ static __forceinline__ T ld8(const bf16* p) { return *reinterpret_cast<const bf16x8*>(p); }
  __device__ static __forceinline__ bf16x8 tobf(T x) { return x; } };
template <> struct Stage<float> { using T = f32x8;
  __device__ static __forceinline__ T ld8(const float* p) { return *reinterpret_cast<const f32x8*>(p); }
  __device__ static __forceinline__ bf16x8 tobf(T x) {
    u32x4 w = {cvtpk(x[0], x[1]), cvtpk(x[2], x[3]), cvtpk(x[4], x[5]), cvtpk(x[6], x[7])}; return *reinterpret_cast<bf16x8*>(&w); } };

template <bool FIXM = false> __device__ __forceinline__ void smax(const f32x16& p0, const f32x16& p1, float& m_reg, float& mn, float& alpha) {
  if constexpr (FIXM) { mn = m_reg; alpha = 1.f; return; }
  float pmax = p0[0]; for (int r = 1; r < 16; ++r) pmax = fmaxf(pmax, p0[r]); for (int r = 0; r < 16; ++r) pmax = fmaxf(pmax, p1[r]);
  { auto rr = __builtin_amdgcn_permlane32_swap(__float_as_uint(pmax), __float_as_uint(pmax), false, false);
    pmax = fmaxf(__uint_as_float(rr[0]), __uint_as_float(rr[1])); }
  if (__builtin_expect(__all(pmax - m_reg <= THR * 1.4426950408889634f), 1)) { mn = m_reg; alpha = 1.f; }
  else { mn = fmaxf(m_reg, pmax); alpha = __builtin_amdgcn_exp2f(m_reg - mn); m_reg = mn; }
}
template <bool FIXM = false> __device__ __forceinline__ void sexp(f32x16& p0, f32x16& p1, float mn) {
  if constexpr (!FIXM) { for (int r = 0; r < 16; ++r) p0[r] -= mn; for (int r = 0; r < 16; ++r) p1[r] -= mn; }
  for (int r = 0; r < 16; ++r) p0[r] = __builtin_amdgcn_exp2f(p0[r]);
  asm volatile("" : "+v"(p0), "+v"(p1));
}
template <bool FIXM = false> __device__ __forceinline__ void partialSM(f32x16& p0, f32x16& p1, float& m_reg, float& mn, float& alpha) { smax<FIXM>(p0, p1, m_reg, mn, alpha); sexp<FIXM>(p0, p1, mn); }
__device__ __forceinline__ void finishSM(f32x16& p0, f32x16& p1, float alpha, float& l_reg, bf16x8& pa0, bf16x8& pa1, bf16x8& pa2, bf16x8& pa3) {
  for (int r = 0; r < 16; ++r) p1[r] = __builtin_amdgcn_exp2f(p1[r]);
  float ps = 0; for (int r = 0; r < 16; ++r) ps += p0[r]; for (int r = 0; r < 16; ++r) ps += p1[r];
  { auto rr = __builtin_amdgcn_permlane32_swap(__float_as_uint(ps), __float_as_uint(ps), false, false);
    ps = __uint_as_float(rr[0]) + __uint_as_float(rr[1]); }
  l_reg = l_reg * alpha + ps;
#define PK4(P, BASE, OUT) do { unsigned a0 = cvtpk(P[BASE + 0], P[BASE + 1]), a1 = cvtpk(P[BASE + 2], P[BASE + 3]);   \
    unsigned b0 = cvtpk(P[BASE + 4], P[BASE + 5]), b1 = cvtpk(P[BASE + 6], P[BASE + 7]);                              \
    auto r0 = __builtin_amdgcn_permlane32_swap(a0, b0, false, false); auto r1 = __builtin_amdgcn_permlane32_swap(a1, b1, false, false); \
    u32x4 w = {r0[0], r1[0], r0[1], r1[1]}; OUT = *reinterpret_cast<bf16x8*>(&w); } while (0)
  PK4(p0, 0, pa0); PK4(p0, 8, pa1); PK4(p1, 0, pa2); PK4(p1, 8, pa3);
#undef PK4
}
template <int OFF> __device__ __forceinline__ bf16x8 k_rd(int addr) { bf16x8 r; asm volatile("ds_read_b128 %0, %1 offset:%2" : "=&v"(r) : "v"(addr), "i"(OFF) : "memory"); return r; }
#define K_WAIT(N, X, Y) asm volatile("s_waitcnt lgkmcnt(" #N ")" : "+v"(X), "+v"(Y) :: "memory")
__device__ __forceinline__ void qkt(f32x16& p0, f32x16& p1, int kb, const bf16x8* qr, const int (&ka)[4]) {
  p0 = f32x16{}; p1 = f32x16{};
  const int a0 = kb + ka[0], a1 = kb + ka[1], a2 = kb + ka[2], a3 = kb + ka[3];
  bf16x8 x0 = k_rd<0>(a0), y0 = k_rd<8192>(a0), x1 = k_rd<0>(a1), y1 = k_rd<8192>(a1);
#define K_STEP(D0, X, Y, N, NEXT) do { K_WAIT(N, X, Y); p0 = __builtin_amdgcn_mfma_f32_32x32x16_bf16(X, qr[D0], p0, 0, 0, 0); p1 = __builtin_amdgcn_mfma_f32_32x32x16_bf16(Y, qr[D0], p1, 0, 0, 0); NEXT; } while (0)
  K_STEP(0, x0, y0, 2, (x0 = k_rd<0>(a2), y0 = k_rd<8192>(a2)));
  K_STEP(1, x1, y1, 2, (x1 = k_rd<0>(a3), y1 = k_rd<8192>(a3)));
  K_STEP(2, x0, y0, 2, (x0 = k_rd<128>(a0), y0 = k_rd<8320>(a0)));
  K_STEP(3, x1, y1, 2, (x1 = k_rd<128>(a1), y1 = k_rd<8320>(a1)));
  K_STEP(4, x0, y0, 2, (x0 = k_rd<128>(a2), y0 = k_rd<8320>(a2)));
  K_STEP(5, x1, y1, 2, (x1 = k_rd<128>(a3), y1 = k_rd<8320>(a3)));
  K_STEP(6, x0, y0, 2, (void)0);
  K_STEP(7, x1, y1, 0, (void)0);
#undef K_STEP
}
#undef K_WAIT
__device__ __forceinline__ int v_st(int k, int c) { const int kk = (k & ~0xC) | ((k & 4) << 1) | ((k & 8) >> 1); return ((kk >> 3) * 4 + (c >> 5)) * 512 + ((kk & 7) * 32 + (c & 31)) * 2; }
__device__ __forceinline__ int v_rd_base(int lane) { return ((lane & 3) << 3) | (((lane >> 2) & 3) << 6) | (((lane >> 4) & 1) << 5) | (((lane >> 5) & 1) << 8); }
constexpr int v_rd_off(int d0, int ks, int half) { return d0 * 512 + ks * 4096 + half * 2048; }
template <int OFF> __device__ __forceinline__ s16x4 tr_read(int vb) {
  s16x4 r; asm volatile("ds_read_b64_tr_b16 %0, %1 offset:%2" : "=&v"(r) : "v"(vb), "i"(OFF) : "memory"); return r;
}
#define PK(L, H) (bf16x8){L[0], L[1], L[2], L[3], H[0], H[1], H[2], H[3]}
template <int D0> __device__ __forceinline__ void pv_two(f32x16& oa, f32x16& ob, int vb, bf16x8 pa0, bf16x8 pa1, bf16x8 pa2, bf16x8 pa3) {
  const s16x4 l0 = tr_read<v_rd_off(D0, 0, 0)>(vb), h0 = tr_read<v_rd_off(D0, 0, 1)>(vb), l1 = tr_read<v_rd_off(D0, 1, 0)>(vb), h1 = tr_read<v_rd_off(D0, 1, 1)>(vb);
  const s16x4 l2 = tr_read<v_rd_off(D0, 2, 0)>(vb), h2 = tr_read<v_rd_off(D0, 2, 1)>(vb), l3 = tr_read<v_rd_off(D0, 3, 0)>(vb), h3 = tr_read<v_rd_off(D0, 3, 1)>(vb);
  const s16x4 m0 = tr_read<v_rd_off(D0 + 1, 0, 0)>(vb), g0 = tr_read<v_rd_off(D0 + 1, 0, 1)>(vb), m1 = tr_read<v_rd_off(D0 + 1, 1, 0)>(vb), g1 = tr_read<v_rd_off(D0 + 1, 1, 1)>(vb);
  const s16x4 m2 = tr_read<v_rd_off(D0 + 1, 2, 0)>(vb), g2 = tr_read<v_rd_off(D0 + 1, 2, 1)>(vb), m3 = tr_read<v_rd_off(D0 + 1, 3, 0)>(vb), g3 = tr_read<v_rd_off(D0 + 1, 3, 1)>(vb);
  asm volatile("s_waitcnt lgkmcnt(0)" ::: "memory"); SBAR();
  oa = __builtin_amdgcn_mfma_f32_32x32x16_bf16(pa0, PK(l0, h0), oa, 0, 0, 0);
  ob = __builtin_amdgcn_mfma_f32_32x32x16_bf16(pa0, PK(m0, g0), ob, 0, 0, 0);
  oa = __builtin_amdgcn_mfma_f32_32x32x16_bf16(pa1, PK(l1, h1), oa, 0, 0, 0);
  ob = __builtin_amdgcn_mfma_f32_32x32x16_bf16(pa1, PK(m1, g1), ob, 0, 0, 0);
  oa = __builtin_amdgcn_mfma_f32_32x32x16_bf16(pa2, PK(l2, h2), oa, 0, 0, 0);
  ob = __builtin_amdgcn_mfma_f32_32x32x16_bf16(pa2, PK(m2, g2), ob, 0, 0, 0);
  oa = __builtin_amdgcn_mfma_f32_32x32x16_bf16(pa3, PK(l3, h3), oa, 0, 0, 0);
  ob = __builtin_amdgcn_mfma_f32_32x32x16_bf16(pa3, PK(m3, g3), ob, 0, 0, 0);
}
#undef PK
__device__ __forceinline__ void pv_d0(f32x16* o, int vb, bf16x8 pa0, bf16x8 pa1, bf16x8 pa2, bf16x8 pa3) {
  pv_two<0>(o[0], o[1], vb, pa0, pa1, pa2, pa3); pv_two<2>(o[2], o[3], vb, pa0, pa1, pa2, pa3);
}

template <typename TQ, int LDO_T, bool FIXM>
__device__ __forceinline__ void attn_dense_body(const TQ* __restrict__ Qb, const bf16* __restrict__ Kh, const bf16* __restrict__ Vh,
                                                unsigned short* __restrict__ Ob, float* __restrict__ stat, int seq, char* lds, float mfix) {
  using St = Stage<bf16>; using SQ = Stage<TQ>;
  const int tid = opaque_tid(), wid = tid >> 6, lane = tid & 63, r32 = lane & 31, hi = lane >> 5;
  bf16* V_lds = (bf16*)lds; bf16* K_lds = (bf16*)(lds + 3 * SHM_V);
  float* ws = (float*)(lds + 3 * SHM_V + 3 * SHM_K) + wid * 64; float* li_l = ws; float* al_l = ws + 32;
  float m_reg = FIXM ? mfix : -1e30f, l_reg = 0; f32x16 o[4] = {}; bf16x8 qr[8];
  const TQ* Qw = Qb + (long)(wid * QBLK + r32) * LDQ + hi * 8;
#pragma unroll
  for (int d0 = 0; d0 < 8; ++d0) qr[d0] = SQ::tobf(SQ::ld8(Qw + d0 * 16));
  const int sr = tid >> 4, sc = (tid & 15) * 8, vst0 = v_st(sr, sc), vst1 = v_st(32 + sr, sc);
  const int vb0 = (int)(uintptr_t)V_lds + v_rd_base(lane);
  const int kb0 = (int)(uintptr_t)K_lds; const int ka[4] = {KSWZ(r32, (0 * 16 + hi * 8) * 2), KSWZ(r32, (1 * 16 + hi * 8) * 2), KSWZ(r32, (2 * 16 + hi * 8) * 2), KSWZ(r32, (3 * 16 + hi * 8) * 2)};
  struct { typename St::T vs0, vs1, ks0, ks1; } sr_[SDEPTH];
#define SLOAD(i, k0) do { sr_[i].vs0 = St::ld8(&Vh[(long)((k0) + sr) * LDK + sc]); sr_[i].vs1 = St::ld8(&Vh[(long)((k0) + 32 + sr) * LDK + sc]); \
    sr_[i].ks0 = St::ld8(&Kh[(long)((k0) + sr) * LDK + sc]); sr_[i].ks1 = St::ld8(&Kh[(long)((k0) + 32 + sr) * LDK + sc]); } while (0)
#define SWRITE(b, i) do { *(bf16x8*)((char*)V_lds + (b) * (int)SHM_V + vst0) = St::tobf(sr_[i].vs0);          \
    *(bf16x8*)((char*)V_lds + (b) * (int)SHM_V + vst1) = St::tobf(sr_[i].vs1); int kc = sc * 2;               \
    *(bf16x8*)((char*)K_lds + (b) * (int)SHM_K + KSWZ(sr, kc)) = St::tobf(sr_[i].ks0);                       \
    *(bf16x8*)((char*)K_lds + (b) * (int)SHM_K + KSWZ(32 + sr, kc)) = St::tobf(sr_[i].ks1); } while (0)
#define SWAIT() do { if constexpr (SDEPTH == 2) asm volatile("s_waitcnt vmcnt(4)" ::: "memory"); else asm volatile("s_waitcnt vmcnt(0)" ::: "memory"); } while (0)
#define RESC(a) do { if constexpr (!FIXM) if (__any((a) < 1.f)) { if (hi == 0) al_l[r32] = (a); asm volatile("s_waitcnt lgkmcnt(0)" ::: "memory"); \
    for (int d = 0; d < 4; ++d) for (int r = 0; r < 16; ++r) o[d][r] *= al_l[crow(r, hi)]; } } while (0)
#define KBUF(b) ((bf16*)((char*)K_lds + (b) * (int)SHM_K))
  f32x16 pA0, pA1, pB0, pB1; float mnA, mnB, alA, alB; bf16x8 pa0, pa1, pa2, pa3; const int NT = seq / KVBLK;
  constexpr int SE = 0, SO = SDEPTH - 1;
  SLOAD(SE, 0); asm volatile("s_waitcnt vmcnt(0)" ::: "memory"); SWRITE(0, SE); __syncthreads();
  qkt(pA0, pA1, kb0, qr, ka); partialSM<FIXM>(pA0, pA1, m_reg, mnA, alA);
  SLOAD(SO, KVBLK); if constexpr (SDEPTH == 2) { if (2 < NT) SLOAD(SE, 2 * KVBLK); }
  SWAIT(); SWRITE(1, SO); __syncthreads();
  int iV = 0, iK = 1, iW = 2;
  for (int j = 1; j + 1 < NT; j += 2) {
    SBAR(); qkt(pB0, pB1, kb0 + iK * (int)SHM_K, qr, ka);
    finishSM(pA0, pA1, alA, l_reg, pa0, pa1, pa2, pa3); SBAR();
    SLOAD(SO, (j + SDEPTH) * KVBLK); SBAR();
    pv_two<0>(o[0], o[1], vb0 + iV * (int)SHM_V, pa0, pa1, pa2, pa3); smax<FIXM>(pB0, pB1, m_reg, mnB, alB);
    pv_two<2>(o[2], o[3], vb0 + iV * (int)SHM_V, pa0, pa1, pa2, pa3); sexp<FIXM>(pB0, pB1, mnB);
    SWAIT(); SWRITE(iW, SE);
    RESC(alB); __syncthreads();
    { const int t_ = iV; iV = iK; iK = iW; iW = t_; }
    SBAR(); qkt(pA0, pA1, kb0 + iK * (int)SHM_K, qr, ka);
    finishSM(pB0, pB1, alB, l_reg, pa0, pa1, pa2, pa3); SBAR();
    if (SDEPTH == 1 || j + 3 < NT) SLOAD(SE, (j + 1 + SDEPTH) * KVBLK); SBAR();
    pv_two<0>(o[0], o[1], vb0 + iV * (int)SHM_V, pa0, pa1, pa2, pa3); smax<FIXM>(pA0, pA1, m_reg, mnA, alA);
    pv_two<2>(o[2], o[3], vb0 + iV * (int)SHM_V, pa0, pa1, pa2, pa3); sexp<FIXM>(pA0, pA1, mnA);
    SWAIT(); SWRITE(iW, SO);
    RESC(alA); __syncthreads();
    { const int t_ = iV; iV = iK; iK = iW; iW = t_; }
  }
  SBAR(); qkt(pB0, pB1, kb0 + iK * (int)SHM_K, qr, ka);
  finishSM(pA0, pA1, alA, l_reg, pa0, pa1, pa2, pa3); SBAR();
  pv_d0(o, vb0 + iV * (int)SHM_V, pa0, pa1, pa2, pa3); partialSM<FIXM>(pB0, pB1, m_reg, mnB, alB);
  RESC(alB);
  finishSM(pB0, pB1, alB, l_reg, pa0, pa1, pa2, pa3); SBAR();
  pv_d0(o, vb0 + iK * (int)SHM_V, pa0, pa1, pa2, pa3);
#undef KBUF
  if (hi == 0) li_l[r32] = l_reg; asm volatile("s_waitcnt lgkmcnt(0)" ::: "memory");
  float rli[16];
#pragma unroll
  for (int r = 0; r < 16; ++r) rli[r] = __builtin_amdgcn_rcpf(li_l[crow(r, hi)]);
  if (stat != nullptr && hi == 0) { stat[(wid * QBLK + r32) * 16] = m_reg; stat[(wid * QBLK + r32) * 16 + 1] = l_reg; }
  unsigned short* Ow = Ob + (long)(wid * QBLK) * LDO_T;
#pragma unroll
  for (int r = 0; r < 16; ++r) { int orow = crow(r, hi);
    for (int d0 = 0; d0 < 4; ++d0) Ow[(long)orow * LDO_T + d0 * 32 + r32] = (unsigned short)f2bf(o[d0][r] * rli[r]); }
#undef SLOAD
#undef SWRITE
#undef SWAIT
#undef RESC
}
}
struct Frame {
    LAS unsigned char* lds; unsigned char* ldsg;
    volatile LAS unsigned* MISC;
    unsigned* ctl; unsigned char* ws;
    int tid, lane, wave, G, vcu;
};
__device__ __forceinline__ const float* inp(const Frame& F, int k) {
    const unsigned lo = __builtin_amdgcn_readfirstlane(F.MISC[16 + 2 * k]), hi = __builtin_amdgcn_readfirstlane(F.MISC[17 + 2 * k]);
    return (const float*)(const GAS float*)(((unsigned long long)hi << 32) | (unsigned long long)lo);
}
enum { I_x = 0, I_c, I_ctx, I_c_ctx, I_w_ada, I_b_ada, I_w_in, I_ret_decay, I_dn_conv_w, I_dn_a_log, I_dn_dt_bias, I_dn_norm_w, I_att_qn_w, I_att_kn_w, I_w_o, I_ln1_w, I_ln1_b, I_w_ffi, I_w_ffo, I_ln2_w, I_ln2_b, I_out };

struct TrItem { const float* src; bf16_t* dst; int ldw, K, ncols; };
__device__ __forceinline__ TrItem tr_decode(const Frame& F, int it) {
    constexpr int I_IN = 32 * 177, I_O = 32 * 64, I_FI = 32 * 352, I_FO = 88 * 64, I_L = I_IN + I_O + I_FI + I_FO;
    bf16_t* Win_t = (bf16_t*)(F.ws + WS_WIN); bf16_t* Wo_t = (bf16_t*)(F.ws + WS_WO); bf16_t* Wfi_t = (bf16_t*)(F.ws + WS_WFI); bf16_t* Wfo_t = (bf16_t*)(F.ws + WS_WFO);
    const int l = it / I_L; int r = it - l * I_L; TrItem t;
    if (r < I_IN) { const int kb = r / 177, nb = r - kb * 177; int dst = 32 * nb, src = 32 * nb, nc = 32;
        if (nb >= 128) src += 16; if (nb == 176) { dst = 5632; src = 4096; nc = 16; }
        t.src = inp(F, I_w_in) + (size_t)l * DM * PROJ_SRC + (size_t)(64 * kb) * PROJ_SRC + src; t.ldw = PROJ_SRC; t.K = DM; t.ncols = nc; t.dst = Win_t + (size_t)l * PWPAD * DM + (size_t)dst * DM + 64 * kb; return t; }
    r -= I_IN;
    if (r < I_O) { const int kb = r >> 6, nb = r & 63;
        t.src = inp(F, I_w_o) + (size_t)l * DM * DM + (size_t)(64 * kb) * DM + 32 * nb; t.ldw = DM; t.K = DM; t.ncols = 32; t.dst = Wo_t + (size_t)l * DM * DM + (size_t)(32 * nb) * DM + 64 * kb; return t; }
    r -= I_O;
    if (r < I_FI) { const int kb = r / 352, nb = r - kb * 352, pn = nb >> 3, q = nb & 7; const int src = q < 4 ? 128 * pn + 32 * q : DFF + 128 * pn + 32 * (q - 4);
        t.src = inp(F, I_w_ffi) + (size_t)l * DM * 2 * DFF + (size_t)(64 * kb) * 2 * DFF + src; t.ldw = 2 * DFF; t.K = DM; t.ncols = 32; t.dst = Wfi_t + (size_t)l * 2 * DFF * DM + (size_t)(32 * nb) * DM + 64 * kb; return t; }
    r -= I_FI;
    { const int kb = r >> 6, nb = r & 63;
        t.src = inp(F, I_w_ffo) + (size_t)l * DFF * DM + (size_t)(64 * kb) * DM + 32 * nb; t.ldw = DM; t.K = DFF; t.ncols = 32; t.dst = Wfo_t + (size_t)l * DM * DFF + (size_t)(32 * nb) * DFF + 64 * kb; return t; }
}
#define TR_LOAD(v, t) do { const int kr_ = lane >> 3, c4_ = (lane & 7) * 4; const bool ok_ = c4_ < (t).ncols; \
        _Pragma("unroll") for (int i_ = 0; i_ < 8; ++i_) v[i_] = ok_ ? *(const f32x4*)((t).src + (size_t)(8 * i_ + kr_) * (t).ldw + c4_) : (f32x4){0.f, 0.f, 0.f, 0.f}; } while (0)
#define TR_PROC(v, t) do { const int kr_ = lane >> 3, c4_ = (lane & 7) * 4; \
        _Pragma("unroll") for (int i_ = 0; i_ < 8; ++i_) { LAS float* s_ = scr + (8 * i_ + kr_) * 33 + c4_; s_[0] = v[i_][0]; s_[1] = v[i_][1]; s_[2] = v[i_][2]; s_[3] = v[i_][3]; } \
        LDS_WAIT(); const int c8_ = lane & 7; \
        _Pragma("unroll") for (int j_ = 0; j_ < 4; ++j_) { const int n_ = (lane >> 3) + 8 * j_; const LAS float* s_ = scr + (8 * c8_) * 33 + n_; \
            u32x4 o_; o_.x = pk2(s_[0 * 33], s_[1 * 33]); o_.y = pk2(s_[2 * 33], s_[3 * 33]); o_.z = pk2(s_[4 * 33], s_[5 * 33]); o_.w = pk2(s_[6 * 33], s_[7 * 33]); \
            if (n_ < (t).ncols) *(u32x4*)((t).dst + (size_t)n_ * (t).K + 8 * c8_) = o_; } \
        LDS_WAIT(); } while (0)
__device__ __forceinline__ void prologue_phase(Frame& F) {
    LAS float* scr = (LAS float*)(F.lds + F.wave * 8448);
    const int gw = F.vcu * NWAVES + F.wave, NGW = F.G * NWAVES, lane = F.lane;
    bf16_t* Win_t = (bf16_t*)(F.ws + WS_WIN);
    constexpr int NIT = DEPTH * (32 * 177 + 32 * 64 + 32 * 352 + 88 * 64);
    { f32x4 va[8], vb[8]; TrItem ta, tb;
      int it = gw; if (it < NIT) { ta = tr_decode(F, it); TR_LOAD(va, ta); }
      while (it < NIT) {
          int in = it + NGW; if (in < NIT) { tb = tr_decode(F, in); TR_LOAD(vb, tb); }
          TR_PROC(va, ta); it = in; if (it >= NIT) break;
          in = it + NGW; if (in < NIT) { ta = tr_decode(F, in); TR_LOAD(va, ta); }
          TR_PROC(vb, tb); it = in;
      } }
    { constexpr int PER_L = (PWPAD - PROJ_SRC) * DM / 8;
      for (int i = (F.vcu * NWAVES * 64) + F.tid; i < DEPTH * PER_L; i += F.G * NWAVES * 64) { const int l = i / PER_L, j = i - l * PER_L;
          *(u32x4*)(Win_t + (size_t)l * PWPAD * DM + (size_t)PROJ_SRC * DM + (size_t)j * 8) = (u32x4){0u, 0u, 0u, 0u}; } }
    LAS float* cond = (LAS float*)(F.lds + 73728);
    LAS float* red = (LAS float*)(F.lds + 98304);
    __syncthreads();
    for (int i = F.tid; i < 3 * DM; i += NWAVES * 64) { const int s = i / DM, k = i - s * DM; const float v = s < 2 ? inp(F, I_c)[s * DM + k] : inp(F, I_c_ctx)[k]; cond[i] = v / (1.f + expf(-v)); }
    __syncthreads();
    float* MOD = (float*)(F.ws + WS_MOD);
    for (int item = F.vcu; item < DEPTH * 96; item += F.G) {
        const int l = item / 96, cb = item - l * 96;
        const float* W = inp(F, I_w_ada) + (size_t)l * DM * 12288 + cb * 128 + 2 * lane;
        float a00 = 0.f, a01 = 0.f, a10 = 0.f, a11 = 0.f, a20 = 0.f, a21 = 0.f;
        const int kbeg = F.wave * 256;
#pragma unroll 16
        for (int k = kbeg; k < kbeg + 256; ++k) { const f32x2 w = *(const f32x2*)(W + (size_t)k * 12288); const float c0 = cond[k], c1 = cond[DM + k], c2 = cond[2 * DM + k];
            a00 += c0 * w.x; a01 += c0 * w.y; a10 += c1 * w.x; a11 += c1 * w.y; a20 += c2 * w.x; a21 += c2 * w.y; }
        red[(F.wave * 3 + 0) * 128 + 2 * lane] = a00; red[(F.wave * 3 + 0) * 128 + 2 * lane + 1] = a01;
        red[(F.wave * 3 + 1) * 128 + 2 * lane] = a10; red[(F.wave * 3 + 1) * 128 + 2 * lane + 1] = a11;
        red[(F.wave * 3 + 2) * 128 + 2 * lane] = a20; red[(F.wave * 3 + 2) * 128 + 2 * lane + 1] = a21;
        __syncthreads();
        if (F.tid < 384) { const int s = F.tid >> 7, cc = F.tid & 127; float sum = inp(F, I_b_ada)[l * 12288 + cb * 128 + cc];
#pragma unroll
            for (int w = 0; w < 8; ++w) sum += red[(w * 3 + s) * 128 + cc];
            MOD[(size_t)(l * 3 + s) * 12288 + cb * 128 + cc] = sum; }
        __syncthreads();
    }
}

template <int MODE> __device__ __forceinline__ void ln_mod_phase(Frame& F, int l, bool skip_ctx) {
    float* X = (float*)(F.ws + WS_X); bf16_t* H = (bf16_t*)(F.ws + WS_H); const float* MOD = (const float*)(F.ws + WS_MOD); float* LNS = (float*)(F.ws + WS_LNS);
    const int gw = F.vcu * NWAVES + F.wave, NGW = F.G * NWAVES, lane = F.lane;
    const int lm = MODE == 0 ? 0 : (MODE == 1 ? l : l + 1), ish = MODE == 1 ? 3 : 0, isc = MODE == 1 ? 4 : 1;
    f32x4 lw[8], lb[8];
    if (MODE != 0) { const float* pw = (MODE == 1 ? inp(F, I_ln1_w) : inp(F, I_ln2_w)) + l * DM; const float* pb = (MODE == 1 ? inp(F, I_ln1_b) : inp(F, I_ln2_b)) + l * DM;
#pragma unroll
        for (int j = 0; j < 8; ++j) { lw[j] = *(const f32x4*)(pw + 4 * lane + 256 * j); lb[j] = *(const f32x4*)(pb + 4 * lane + 256 * j); } }
    const float* xin = MODE == 0 ? inp(F, I_x) : nullptr; const float* cin = MODE == 0 ? inp(F, I_ctx) : nullptr; float* outp = MODE == 3 ? (float*)inp(F, I_out) : nullptr;
#define LN_ROW(seg, i) ((seg) == 0 ? ((i) >> 8) * TOK + ((i) & 255) : ((seg) - 1) * TOK + CTXL + (i))
#define LN_SRC(seg, i) (MODE == 0 ? ((seg) == 0 ? cin + (size_t)(i) * DM : xin + (size_t)(((seg) - 1) * SEQ + (i)) * DM) : X + (size_t)LN_ROW(seg, i) * DM)
#define LN_LOAD(v, seg, i) do { const float* s_ = LN_SRC(seg, i); _Pragma("unroll") for (int j = 0; j < 8; ++j) v[j] = *(const f32x4*)(s_ + 4 * lane + 256 * j); } while (0)
#define LN_PROC(v, seg, i) do { \
        if (MODE != 0) { float sm = 0.f; \
            _Pragma("unroll") for (int j = 0; j < 8; ++j) sm += (v[j][0] + v[j][1]) + (v[j][2] + v[j][3]); \
            const float mean = wave_sum(sm) * (1.f / DM); float sq = 0.f; \
            _Pragma("unroll") for (int j = 0; j < 8; ++j) { v[j] = v[j] - mean; sq += (v[j][0] * v[j][0] + v[j][1] * v[j][1]) + (v[j][2] * v[j][2] + v[j][3] * v[j][3]); } \
            const float rstd = rsqrtf(wave_sum(sq) * (1.f / DM) + EPS); \
            if (MODE != 3 && lane == 0) *(f32x2*)(LNS + (size_t)LN_ROW(seg, i) * 2) = (f32x2){mean, rstd};     \
            _Pragma("unroll") for (int j = 0; j < 8; ++j) v[j] = v[j] * rstd * lw[j] + lb[j]; } \
        if (MODE == 3) { float* o_ = outp + (size_t)(((seg) - 1) * SEQ + (i)) * DM; \
            _Pragma("unroll") for (int j = 0; j < 8; ++j) __builtin_nontemporal_store(v[j], (f32x4*)(o_ + 4 * lane + 256 * j)); } \
        else { const size_t r_ = (size_t)LN_ROW(seg, i); \
            _Pragma("unroll") for (int j = 0; j < 8; ++j) { if (MODE == 0) *(f32x4*)(X + r_ * DM + 4 * lane + 256 * j) = v[j]; const f32x4 hh = v[j] * (sc[j] + 1.f) + sh[j]; \
                u32x2 w_; w_.x = pk2(hh[0], hh[1]); w_.y = pk2(hh[2], hh[3]); *(u32x2*)(H + r_ * DM + 4 * lane + 256 * j) = w_; } } } while (0)
    for (int seg = ((skip_ctx || MODE == 3) ? 1 : 0); seg < 3; ++seg) {
        const int n = seg == 0 ? NBATCH * CTXL : SEQ, s = seg == 0 ? 2 : seg - 1;
        f32x4 sh[8], sc[8];
        if (MODE != 3) { const float* msh = MOD + (size_t)(lm * 3 + s) * 12288 + ish * DM; const float* msc = MOD + (size_t)(lm * 3 + s) * 12288 + isc * DM;
#pragma unroll
            for (int j = 0; j < 8; ++j) { sh[j] = *(const f32x4*)(msh + 4 * lane + 256 * j); sc[j] = *(const f32x4*)(msc + 4 * lane + 256 * j); } }
        f32x4 va[8], vb[8];
        int i = gw; if (i < n) LN_LOAD(va, seg, i);
        while (i < n) {
            int in = i + NGW; if (in < n) LN_LOAD(vb, seg, in);
            LN_PROC(va, seg, i); i = in; if (i >= n) break;
            in = i + NGW; if (in < n) LN_LOAD(va, seg, in);
            LN_PROC(vb, seg, i); i = in;
        }
    }
#undef LN_ROW
#undef LN_SRC
#undef LN_LOAD
#undef LN_PROC
}

__device__ __forceinline__ void ctx_gemm_resid(Frame& F, const bf16_t* A, const bf16_t* Bt, int K, float* X, const float* gate_ctx, float alpha, const float* stats, const float* lnw, const float* lnb, int ln) {
    LAS unsigned char* L = F.lds; const int tid = F.tid, lane = F.lane, wave = F.wave, rr = lane & 15, kg = lane >> 4;
    const int srow = tid >> 3, sc = tid & 7;
    for (int tile = F.vcu; tile < 256; tile += F.G) {
        const int rt = tile >> 5, ct = tile & 31; const size_t row0 = (size_t)(rt >> 2) * TOK + (rt & 3) * 64; const int col0 = ct * 64;
        const bf16_t* ap = A + (row0 + srow) * K + sc * 8; const bf16_t* bp = Bt + (size_t)(col0 + srow) * K + sc * 8;
        f32x4 acc[2]; acc[0] = (f32x4){0.f, 0.f, 0.f, 0.f}; acc[1] = acc[0];
        u32x4 ra0, ra1, ra2, ra3, ra4, ra5, ra6, ra7, rb0, rb1, rb2, rb3, rb4, rb5, rb6, rb7; const int nk = K / 64;
#define CG_LD(i, RA, RB) do { RA = *(const u32x4*)(ap + (i) * 64); RB = *(const u32x4*)(bp + (i) * 64); } while (0)
        CG_LD(0, ra0, rb0); CG_LD(1, ra1, rb1); CG_LD(2, ra2, rb2); CG_LD(3, ra3, rb3); CG_LD(4, ra4, rb4); CG_LD(5, ra5, rb5); CG_LD(6, ra6, rb6); CG_LD(7, ra7, rb7);
#define CG_STEP(kt, RA, RB) do { LAS unsigned char* As_ = L + ((kt) & 1) * 18432; LAS unsigned char* Bs_ = As_ + 9216; \
            *(LAS u32x4*)(As_ + srow * 144 + sc * 16) = RA; *(LAS u32x4*)(Bs_ + srow * 144 + sc * 16) = RB; \
            __syncthreads(); \
            if ((kt) + 8 < nk) CG_LD((kt) + 8, RA, RB); \
            _Pragma("unroll") for (int ks = 0; ks < 2; ++ks) { const bf16x8 af = ldsfrag(As_ + (16 * (wave & 3) + rr) * 144 + (32 * ks + 8 * kg) * 2); \
                _Pragma("unroll") for (int j = 0; j < 2; ++j) acc[j] = mfma16(ldsfrag(Bs_ + (32 * (wave >> 2) + 16 * j + rr) * 144 + (32 * ks + 8 * kg) * 2), af, acc[j]); } } while (0)
        for (int kt = 0; kt < nk; kt += 8) { CG_STEP(kt, ra0, rb0); CG_STEP(kt + 1, ra1, rb1); CG_STEP(kt + 2, ra2, rb2); CG_STEP(kt + 3, ra3, rb3); CG_STEP(kt + 4, ra4, rb4); CG_STEP(kt + 5, ra5, rb5); CG_STEP(kt + 6, ra6, rb6); CG_STEP(kt + 7, ra7, rb7); }
#undef CG_STEP
#undef CG_LD
        const size_t row = row0 + 16 * (wave & 3) + rr;
#pragma unroll
        for (int j = 0; j < 2; ++j) { const int col = col0 + 32 * (wave >> 2) + 16 * j + 4 * kg; float* xp = X + row * DM + col;
            const f32x4 g = *(const f32x4*)(gate_ctx + col); f32x4 x = *(const f32x4*)xp;
            if (ln) { const f32x2 st = *(const f32x2*)(stats + row * 2); x = (x - st.x) * st.y * *(const f32x4*)(lnw + col) + *(const f32x4*)(lnb + col); }
            x = x * alpha + g * acc[j]; *(f32x4*)xp = x; }
        __syncthreads();
    }
}

__device__ __forceinline__ void rowprep_phase(Frame& F, int l) {
    bf16_t* P = (bf16_t*)(F.ws + WS_P); float* AB = (float*)(F.ws + WS_AB); bf16_t* DQ = (bf16_t*)(F.ws + WS_DQ);
    const int lane = F.lane, gw = F.vcu * NWAVES + F.wave, NGW = F.G * NWAVES;
    LAS float* csl = (LAS float*)(F.lds + F.wave * 512);
    const float* cw = inp(F, I_dn_conv_w) + (size_t)l * 5 * 1536;
    const float inv = powf(10000.f, -(float)(lane & 31) * (1.f / 32.f));
    const float nega = lane < 8 ? -expf(inp(F, I_dn_a_log)[l * 8 + lane]) : 0.f, dtb = lane < 8 ? inp(F, I_dn_dt_bias)[l * 8 + lane] : 0.f;
    const int hs = lane >> 3, c8 = (lane & 7) * 8;
    f32x4 qn1a, qn1b, qn2a, qn2b, kn1a, kn1b, kn2a, kn2b;
    { const float* qn = inp(F, I_att_qn_w) + l * 128; const float* kn = inp(F, I_att_kn_w) + l * 128;
      qn1a = *(const f32x4*)(qn + c8); qn1b = *(const f32x4*)(qn + c8 + 4); qn2a = *(const f32x4*)(qn + 64 + c8); qn2b = *(const f32x4*)(qn + 64 + c8 + 4);
      kn1a = *(const f32x4*)(kn + c8); kn1b = *(const f32x4*)(kn + c8 + 4); kn2a = *(const f32x4*)(kn + 64 + c8); kn2b = *(const f32x4*)(kn + 64 + c8 + 4); }
#define RP_UNPACK(V_, lo, hi) do { lo = (f32x4){bflo(V_.x), bfhi(V_.x), bflo(V_.y), bfhi(V_.y)}; hi = (f32x4){bflo(V_.z), bfhi(V_.z), bflo(V_.w), bfhi(V_.w)}; } while (0)
#define RP_PACK(lo, hi) (u32x4){pk2(lo[0], lo[1]), pk2(lo[2], lo[3]), pk2(hi[0], hi[1]), pk2(hi[2], hi[3])}
#define RP_GLOAD(base, act, r1_, r2_) do { const bf16_t* p1_ = p + (base) + hs * 128 + c8; r1_ = (u32x4){0u, 0u, 0u, 0u}; r2_ = r1_; if (act) { r1_ = *(const u32x4*)p1_; r2_ = *(const u32x4*)(p1_ + 64); } } while (0)
#define RP_GROUP(base, NORM, w1a, w1b, w2a, w2b, scl, act, r1_, r2_) do { bf16_t* p1_ = p + (base) + hs * 128 + c8; \
        f32x4 x1a, x1b, x2a, x2b; RP_UNPACK(r1_, x1a, x1b); RP_UNPACK(r2_, x2a, x2b); \
        if (NORM) { f32x4 q_ = x1a * x1a + x1b * x1b + x2a * x2a + x2b * x2b; float ss_ = (q_[0] + q_[1]) + (q_[2] + q_[3]); ss_ += __shfl_xor(ss_, 1); ss_ += __shfl_xor(ss_, 2); ss_ += __shfl_xor(ss_, 4); \
            const float ri_ = rsqrtf(ss_ * (1.f / 128.f) + EPS); x1a = x1a * ri_ * w1a; x1b = x1b * ri_ * w1b; x2a = x2a * ri_ * w2a; x2b = x2b * ri_ * w2b; } \
        const f32x4 y1a = (x1a * ca - x2a * sa) * (scl), y1b = (x1b * cb - x2b * sb) * (scl), y2a = (x1a * sa + x2a * ca) * (scl), y2b = (x1b * sb + x2b * cb) * (scl); \
        if (act) { *(u32x4*)p1_ = RP_PACK(y1a, y1b); *(u32x4*)(p1_ + 64) = RP_PACK(y2a, y2b); } } while (0)
    for (int r = gw; r < MROWS; r += NGW) {
        const int b = r / TOK, tp = r - b * TOK; const bool is_ctx = tp < CTXL;
        { float cs = 1.f, sn = 0.f;
          if (!is_ctx) { const int t = tp - CTXL; const float pos = (lane < 32) ? (float)(t >> 6) : (float)(t & 63); sn = __sinf(pos * inv); cs = __cosf(pos * inv); }
          csl[lane] = cs; csl[64 + lane] = sn; LDS_WAIT(); }
        const f32x4 ca = *(const LAS f32x4*)(csl + c8), cb = *(const LAS f32x4*)(csl + c8 + 4), sa = *(const LAS f32x4*)(csl + 64 + c8), sb = *(const LAS f32x4*)(csl + 64 + c8 + 4);
        bf16_t* p = P + (size_t)r * PW;
        u32x4 gq1, gq2, gk1, gk2, gr1, gr2, cv[3][5]; float abv = 0.f, bbv = 0.f;
        RP_GLOAD(C_AQ, true, gq1, gq2); RP_GLOAD(C_AK, (hs < 2), gk1, gk2); RP_GLOAD(C_RQ, true, gr1, gr2);
#pragma unroll
        for (int j = 0; j < 3; ++j)
#pragma unroll
            for (int k = 0; k < 5; ++k) { const int rr = tp + k - 2; const bool valid = is_ctx ? (rr >= 0 && rr < CTXL) : (rr >= CTXL && rr < TOK);
                cv[j][k] = (u32x4){0u, 0u, 0u, 0u}; if (valid) cv[j][k] = *(const u32x4*)(P + (size_t)(r + k - 2) * PW + C_DQKV + 8 * (lane + 64 * j)); }
        if (lane < 8) { abv = AB[(size_t)r * 16 + lane]; bbv = AB[(size_t)r * 16 + 8 + lane]; }
        asm volatile("" ::: "memory");
        RP_GROUP(C_AQ, true, qn1a, qn1b, qn2a, qn2b, (0.088388347648318440f * 1.4426950408889634f), true, gq1, gq2);
        RP_GROUP(C_AK, true, kn1a, kn1b, kn2a, kn2b, 1.f, (hs < 2), gk1, gk2);
        RP_GROUP(C_RQ, false, qn1a, qn1b, qn2a, qn2b, (hs < 4 ? 1.f : 0.088388347648318440f), true, gr1, gr2);
        LDS_WAIT();
#pragma unroll
        for (int j = 0; j < 3; ++j) {
            const int c0 = 8 * (lane + 64 * j); float a[8];
#pragma unroll
            for (int e = 0; e < 8; ++e) a[e] = 0.f;
#pragma unroll
            for (int k = 0; k < 5; ++k) { const int rr = tp + k - 2; const bool valid = is_ctx ? (rr >= 0 && rr < CTXL) : (rr >= CTXL && rr < TOK);
                if (valid) { const u32x4 xv = cv[j][k]; const f32x4 w0 = *(const f32x4*)(cw + k * 1536 + c0), w1 = *(const f32x4*)(cw + k * 1536 + c0 + 4);
                    a[0] += w0[0] * bflo(xv.x); a[1] += w0[1] * bfhi(xv.x); a[2] += w0[2] * bflo(xv.y); a[3] += w0[3] * bfhi(xv.y);
                    a[4] += w1[0] * bflo(xv.z); a[5] += w1[1] * bfhi(xv.z); a[6] += w1[2] * bflo(xv.w); a[7] += w1[3] * bfhi(xv.w); } }
            float ss = 0.f;
#pragma unroll
            for (int e = 0; e < 8; ++e) { a[e] = silu_f(a[e]); ss += a[e] * a[e]; }
            if (j < 2) { const float sc = rsqrtf(sum16(ss) + EPS) * (j == 0 ? 0.088388347648318440f : 1.f);
#pragma unroll
                for (int e = 0; e < 8; ++e) a[e] *= sc; }
            u32x4 o; o.x = pk2(a[0], a[1]); o.y = pk2(a[2], a[3]); o.z = pk2(a[4], a[5]); o.w = pk2(a[6], a[7]);
            *(u32x4*)(DQ + (size_t)r * 1536 + c0) = o;
        }
        if (lane < 8) { const float av = abv, bv = bbv; const float xx = av + dtb; const float sp = xx > 20.f ? xx : log1pf(expf(xx));
            AB[(size_t)r * 16 + lane] = nega * sp; AB[(size_t)r * 16 + 8 + lane] = 1.f / (1.f + expf(-bv)); }
    }
#undef RP_UNPACK
#undef RP_PACK
#undef RP_GROUP
#undef RP_GLOAD
}

constexpr int DP_QS = 0, DP_KS = 17408, DP_KT = 36864, DP_VT = 55296, DP_AS = 73728, DP_GC = 108544;
__device__ __forceinline__ void dnprep_unit(Frame& F, int unit) {
    const bf16_t* DQ = (const bf16_t*)(F.ws + WS_DQ); const float* GB = (const float*)(F.ws + WS_AB);
    bf16_t* DNW = (bf16_t*)(F.ws + WS_DNW); bf16_t* DNKC = (bf16_t*)(F.ws + WS_DNKC); bf16_t* DNQG = (bf16_t*)(F.ws + WS_DNQG); bf16_t* DNKGT = (bf16_t*)(F.ws + WS_DNKGT); bf16_t* DNQK = (bf16_t*)(F.ws + WS_DNQK); float* DNGL = (float*)(F.ws + WS_DNGL);
    LAS unsigned char* L = F.lds; LAS float* gcs = (LAS float*)(L + DP_GC); LAS float* bes = gcs + 128; LAS float* AS = (LAS float*)(L + DP_AS);
    const int tid = opaque_tid(), lane = tid & 63, wave = __builtin_amdgcn_readfirstlane(tid >> 6), rr = lane & 15, kg = lane >> 4;
    const int h = unit & 3, cg = (unit >> 2) % DN_NCH, b = (unit >> 2) / DN_NCH, rbase = b * TOK + 64 * cg;
    const size_t pu0 = (size_t)((b * DN_NCH + cg) * 4 + h) * 2;
    if (wave < 2) { const int dir = wave, tok = dir ? 63 - lane : lane; const size_t row = rbase + tok;
        float s = GB[row * 16 + dir * 4 + h]; const float be = GB[row * 16 + 8 + dir * 4 + h];
#pragma unroll
        for (int o = 1; o < 64; o <<= 1) { const float t = __shfl_up(s, o); if (lane >= o) s += t; }
        gcs[dir * 64 + lane] = s; bes[dir * 64 + lane] = be; }
    { const int row = tid >> 3, seg = tid & 7; const bf16_t* src = DQ + (size_t)(rbase + row) * 1536 + h * 128 + seg * 16;
      const u32x4 q0 = *(const u32x4*)src, q1 = *(const u32x4*)(src + 8), k0 = *(const u32x4*)(src + 512), k1 = *(const u32x4*)(src + 520), v0 = *(const u32x4*)(src + 1024), v1 = *(const u32x4*)(src + 1032);
      *(LAS u32x4*)(L + DP_QS + row * 272 + seg * 32) = q0; *(LAS u32x4*)(L + DP_QS + row * 272 + seg * 32 + 16) = q1;
      *(LAS u32x4*)(L + DP_KS + row * 272 + seg * 32) = k0; *(LAS u32x4*)(L + DP_KS + row * 272 + seg * 32 + 16) = k1;
      const unsigned kw[8] = {k0.x, k0.y, k0.z, k0.w, k1.x, k1.y, k1.z, k1.w}, vw[8] = {v0.x, v0.y, v0.z, v0.w, v1.x, v1.y, v1.z, v1.w};
#pragma unroll
      for (int e = 0; e < 8; ++e) { const int d = seg * 16 + 2 * e;
          *(LAS bf16_t*)(L + DP_KT + (d * 72 + row) * 2) = (bf16_t)(kw[e] & 0xffffu); *(LAS bf16_t*)(L + DP_KT + ((d + 1) * 72 + row) * 2) = (bf16_t)(kw[e] >> 16);
          *(LAS bf16_t*)(L + DP_VT + (d * 72 + row) * 2) = (bf16_t)(vw[e] & 0xffffu); *(LAS bf16_t*)(L + DP_VT + ((d + 1) * 72 + row) * 2) = (bf16_t)(vw[e] >> 16); } }
    __syncthreads();
#pragma unroll
    for (int jj = 0; jj < 2; ++jj) {
        const int it = wave >> 1, jt = 2 * (wave & 1) + jj; f32x4 kk = {0.f, 0.f, 0.f, 0.f}, qk = {0.f, 0.f, 0.f, 0.f};
#pragma unroll
        for (int ks = 0; ks < 4; ++ks) { const bf16x8 aK = ldsfrag(L + DP_KS + (16 * jt + rr) * 272 + (32 * ks + 8 * kg) * 2), bK = ldsfrag(L + DP_KS + (16 * it + rr) * 272 + (32 * ks + 8 * kg) * 2), bQ = ldsfrag(L + DP_QS + (16 * it + rr) * 272 + (32 * ks + 8 * kg) * 2);
            kk = mfma16(aK, bK, kk); qk = mfma16(aK, bQ, qk); }
        const int i = 16 * it + rr, jb = 16 * jt + 4 * kg;
        { const float gi = gcs[i], bi = bes[i]; float av[4], qv[4];
#pragma unroll
          for (int r = 0; r < 4; ++r) { const int j = jb + r; const float e = (j <= i) ? __expf(gi - gcs[j]) : 0.f; av[r] = (j < i) ? bi * kk[r] * e : 0.f; qv[r] = qk[r] * e; }
          *(LAS f32x4*)(AS + i * 68 + jb) = (f32x4){av[0], av[1], av[2], av[3]};
          u32x2 w; w.x = pk2(qv[0], qv[1]); w.y = pk2(qv[2], qv[3]); *(u32x2*)(DNQK + (pu0 + 0) * 4096 + i * 64 + jb) = w; }
        { const int i1 = 63 - i; const float gi = gcs[64 + i1], bi = bes[64 + i1]; float av[4], qv[4];
#pragma unroll
          for (int r = 0; r < 4; ++r) { const int j1 = 63 - (jb + r); const float e = (j1 <= i1) ? __expf(gi - gcs[64 + j1]) : 0.f; av[r] = (j1 < i1) ? bi * kk[r] * e : 0.f; qv[r] = qk[r] * e; }
          const int jl = 60 - jb;
          *(LAS f32x4*)(AS + 64 * 68 + i1 * 68 + jl) = (f32x4){av[3], av[2], av[1], av[0]};
          u32x2 w; w.x = pk2(qv[3], qv[2]); w.y = pk2(qv[1], qv[0]); *(u32x2*)(DNQK + (pu0 + 1) * 4096 + i1 * 64 + jl) = w; }
    }
    { const int row = tid >> 3, seg = tid & 7;
#pragma unroll
      for (int dir = 0; dir < 2; ++dir) { const int tok = dir ? 63 - row : row; const float e = __expf(gcs[dir * 64 + row]);
          const u32x4 a0 = *(const LAS u32x4*)(L + DP_QS + tok * 272 + seg * 32), a1 = *(const LAS u32x4*)(L + DP_QS + tok * 272 + seg * 32 + 16);
          u32x4 o0, o1; o0.x = pk2(bflo(a0.x) * e, bfhi(a0.x) * e); o0.y = pk2(bflo(a0.y) * e, bfhi(a0.y) * e); o0.z = pk2(bflo(a0.z) * e, bfhi(a0.z) * e); o0.w = pk2(bflo(a0.w) * e, bfhi(a0.w) * e);
          o1.x = pk2(bflo(a1.x) * e, bfhi(a1.x) * e); o1.y = pk2(bflo(a1.y) * e, bfhi(a1.y) * e); o1.z = pk2(bflo(a1.z) * e, bfhi(a1.z) * e); o1.w = pk2(bflo(a1.w) * e, bfhi(a1.w) * e);
          bf16_t* dst = DNQG + (pu0 + dir) * 8192 + row * 128 + seg * 16; *(u32x4*)dst = o0; *(u32x4*)(dst + 8) = o1; } }
    { const int d = tid >> 2, sg = tid & 3;
#pragma unroll
      for (int dir = 0; dir < 2; ++dir) { const float gl = gcs[dir * 64 + 63]; unsigned ow[8];
#pragma unroll
          for (int e = 0; e < 8; ++e) { const int i0 = 16 * sg + 2 * e, i1 = i0 + 1; const int t0 = dir ? 63 - i0 : i0, t1 = dir ? 63 - i1 : i1;
              const float v0 = bf2f(*(const LAS bf16_t*)(L + DP_KT + (d * 72 + t0) * 2)) * __expf(gl - gcs[dir * 64 + i0]), v1 = bf2f(*(const LAS bf16_t*)(L + DP_KT + (d * 72 + t1) * 2)) * __expf(gl - gcs[dir * 64 + i1]);
              ow[e] = pk2(v0, v1); }
          bf16_t* dst = DNKGT + (pu0 + dir) * 8192 + d * 64 + 16 * sg; *(u32x4*)dst = (u32x4){ow[0], ow[1], ow[2], ow[3]}; *(u32x4*)(dst + 8) = (u32x4){ow[4], ow[5], ow[6], ow[7]}; } }
    if (tid < 2) DNGL[pu0 + tid] = __expf(gcs[tid * 64 + 63]);
    __syncthreads();
    if (wave < 2) { const int dir = wave; const LAS float* A = AS + dir * 64 * 68; f32x2 tp[32]; const int lane3 = opaque_tid() & 63;
#pragma unroll
        for (int i0 = 0; i0 < 64; i0 += 4) { f32x2 ac[4];
#pragma unroll
            for (int r = 0; r < 4; ++r) ac[r] = (f32x2){(i0 + r == lane3) ? 1.f : 0.f, 0.f};
#pragma unroll
            for (int j4 = 0; j4 < i0 / 4; ++j4) {
#pragma unroll
                for (int r = 0; r < 4; ++r) { const f32x4 v = *(const LAS f32x4*)(A + (i0 + r) * 68 + 4 * j4);
                    ac[r] -= (f32x2){v[0], v[1]} * tp[2 * j4]; ac[r] -= (f32x2){v[2], v[3]} * tp[2 * j4 + 1]; }
                asm volatile("" : "+v"(ac[0]), "+v"(ac[1]), "+v"(ac[2]), "+v"(ac[3]) :: "memory"); }
            const f32x4 v1 = *(const LAS f32x4*)(A + (i0 + 1) * 68 + i0), v2 = *(const LAS f32x4*)(A + (i0 + 2) * 68 + i0), v3 = *(const LAS f32x4*)(A + (i0 + 3) * 68 + i0);
            const float t0 = ac[0].x + ac[0].y;
            const float t1 = (ac[1].x + ac[1].y) - v1[0] * t0;
            const float t2 = (ac[2].x + ac[2].y) - v2[0] * t0 - v2[1] * t1;
            const float t3 = (ac[3].x + ac[3].y) - v3[0] * t0 - v3[1] * t1 - v3[2] * t2;
            tp[i0 / 2] = (f32x2){t0, t1}; tp[i0 / 2 + 1] = (f32x2){t2, t3}; }
        const float be = bes[dir * 64 + lane3], bg = be * __expf(gcs[dir * 64 + lane3]); const int tau = dir ? 63 - lane3 : lane3;
        LAS bf16_t* TP = (LAS bf16_t*)(L + (dir * 2 + 0) * 9216); LAS bf16_t* TPP = (LAS bf16_t*)(L + (dir * 2 + 1) * 9216);
#pragma unroll
        for (int k = 0; k < 32; ++k) { TP[(2 * k) * 72 + tau] = (bf16_t)f2bf(tp[k].x * be); TPP[(2 * k) * 72 + tau] = (bf16_t)f2bf(tp[k].x * bg); TP[(2 * k + 1) * 72 + tau] = (bf16_t)f2bf(tp[k].y * be); TPP[(2 * k + 1) * 72 + tau] = (bf16_t)f2bf(tp[k].y * bg); } }
    __syncthreads();
    { const int tid4 = opaque_tid(), lane4 = tid4 & 63, wave4 = __builtin_amdgcn_readfirstlane(tid4 >> 6), rr4 = lane4 & 15, kg4 = lane4 >> 4;
#pragma unroll
    for (int mat = 0; mat < 2; ++mat) { const LAS unsigned char* As_ = L + (mat ? DP_KT : DP_VT); bf16x8 a[2];
#pragma unroll
        for (int ks = 0; ks < 2; ++ks) a[ks] = ldsfrag(As_ + (16 * wave4 + rr4) * 144 + (32 * ks + 8 * kg4) * 2);
#pragma unroll
        for (int dir = 0; dir < 2; ++dir) { const LAS unsigned char* Bs_ = L + (dir * 2 + mat) * 9216; bf16_t* OUT = (mat ? DNKC : DNW) + (pu0 + dir) * 8192;
#pragma unroll
            for (int it = 0; it < 4; ++it) { f32x4 c = {0.f, 0.f, 0.f, 0.f};
#pragma unroll
                for (int ks = 0; ks < 2; ++ks) c = mfma16(a[ks], ldsfrag(Bs_ + (16 * it + rr4) * 144 + (32 * ks + 8 * kg4) * 2), c);
                u32x2 w; w.x = pk2(c[0], c[1]); w.y = pk2(c[2], c[3]); *(u32x2*)(OUT + (16 * it + rr4) * 128 + 16 * wave4 + 4 * kg4) = w; } } } }
    __syncthreads();
}

constexpr int DS_KC = 0, DS_QG = 17408, DS_KGT = 34816, DS_QK = 53248, DS_W = 62464, DS_SB = 79872, DS_VT = 114688;
__device__ __forceinline__ void dnscan_unit(Frame& F, int unit) {
    const bf16_t* DNW = (const bf16_t*)(F.ws + WS_DNW); const bf16_t* DNKC = (const bf16_t*)(F.ws + WS_DNKC); const bf16_t* DNQG = (const bf16_t*)(F.ws + WS_DNQG); const bf16_t* DNKGT = (const bf16_t*)(F.ws + WS_DNKGT); const bf16_t* DNQK = (const bf16_t*)(F.ws + WS_DNQK); const float* DNGL = (const float*)(F.ws + WS_DNGL);
    bf16_t* ODN = (bf16_t*)(F.ws + WS_ODN);
    LAS unsigned char* L = F.lds;
    const int tid = F.tid, lane = F.lane, wave = F.wave, rr = lane & 15, kg = lane >> 4;
    const int dir = unit & 1, h = (unit >> 1) & 3, b = unit >> 3;
    const int mt = wave >> 1, ng = wave & 1;
    f32x4 s[2][4];
#pragma unroll
    for (int di = 0; di < 2; ++di)
#pragma unroll
        for (int j = 0; j < 4; ++j) s[di][j] = (f32x4){0.f, 0.f, 0.f, 0.f};
    for (int i = tid; i < 34816 / 4; i += NWAVES * 64) ((LAS unsigned*)(L + DS_SB))[i] = 0u;
#define DS_CG(t) (dir ? ((t) < 4 ? 3 - (t) : 135 - (t)) : (t))
#define DS_DECL(S) u32x4 rKC##S[2], rQG##S[2], rKGT##S[2], rQK##S, rW##S[2]; float rGL##S = 0.f
#define DS_LOAD(t, S) do { const size_t pu_ = (size_t)((b * DN_NCH + DS_CG(t)) * 4 + h) * 2 + dir; \
        _Pragma("unroll") for (int q_ = 0; q_ < 2; ++q_) { const int id_ = tid + 512 * q_; \
            rKC##S[q_] = *(const u32x4*)(DNKC + pu_ * 8192 + (id_ >> 4) * 128 + (id_ & 15) * 8); rQG##S[q_] = *(const u32x4*)(DNQG + pu_ * 8192 + (id_ >> 4) * 128 + (id_ & 15) * 8); \
            rW##S[q_] = *(const u32x4*)(DNW + pu_ * 8192 + (id_ >> 4) * 128 + (id_ & 15) * 8); \
            rKGT##S[q_] = *(const u32x4*)(DNKGT + pu_ * 8192 + (id_ >> 3) * 64 + (id_ & 7) * 8); } \
        rQK##S = *(const u32x4*)(DNQK + pu_ * 4096 + (tid >> 3) * 64 + (tid & 7) * 8); \
        rGL##S = DNGL[pu_]; } while (0)
#define DS_STORE(S) do { _Pragma("unroll") for (int q_ = 0; q_ < 2; ++q_) { const int id_ = tid + 512 * q_; \
            *(LAS u32x4*)(L + DS_KC + (id_ >> 4) * 272 + (id_ & 15) * 16) = rKC##S[q_]; *(LAS u32x4*)(L + DS_QG + (id_ >> 4) * 272 + (id_ & 15) * 16) = rQG##S[q_]; \
            *(LAS u32x4*)(L + DS_W + (id_ >> 4) * 272 + (id_ & 15) * 16) = rW##S[q_]; \
            *(LAS u32x4*)(L + DS_KGT + (id_ >> 3) * 144 + (id_ & 7) * 16) = rKGT##S[q_]; } \
        *(LAS u32x4*)(L + DS_QK + (tid >> 3) * 144 + (tid & 7) * 16) = rQK##S; gl = rGL##S; } while (0)
#define DS_STEP(t) do { const int cg = DS_CG(t); \
        f32x4 av[4], ao[4]; \
        _Pragma("unroll") for (int j = 0; j < 4; ++j) { av[j] = (f32x4){0.f, 0.f, 0.f, 0.f}; ao[j] = av[j]; } \
        _Pragma("unroll") for (int ks = 0; ks < 4; ++ks) { const bf16x8 akc = ldsfrag(L + DS_KC + (16 * mt + rr) * 272 + (32 * ks + 8 * kg) * 2), aqg = ldsfrag(L + DS_QG + (16 * mt + rr) * 272 + (32 * ks + 8 * kg) * 2); \
            _Pragma("unroll") for (int j = 0; j < 4; ++j) { const bf16x8 bs = ldsfrag(L + DS_SB + (64 * ng + 16 * j + rr) * 272 + (32 * ks + 8 * kg) * 2); av[j] = mfma16(akc, bs, av[j]); ao[j] = mfma16(aqg, bs, ao[j]); } } \
        _Pragma("unroll") for (int j = 0; j < 4; ++j) { float vn[4]; \
            _Pragma("unroll") for (int r = 0; r < 4; ++r) vn[r] = bf2f(*(const LAS bf16_t*)(L + DS_W + (16 * mt + 4 * kg + r) * 272 + (64 * ng + 16 * j + rr) * 2)) - av[j][r]; \
            u32x2 w; w.x = pk2(vn[0], vn[1]); w.y = pk2(vn[2], vn[3]); *(LAS u32x2*)(L + DS_VT + (64 * ng + 16 * j + rr) * 144 + (16 * mt + 4 * kg) * 2) = w; } \
        __syncthreads(); \
        bf16x8 bV[4][2]; \
        _Pragma("unroll") for (int ks = 0; ks < 2; ++ks) { const bf16x8 aqk = ldsfrag(L + DS_QK + (16 * mt + rr) * 144 + (32 * ks + 8 * kg) * 2); \
            _Pragma("unroll") for (int j = 0; j < 4; ++j) { bV[j][ks] = ldsfrag(L + DS_VT + (64 * ng + 16 * j + rr) * 144 + (32 * ks + 8 * kg) * 2); ao[j] = mfma16(aqk, bV[j][ks], ao[j]); } } \
        _Pragma("unroll") for (int j = 0; j < 4; ++j) \
            _Pragma("unroll") for (int r = 0; r < 4; ++r) { const int i = 16 * mt + 4 * kg + r, tok = dir ? 63 - i : i; \
                ODN[((size_t)dir * MROWS + (size_t)(b * TOK + 64 * cg + tok)) * 512 + h * 128 + 64 * ng + 16 * j + rr] = (bf16_t)f2bf(ao[j][r]); } \
        _Pragma("unroll") for (int di = 0; di < 2; ++di) \
            _Pragma("unroll") for (int j = 0; j < 4; ++j) s[di][j] = s[di][j] * gl; \
        _Pragma("unroll") for (int ks = 0; ks < 2; ++ks) \
            _Pragma("unroll") for (int di = 0; di < 2; ++di) { const bf16x8 akg = ldsfrag(L + DS_KGT + (32 * mt + 16 * di + rr) * 144 + (32 * ks + 8 * kg) * 2); \
                _Pragma("unroll") for (int j = 0; j < 4; ++j) s[di][j] = mfma16(akg, bV[j][ks], s[di][j]); } \
        __syncthreads(); \
        _Pragma("unroll") for (int di = 0; di < 2; ++di) \
            _Pragma("unroll") for (int j = 0; j < 4; ++j) { u32x2 w; w.x = pk2(s[di][j][0], s[di][j][1]); w.y = pk2(s[di][j][2], s[di][j][3]); \
                *(LAS u32x2*)(L + DS_SB + (64 * ng + 16 * j + rr) * 272 + (32 * mt + 16 * di + 4 * kg) * 2) = w; } } while (0)
    DS_DECL(A); DS_DECL(B); float gl = 0.f;
    DS_LOAD(0, A); DS_LOAD(1, B); DS_STORE(A);
    __syncthreads();
    for (int t = 0; t < DN_NCH; t += 2) {
        if (t + 2 < DN_NCH) DS_LOAD(t + 2, A);
        DS_STEP(t);
        DS_STORE(B);
        __syncthreads();
        if (t + 3 < DN_NCH) DS_LOAD(t + 3, B);
        DS_STEP(t + 1);
        if (t + 2 < DN_NCH) DS_STORE(A);
        __syncthreads();
    }
#undef DS_CG
#undef DS_DECL
#undef DS_LOAD
#undef DS_STORE
#undef DS_STEP
}

__device__ __forceinline__ float log_sigmoid_f(float x) { return -log1pf(expf(-x)); }
constexpr int RP_QS = 0, RP_KS = 34816, RP_DK = 69632;
__device__ __forceinline__ void retprep_unit(Frame& F, int l, int unit) {
    const bf16_t* P = (const bf16_t*)(F.ws + WS_P); bf16_t* RQKD = (bf16_t*)(F.ws + WS_RQKD); bf16_t* RKDT = (bf16_t*)(F.ws + WS_RKDT);
    LAS unsigned char* L = F.lds;
    const int tid = F.tid, lane = F.lane, wave = F.wave, rr = lane & 15, kg = lane >> 4;
    const int h = unit & 3, c = (unit >> 2) % RET_NCH, b = (unit >> 2) / RET_NCH, rbase = b * TOK + 128 * c;
    const size_t pu0 = (size_t)((b * RET_NCH + c) * 4 + h) * 2;
    const float lg0 = log_sigmoid_f(inp(F, I_ret_decay)[l * 8 + h]), lg1 = log_sigmoid_f(inp(F, I_ret_decay)[l * 8 + 4 + h]);
    { const int row = tid >> 2, seg = tid & 3; const bf16_t* src = P + (size_t)(rbase + row) * PW + h * 128 + seg * 32;
#pragma unroll
      for (int q = 0; q < 4; ++q) { *(LAS u32x4*)(L + RP_QS + row * 272 + seg * 64 + q * 16) = *(const u32x4*)(src + C_RQ + q * 8); *(LAS u32x4*)(L + RP_KS + row * 272 + seg * 64 + q * 16) = *(const u32x4*)(src + C_RK + q * 8); } }
    if (tid < 256) ((LAS float*)(L + RP_DK))[tid] = __expf((float)(127 - (tid & 127)) * (tid < 128 ? lg0 : lg1));
    __syncthreads();
    { bf16x8 bQ[4];
#pragma unroll
      for (int ks = 0; ks < 4; ++ks) bQ[ks] = ldsfrag(L + RP_QS + (16 * wave + rr) * 272 + (32 * ks + 8 * kg) * 2);
      const int i = 16 * wave + rr;
      for (int jt = 0; jt < 8; ++jt) { f32x4 cc = {0.f, 0.f, 0.f, 0.f};
#pragma unroll
          for (int ks = 0; ks < 4; ++ks) cc = mfma16(ldsfrag(L + RP_KS + (16 * jt + rr) * 272 + (32 * ks + 8 * kg) * 2), bQ[ks], cc);
          const int jb = 16 * jt + 4 * kg; float v0[4], v1[4];
#pragma unroll
          for (int r = 0; r < 4; ++r) { const int j = jb + r; v0[r] = (j <= i) ? cc[r] * __expf((float)(i - j) * lg0) : 0.f; v1[r] = (j >= i) ? cc[r] * __expf((float)(j - i) * lg1) : 0.f; }
          u32x2 w; w.x = pk2(v0[0], v0[1]); w.y = pk2(v0[2], v0[3]); *(u32x2*)(RQKD + (pu0 + 0) * 16384 + i * 128 + jb) = w;
          w.x = pk2(v1[3], v1[2]); w.y = pk2(v1[1], v1[0]); *(u32x2*)(RQKD + (pu0 + 1) * 16384 + (127 - i) * 128 + (124 - jb)) = w; } }
    { const int d = tid >> 2, sg = tid & 3;
#pragma unroll
      for (int dir = 0; dir < 2; ++dir) { const float lg = dir ? lg1 : lg0;
#pragma unroll
          for (int q = 0; q < 4; ++q) { unsigned ow[4];
              const f32x4 dk0 = *(const LAS f32x4*)(L + RP_DK + (dir * 128 + 32 * sg + 8 * q) * 4), dk1 = *(const LAS f32x4*)(L + RP_DK + (dir * 128 + 32 * sg + 8 * q + 4) * 4);
#pragma unroll
              for (int e = 0; e < 4; ++e) { const int j0 = 32 * sg + 8 * q + 2 * e, j1 = j0 + 1; const int t0 = dir ? 127 - j0 : j0, t1 = dir ? 127 - j1 : j1;
                  const float a0 = bf2f(*(const LAS bf16_t*)(L + RP_KS + t0 * 272 + d * 2)) * (e < 2 ? dk0[2 * e] : dk1[2 * e - 4]), a1 = bf2f(*(const LAS bf16_t*)(L + RP_KS + t1 * 272 + d * 2)) * (e < 2 ? dk0[2 * e + 1] : dk1[2 * e - 3]);
                  ow[e] = pk2(a0, a1); }
              *(u32x4*)(RKDT + (pu0 + dir) * 16384 + d * 128 + 32 * sg + 8 * q) = (u32x4){ow[0], ow[1], ow[2], ow[3]}; } } }
    __syncthreads();
}

constexpr int RS_VS = 0, RS_SB = 36864;
__device__ __forceinline__ s16x4 rs_tr_read(unsigned addr) { s16x4 r; asm volatile("ds_read_b64_tr_b16 %0, %1" : "=&v"(r) : "v"(addr) : "memory"); return r; }
__device__ __forceinline__ bf16x8 rs_scale_frag(bf16x8 f, float sc) { u32x4 w = __builtin_bit_cast(u32x4, f);
    w.x = pk2(bflo(w.x) * sc, bfhi(w.x) * sc); w.y = pk2(bflo(w.y) * sc, bfhi(w.y) * sc); w.z = pk2(bflo(w.z) * sc, bfhi(w.z) * sc); w.w = pk2(bflo(w.w) * sc, bfhi(w.w) * sc); return __builtin_bit_cast(bf16x8, w); }
__device__ __forceinline__ void retscan_unit(Frame& F, int l, int unit) {
    const bf16_t* P = (const bf16_t*)(F.ws + WS_P); const bf16_t* RQKD = (const bf16_t*)(F.ws + WS_RQKD); const bf16_t* RKDT = (const bf16_t*)(F.ws + WS_RKDT); bf16_t* ORET = (bf16_t*)(F.ws + WS_ORET);
    LAS unsigned char* L = F.lds;
    const int tid = F.tid, lane = F.lane, wave = F.wave, rr = lane & 15, kg = lane >> 4;
    const int dir = unit & 1, h = (unit >> 1) & 3, b = unit >> 3;
    const float lg = log_sigmoid_f(inp(F, I_ret_decay)[l * 8 + dir * 4 + h]), gC = __expf(128.f * lg);
    const int irow = 16 * wave + rr;
    const unsigned vtr = (unsigned)(uintptr_t)L + (unsigned)(RS_VS + (8 * kg + (rr >> 2)) * 288 + (4 * (rr & 3)) * 2);
    f32x4 s[8];
#pragma unroll
    for (int j = 0; j < 8; ++j) s[j] = (f32x4){0.f, 0.f, 0.f, 0.f};
    for (int i = tid; i < 34816 / 4; i += NWAVES * 64) ((LAS unsigned*)(L + RS_SB))[i] = 0u;
#define RS_C(t) (dir ? ((t) < 2 ? 1 - (t) : 67 - (t)) : (t))
    bf16x8 fQ[4], fD[4], fK[4]; u32x4 rV[4];
#define RS_FLOAD(t) do { const int c_ = RS_C(t); const size_t pu_ = (size_t)((b * RET_NCH + c_) * 4 + h) * 2 + dir; const size_t rb_ = (size_t)b * TOK + 128 * c_; \
        const bf16_t* q_ = P + (rb_ + (dir ? 127 - irow : irow)) * PW + C_RQ + h * 128 + 8 * kg; const bf16_t* d_ = RQKD + pu_ * 16384 + irow * 128 + 8 * kg; const bf16_t* k_ = RKDT + pu_ * 16384 + irow * 128 + 8 * kg; \
        _Pragma("unroll") for (int ks = 0; ks < 4; ++ks) { fQ[ks] = *(const bf16x8*)(q_ + 32 * ks); fD[ks] = *(const bf16x8*)(d_ + 32 * ks); fK[ks] = *(const bf16x8*)(k_ + 32 * ks); } } while (0)
#define RS_VLOAD(t) do { const size_t rb_ = (size_t)b * TOK + 128 * RS_C(t); \
        _Pragma("unroll") for (int q4 = 0; q4 < 4; ++q4) { const int id_ = tid + 512 * q4, row_ = id_ >> 4; rV[q4] = *(const u32x4*)(P + (rb_ + (dir ? 127 - row_ : row_)) * PW + C_RV + h * 128 + (id_ & 15) * 8); } } while (0)
#define RS_VSTORE() do { _Pragma("unroll") for (int q4 = 0; q4 < 4; ++q4) { const int id_ = tid + 512 * q4; *(LAS u32x4*)(L + RS_VS + (id_ >> 4) * 288 + (id_ & 15) * 16) = rV[q4]; } } while (0)
    float rsc[4];
#pragma unroll
    for (int r = 0; r < 4; ++r) rsc[r] = __expf((float)(16 * wave + 4 * kg + r + 1) * lg);
    RS_FLOAD(0); RS_VLOAD(0); RS_VSTORE(); if (1 < RET_NCH) RS_VLOAD(1);
    __syncthreads();
    for (int t = 0; t < RET_NCH; ++t) {
        const int c = RS_C(t);
#pragma unroll
        for (int nt = 0; nt < 8; ++nt) { bf16x8 bS[4]; s16x4 vl[4], vh[4];
#pragma unroll
            for (int ks = 0; ks < 4; ++ks) { bS[ks] = ldsfrag(L + RS_SB + (16 * nt + rr) * 272 + (32 * ks + 8 * kg) * 2);
                vl[ks] = rs_tr_read(vtr + (unsigned)((32 * ks) * 288 + 32 * nt)); vh[ks] = rs_tr_read(vtr + (unsigned)((32 * ks + 4) * 288 + 32 * nt)); }
            asm volatile("s_waitcnt lgkmcnt(0)" ::: "memory"); __builtin_amdgcn_sched_barrier(0);
            f32x4 o1 = {0.f, 0.f, 0.f, 0.f}, o2 = {0.f, 0.f, 0.f, 0.f}; s[nt] = s[nt] * gC;
#pragma unroll
            for (int ks = 0; ks < 4; ++ks) { const bf16x8 bv = (bf16x8){vl[ks][0], vl[ks][1], vl[ks][2], vl[ks][3], vh[ks][0], vh[ks][1], vh[ks][2], vh[ks][3]};
                o1 = mfma16(fQ[ks], bS[ks], o1); o2 = mfma16(fD[ks], bv, o2); s[nt] = mfma16(fK[ks], bv, s[nt]); }
#pragma unroll
            for (int r = 0; r < 4; ++r) { const int i = 16 * wave + 4 * kg + r, tok = dir ? 127 - i : i;
                ORET[((size_t)dir * MROWS + (size_t)(b * TOK + 128 * c + tok)) * 512 + h * 128 + 16 * nt + rr] = (bf16_t)f2bf(o1[r] * rsc[r] + o2[r]); } }
        if (t + 1 < RET_NCH) RS_FLOAD(t + 1);
        __syncthreads();
#pragma unroll
        for (int nt = 0; nt < 8; ++nt) { u32x2 w; w.x = pk2(s[nt][0], s[nt][1]); w.y = pk2(s[nt][2], s[nt][3]); *(LAS u32x2*)(L + RS_SB + (16 * nt + rr) * 272 + (16 * wave + 4 * kg) * 2) = w; }
        if (t + 1 < RET_NCH) RS_VSTORE();
        __syncthreads();
        if (t + 2 < RET_NCH) RS_VLOAD(t + 2);
    }
#undef RS_C
#undef RS_FLOAD
#undef RS_VLOAD
#undef RS_VSTORE
}

constexpr int ATT_SPLIT = 2304;
__device__ __forceinline__ void attention_phase(Frame& F, int l, bool keep_ctx) {
    const bf16_t* P = (const bf16_t*)(F.ws + WS_P); bf16_t* Y = (bf16_t*)(F.ws + WS_Y); bf16_t* OPART = (bf16_t*)(F.ws + WS_OPART); float* ASTAT = (float*)(F.ws + WS_ASTAT);
    unsigned* qhead = F.ctl + CW_ATTQ + 64 * l; volatile LAS unsigned* slot = F.MISC + 4;
    const unsigned nunits = 1024u + (keep_ctx ? 16u : 0u);
    float mraw; { const float* qn = inp(F, I_att_qn_w) + l * 128; const float* kn = inp(F, I_att_kn_w) + l * 128; float a = fmaxf(fabsf(qn[F.lane]), fabsf(qn[64 + F.lane])), b = fmaxf(fabsf(kn[F.lane]), fabsf(kn[64 + F.lane]));
#pragma unroll
      for (int o = 32; o > 0; o >>= 1) { a = fmaxf(a, __shfl_xor(a, o)); b = fmaxf(b, __shfl_xor(b, o)); }
      mraw = __int_as_float(__builtin_amdgcn_readfirstlane(__float_as_int(128.f * 1.01f * a * b))); }
    const bool fixm = mraw * att::SCALE <= 40.f;
    for (;;) {
        __syncthreads();
        if (F.tid == 0) *slot = __hip_atomic_fetch_add(qhead, 1u, __ATOMIC_RELAXED, __HIP_MEMORY_SCOPE_AGENT);
        __syncthreads();
        const unsigned idx = *slot;
        if (idx >= nunits) break;
        if (idx < 1024u) { const int qb = idx & 31, g = (idx >> 5) & 3, kvh = (idx >> 7) & 1, b = (idx >> 8) & 1, part = 1 - (int)(idx >> 9), hq = kvh * 4 + g;
            const size_t qrow0 = (size_t)b * TOK + CTXL + 256 * qb, krow0 = (size_t)b * TOK + (size_t)part * ATT_SPLIT; const int nkeys = part ? TOK - ATT_SPLIT : ATT_SPLIT;
            if (fixm) att::attn_dense_body<att::bf16, 1024, true>((const att::bf16*)(P + qrow0 * PW + C_AQ + hq * 128), (const att::bf16*)(P + krow0 * PW + C_AK + kvh * 128), (const att::bf16*)(P + krow0 * PW + C_AV + kvh * 128),
                                                  OPART + ((size_t)part * MROWS + qrow0) * 1024 + hq * 128, ASTAT + (((size_t)part * MROWS + qrow0) * 8 + hq) * 2, nkeys, (char*)F.ldsg, 0.f);
            else att::attn_dense_body<att::bf16, 1024, false>((const att::bf16*)(P + qrow0 * PW + C_AQ + hq * 128), (const att::bf16*)(P + krow0 * PW + C_AK + kvh * 128), (const att::bf16*)(P + krow0 * PW + C_AV + kvh * 128),
                                                  OPART + ((size_t)part * MROWS + qrow0) * 1024 + hq * 128, ASTAT + (((size_t)part * MROWS + qrow0) * 8 + hq) * 2, nkeys, (char*)F.ldsg, 0.f); }
        else { const int j = idx - 1024, hq = j & 7, b = j >> 3, kvh = hq >> 2; const size_t qrow0 = (size_t)b * TOK;
            att::attn_dense_body<att::bf16, YW, false>((const att::bf16*)(P + qrow0 * PW + C_AQ + hq * 128), (const att::bf16*)(P + qrow0 * PW + C_AK + kvh * 128), (const att::bf16*)(P + qrow0 * PW + C_AV + kvh * 128),
                                                Y + qrow0 * YW + 1024 + hq * 128, nullptr, CTXL, (char*)F.ldsg, 0.f); }
    }
}

__device__ __forceinline__ void mixepi_phase(Frame& F, int l, bool keep_ctx) {
    const bf16_t* P = (const bf16_t*)(F.ws + WS_P); bf16_t* Y = (bf16_t*)(F.ws + WS_Y); const bf16_t* ORET = (const bf16_t*)(F.ws + WS_ORET); const bf16_t* ODN = (const bf16_t*)(F.ws + WS_ODN);
    const bf16_t* OPART = (const bf16_t*)(F.ws + WS_OPART); const float* ASTAT = (const float*)(F.ws + WS_ASTAT);
    const int lane = F.lane, gw = F.vcu * NWAVES + F.wave, NGW = F.G * NWAVES, c0 = 8 * lane;
    const f32x4 nw0 = *(const f32x4*)(inp(F, I_dn_norm_w) + l * 128 + (c0 & 127)), nw1 = *(const f32x4*)(inp(F, I_dn_norm_w) + l * 128 + (c0 & 127) + 4);
    struct RowIn { u32x4 fa[2], fb[2], gz[2], o1[2], o2[2]; f32x2 s1[2], s2[2]; };
#define MX_VALID(r) ((r) < MROWS && (keep_ctx || ((r) % TOK) >= CTXL))
#define MX_NEXT(r) do { r += NGW; } while ((r) < MROWS && !MX_VALID(r))
#define MX_LOAD(S, r) do { const size_t r_ = (size_t)(r); const bool lat_ = ((r) % TOK) >= CTXL; \
        S.fa[0] = *(const u32x4*)(ORET + r_ * 512 + c0); S.fb[0] = *(const u32x4*)(ORET + ((size_t)MROWS + r_) * 512 + c0); S.gz[0] = *(const u32x4*)(P + r_ * PW + C_RG + c0); \
        S.fa[1] = *(const u32x4*)(ODN + r_ * 512 + c0); S.fb[1] = *(const u32x4*)(ODN + ((size_t)MROWS + r_) * 512 + c0); S.gz[1] = *(const u32x4*)(P + r_ * PW + C_DZ + c0); \
        if (lat_) { _Pragma("unroll") for (int q = 0; q < 2; ++q) { const int ch = lane + 64 * q, hq = ch >> 4; \
            S.s1[q] = *(const f32x2*)(ASTAT + (r_ * 8 + hq) * 2); S.s2[q] = *(const f32x2*)(ASTAT + (((size_t)MROWS + r_) * 8 + hq) * 2); \
            S.o1[q] = *(const u32x4*)(OPART + r_ * 1024 + ch * 8); S.o2[q] = *(const u32x4*)(OPART + ((size_t)MROWS + r_) * 1024 + ch * 8); } } } while (0)
#define MX_PROC(S, r) do { const size_t r_ = (size_t)(r); const bool lat_ = ((r) % TOK) >= CTXL; \
        _Pragma("unroll") for (int grp = 0; grp < 2; ++grp) { const u32x4 fa = S.fa[grp], fb = S.fb[grp], gz = S.gz[grp]; \
            f32x4 o0 = (f32x4){bflo(fa.x) + bflo(fb.x), bfhi(fa.x) + bfhi(fb.x), bflo(fa.y) + bflo(fb.y), bfhi(fa.y) + bfhi(fb.y)}, o1 = (f32x4){bflo(fa.z) + bflo(fb.z), bfhi(fa.z) + bfhi(fb.z), bflo(fa.w) + bflo(fb.w), bfhi(fa.w) + bfhi(fb.w)}; \
            float ss = (o0[0] * o0[0] + o0[1] * o0[1]) + (o0[2] * o0[2] + o0[3] * o0[3]) + (o1[0] * o1[0] + o1[1] * o1[1]) + (o1[2] * o1[2] + o1[3] * o1[3]); \
            const float ri = rsqrtf(sum16(ss) * (1.f / 128.f) + EPS); \
            o0 = o0 * ri; o1 = o1 * ri; if (grp) { o0 = o0 * nw0; o1 = o1 * nw1; } \
            u32x4 w; w.x = pk2(o0[0] * silu_f(bflo(gz.x)), o0[1] * silu_f(bfhi(gz.x))); w.y = pk2(o0[2] * silu_f(bflo(gz.y)), o0[3] * silu_f(bfhi(gz.y))); \
            w.z = pk2(o1[0] * silu_f(bflo(gz.z)), o1[1] * silu_f(bfhi(gz.z))); w.w = pk2(o1[2] * silu_f(bflo(gz.w)), o1[3] * silu_f(bfhi(gz.w))); \
            *(u32x4*)(Y + r_ * YW + grp * 512 + c0) = w; } \
        if (lat_) { constexpr float C = 1.f;     \
            _Pragma("unroll") for (int q = 0; q < 2; ++q) { const int ch = lane + 64 * q; const f32x2 s1 = S.s1[q], s2 = S.s2[q]; const u32x4 o1 = S.o1[q], o2 = S.o2[q]; \
                const float m = fmaxf(s1.x, s2.x), a1 = s1.y * __builtin_amdgcn_exp2f((s1.x - m) * C), a2 = s2.y * __builtin_amdgcn_exp2f((s2.x - m) * C), inv = 1.f / (a1 + a2), w1 = a1 * inv, w2 = a2 * inv; \
                u32x4 w; w.x = pk2(w1 * bflo(o1.x) + w2 * bflo(o2.x), w1 * bfhi(o1.x) + w2 * bfhi(o2.x)); w.y = pk2(w1 * bflo(o1.y) + w2 * bflo(o2.y), w1 * bfhi(o1.y) + w2 * bfhi(o2.y)); \
                w.z = pk2(w1 * bflo(o1.z) + w2 * bflo(o2.z), w1 * bfhi(o1.z) + w2 * bfhi(o2.z)); w.w = pk2(w1 * bflo(o1.w) + w2 * bflo(o2.w), w1 * bfhi(o1.w) + w2 * bfhi(o2.w)); \
                *(u32x4*)(Y + r_ * YW + 1024 + ch * 8) = w; } } } while (0)
    RowIn A, B;
    int r = gw; if (!MX_VALID(r) && r < MROWS) MX_NEXT(r);
    if (r < MROWS) MX_LOAD(A, r);
    while (r < MROWS) {
        int rn = r; MX_NEXT(rn); if (rn < MROWS) MX_LOAD(B, rn);
        MX_PROC(A, r); r = rn; if (r >= MROWS) break;
        rn = r; MX_NEXT(rn); if (rn < MROWS) MX_LOAD(A, rn);
        MX_PROC(B, r); r = rn;
    }
#undef MX_VALID
#undef MX_NEXT
#undef MX_LOAD
#undef MX_PROC
}
constexpr int NSTEPS = 2 + 10 * DEPTH;
#ifndef PH_MASK
#define PH_MASK 0xFFFFF
#endif
#define PH(k) (((PH_MASK) >> (k)) & 1)
struct Args { const float* in[21]; float* out; unsigned char* ws; int s_lo, s_hi; };
__global__ void __launch_bounds__(NWAVES * 64, 2) fwd(Args a) {
    extern __shared__ __attribute__((aligned(16))) unsigned char lds_raw[];
    Frame F;
    F.lds = (LAS unsigned char*)lds_raw; F.ldsg = lds_raw;
    F.MISC = (volatile LAS unsigned*)(F.lds + MISC_OFF);
    F.tid = threadIdx.x; F.lane = F.tid & 63; F.wave = __builtin_amdgcn_readfirstlane(F.tid >> 6);
    F.G = gridDim.x; { const int bx = blockIdx.x; F.vcu = (F.G % 8 == 0) ? (bx % 8) * (F.G / 8) + bx / 8 : bx; }
    F.ws = a.ws; F.ctl = (unsigned*)(a.ws + WS_CTL);
    for (int u = F.tid; u < (LDS_BYTES - RING_BYTES) / 4; u += NWAVES * 64) ((LAS unsigned*)(F.lds + RING_BYTES))[u] = 0u;
    __syncthreads();
    if (F.tid == 0) {
#define PUTP(k, p) do { const unsigned long long v_ = (unsigned long long)(p); F.MISC[16 + 2 * (k)] = (unsigned)v_; F.MISC[17 + 2 * (k)] = (unsigned)(v_ >> 32); } while (0)
        PUTP(0, a.in[0]); PUTP(1, a.in[1]); PUTP(2, a.in[2]); PUTP(3, a.in[3]); PUTP(4, a.in[4]); PUTP(5, a.in[5]); PUTP(6, a.in[6]); PUTP(7, a.in[7]); PUTP(8, a.in[8]); PUTP(9, a.in[9]); PUTP(10, a.in[10]);
        PUTP(11, a.in[11]); PUTP(12, a.in[12]); PUTP(13, a.in[13]); PUTP(14, a.in[14]); PUTP(15, a.in[15]); PUTP(16, a.in[16]); PUTP(17, a.in[17]); PUTP(18, a.in[18]); PUTP(19, a.in[19]); PUTP(20, a.in[20]); PUTP(21, a.out);
#undef PUTP
    }
    __syncthreads();
    XcdBarrier bar; bar.bar = F.ctl + CW_BAR; bar.x = 0; bar.st = nullptr;
    if (MK_ONE_LAUNCH) bar = xcd_barrier_post(F.ctl + CW_BAR, F.MISC + 8);
    const int lo = a.s_lo, hi = a.s_hi;
#define IN(k) (lo <= (k) && (k) < hi)
#define ENTER() do { F.tid = opaque_tid(); F.lane = F.tid & 63; F.wave = __builtin_amdgcn_readfirstlane(F.tid >> 6); F.ws = opaque_ptr(a.ws); F.ctl = (unsigned*)F.ws; } while (0)
#define SEAM(k) do { if (MK_ONE_LAUNCH && IN(k) && IN((k) + 1)) xcd_barrier(bar); } while (0)
#define Hb ((bf16_t*)(F.ws + WS_H))
#define Pb ((bf16_t*)(F.ws + WS_P))
#define Yb ((bf16_t*)(F.ws + WS_Y))
#define Xf ((float*)(F.ws + WS_X))
#define ABf ((float*)(F.ws + WS_AB))
#define MOD ((const float*)(F.ws + WS_MOD))

#ifdef PROBE_MASK
#define PROBE_T0() const unsigned long long t0_ = __builtin_amdgcn_s_memrealtime()
#define PROBE_DELAY(cls) do { if (((PROBE_MASK) >> (cls)) & 1) { const unsigned long long t1_ = __builtin_amdgcn_s_memrealtime(), d_ = t1_ - t0_; while (__builtin_amdgcn_s_memrealtime() - t1_ < d_) __builtin_amdgcn_s_sleep(8); } } while (0)
#else
#define PROBE_T0() do { } while (0)
#define PROBE_DELAY(cls) do { } while (0)
#endif
#define STEP(k, cls, ...) do { if (IN(k)) { PROBE_T0(); { __VA_ARGS__ } SEAM(k); PROBE_DELAY(cls); } } while (0)

    STEP(0, 0, if (PH(0)) { ENTER(); prologue_phase(F); });
    STEP(1, 0, if (PH(1)) { ENTER(); ln_mod_phase<0>(F, 0, false); });
    for (int l = 0; l < DEPTH; ++l) {
        const int sb = 2 + 10 * l; if (sb + 10 <= lo || sb >= hi) continue;
        const bool keep_ctx = l < DEPTH - 1; const int skip = keep_ctx ? 0 : 1;
        STEP(sb + 0, 1, if (PH(2)) { ENTER();
            pg8::Gemm g{Hb, (const bf16_t*)(F.ws + WS_WIN) + (size_t)l * PWPAD * DM, MROWS, PWPAD, DM}; pg8::RowOrder S; S.init(PWPAD / 256, F.G, (int)blockIdx.x, 0);
            pg8::EpiProj E{Pb, ABf};
            pg8::gemm_phase<pg8::EpiProj, pg8::RowOrder, true, true>(F.lds, g, S, E); });
        STEP(sb + 1, 2, if (PH(3)) { ENTER(); rowprep_phase(F, l); });
        STEP(sb + 2, 3,
            if (PH(4)) { ENTER(); for (int u = F.vcu; u < NBATCH * DN_NCH * 4; u += F.G) dnprep_unit(F, u); }
            if (PH(13)) { ENTER(); const int nfive = (NBATCH * DN_NCH * 4) % F.G;
                if (F.vcu >= nfive) for (int u = F.vcu - nfive; u < NBATCH * RET_NCH * 4; u += F.G - nfive) retprep_unit(F, l, u); });
        STEP(sb + 3, 4,
            if (PH(5)) { ENTER(); for (int u = (int)blockIdx.x; u < 16; u += F.G) dnscan_unit(F, u); }
            if (PH(14)) { ENTER(); for (int u = (int)blockIdx.x - 16; u < 16; u += F.G) { if (u >= 0) retscan_unit(F, l, u); } }
            if (PH(6)) { ENTER(); attention_phase(F, l, keep_ctx); });
        STEP(sb + 4, 5, if (PH(7)) { ENTER(); mixepi_phase(F, l, keep_ctx); });
        STEP(sb + 5, 6, if (PH(8)) { ENTER();
            pg8::Gemm g{Yb, (const bf16_t*)(F.ws + WS_WO) + (size_t)l * DM * DM, MROWS, DM, DM}; pg8::RowOrder S; S.init(DM / 256, F.G, (int)blockIdx.x, 1);
            const float* lnw_ = inp(F, I_ln2_w) + (l > 0 ? l - 1 : 0) * DM; const float* lnb_ = inp(F, I_ln2_b) + (l > 0 ? l - 1 : 0) * DM; const float* lns_ = (const float*)(F.ws + WS_LNS);
            pg8::EpiResid E{Xf, MOD + (size_t)(l * 3) * 12288 + 2 * DM, ALPHA, lns_, lnw_, lnb_, l > 0 ? 1 : 0};
            pg8::gemm_phase<pg8::EpiResid, pg8::RowOrder, false, true>(F.lds, g, S, E);
            if (keep_ctx) { ENTER(); ctx_gemm_resid(F, Yb, (const bf16_t*)(F.ws + WS_WO) + (size_t)l * DM * DM, DM, Xf, MOD + (size_t)(l * 3 + 2) * 12288 + 2 * DM, ALPHA, (const float*)(F.ws + WS_LNS), inp(F, I_ln2_w) + (l > 0 ? l - 1 : 0) * DM, inp(F, I_ln2_b) + (l > 0 ? l - 1 : 0) * DM, l > 0 ? 1 : 0); } });
        STEP(sb + 6, 7, if (PH(9)) { ENTER(); ln_mod_phase<1>(F, l, !keep_ctx); });
        STEP(sb + 7, 8, if (PH(10)) { ENTER();
            pg8::Gemm g{Hb, (const bf16_t*)(F.ws + WS_WFI) + (size_t)l * 2 * DFF * DM, MROWS, 2 * DFF, DM}; pg8::RowOrder S; S.init(2 * DFF / 256, F.G, (int)blockIdx.x, skip);
            pg8::EpiSwiglu E{Pb};
            pg8::gemm_phase<pg8::EpiSwiglu, pg8::RowOrder, true, true>(F.lds, g, S, E); });
        STEP(sb + 8, 9, if (PH(11)) { ENTER();
            pg8::Gemm g{Pb, (const bf16_t*)(F.ws + WS_WFO) + (size_t)l * DM * DFF, MROWS, DM, DFF}; pg8::RowOrder S; S.init(DM / 256, F.G, (int)blockIdx.x, 1);
            const float* lnw_ = inp(F, I_ln1_w) + l * DM; const float* lnb_ = inp(F, I_ln1_b) + l * DM; const float* lns_ = (const float*)(F.ws + WS_LNS);
            pg8::EpiResid E{Xf, MOD + (size_t)(l * 3) * 12288 + 5 * DM, ALPHA, lns_, lnw_, lnb_, 1};
            pg8::gemm_phase<pg8::EpiResid, pg8::RowOrder, false, true>(F.lds, g, S, E);
            if (keep_ctx) { ENTER(); ctx_gemm_resid(F, Pb, (const bf16_t*)(F.ws + WS_WFO) + (size_t)l * DM * DFF, DFF, Xf, MOD + (size_t)(l * 3 + 2) * 12288 + 5 * DM, ALPHA, (const float*)(F.ws + WS_LNS), inp(F, I_ln1_w) + l * DM, inp(F, I_ln1_b) + l * DM, 1); } });
        STEP(sb + 9, 10, if (PH(12)) { ENTER(); if (keep_ctx) ln_mod_phase<2>(F, l, false); else ln_mod_phase<3>(F, l, true); });
    }
#undef STEP
#undef PROBE_T0
#undef PROBE_DELAY
#undef IN
#undef SEAM
#undef ENTER
#undef Hb
#undef Pb
#undef Yb
#undef Xf
#undef ABf
#undef MOD
}

extern "C" void kernel_launch(void* const* d_in, const int* in_sizes, int n_in, void* d_out, int out_size, void* d_ws, size_t ws_size, hipStream_t stream) {
    static int grid = 0;
    if (grid == 0) {
        if (n_in != 21 || in_sizes[0] != NBATCH * SEQ * DM || out_size != NBATCH * SEQ * DM || ws_size < WS_END) {
            fprintf(stderr, "kernel_launch: shape mismatch: n_in %d in0 %d out %d ws %zu (need >= %zu)\n", n_in, n_in > 0 ? in_sizes[0] : -1, out_size, ws_size, (size_t)WS_END); grid = -1; return; }
        int dev = 0, cus = 0, per_cu = 0;
        if (hipGetDevice(&dev) != hipSuccess || hipDeviceGetAttribute(&cus, hipDeviceAttributeMultiprocessorCount, dev) != hipSuccess) { fprintf(stderr, "kernel_launch: device query failed\n"); grid = -1; return; }
        if (hipFuncSetAttribute((const void*)fwd, hipFuncAttributeMaxDynamicSharedMemorySize, LDS_BYTES) != hipSuccess) { fprintf(stderr, "kernel_launch: hipFuncSetAttribute failed\n"); grid = -1; return; }
        if (hipOccupancyMaxActiveBlocksPerMultiprocessor(&per_cu, (const void*)fwd, NWAVES * 64, LDS_BYTES) != hipSuccess || per_cu < 1)
            fprintf(stderr, "kernel_launch: note: occupancy query reports %d workgroups per CU\n", per_cu);
        (void)hipGetLastError();
        grid = cus;
    }
    if (grid < 0) return;
    if (hipMemsetAsync((char*)d_ws + WS_CTL, 0, CTL_ZERO_BYTES, stream) != hipSuccess) { fprintf(stderr, "kernel_launch: memset failed\n"); return; }
    Args a{};
    for (int i = 0; i < 21; ++i) a.in[i] = (const float*)d_in[i];
    a.out = (float*)d_out; a.ws = (unsigned char*)d_ws;
#if MK_ONE_LAUNCH
    a.s_lo = 0; a.s_hi = NSTEPS;
    hipLaunchKernelGGL(fwd, dim3(grid), dim3(NWAVES * 64), LDS_BYTES, stream, a);
#else
    for (int s = 0; s < NSTEPS; ++s) { a.s_lo = s; a.s_hi = s + 1; hipLaunchKernelGGL(fwd, dim3(grid), dim3(NWAVES * 64), LDS_BYTES, stream, a); }
#endif
    const hipError_t le = hipPeekAtLastError();
    if (le != hipSuccess) fprintf(stderr, "kernel_launch: launch failed: %s\n", hipGetErrorName(le));
}
```

```cpp
#include <hip/hip_runtime.h>
#include <hip/hip_bf16.h>
#include <cstdio>
#include <cstdint>

#ifndef MK_ONE_LAUNCH
#define MK_ONE_LAUNCH 1
#endif

constexpr int DM = 2048, NBATCH = 2, SEQ = 8192, CTXL = 256, TOK = CTXL + SEQ  , MROWS = NBATCH * TOK  , DEPTH = 4;
constexpr int HD = 128, DFF = 5632, PW = 5632  , PWPAD = 5888, PROJ_SRC = 5648;
constexpr int C_RQ = 0, C_RK = 512, C_RV = 1024, C_RG = 1536, C_DQKV = 2048, C_DZ = 3584, C_AQ = 4096, C_AK = 5120, C_AV = 5376;
constexpr int YW = 2048;
constexpr float ALPHA = 1.6817928305074292f;
constexpr float EPS = 1e-6f;
constexpr int DN_NCH = TOK / 64  , RET_NCH = TOK / 128  ;
constexpr int DN_PU = NBATCH * DN_NCH * 4 * 2  , RET_PU = NBATCH * RET_NCH * 4 * 2  ;

constexpr size_t MiB = 1u << 20;
constexpr size_t WS_CTL = 0, CTL_ZERO_BYTES = 1 * MiB;
constexpr size_t WS_MOD = 1 * MiB;
constexpr size_t WS_WIN = 2 * MiB;
constexpr size_t WS_WO = 94 * MiB;
constexpr size_t WS_WFI = 126 * MiB;
constexpr size_t WS_WFO = 302 * MiB;
constexpr size_t WS_X = 390 * MiB;
constexpr size_t WS_H = 522 * MiB;
constexpr size_t WS_P = 588 * MiB;
constexpr size_t WS_AB = 770 * MiB;
constexpr size_t WS_Y = 772 * MiB;
constexpr size_t WS_DQ = 838 * MiB;
constexpr size_t WS_DNW = 888 * MiB, WS_DNKC = 921 * MiB, WS_DNQG = 954 * MiB, WS_DNKGT = 987 * MiB;
constexpr size_t WS_DNQK = 1020 * MiB;
constexpr size_t WS_DNGL = 1037 * MiB;
constexpr size_t WS_ODN = 1038 * MiB;
constexpr size_t WS_ORET = 1104 * MiB;
constexpr size_t WS_RQKD = 1170 * MiB, WS_RKDT = 1203 * MiB;
constexpr size_t WS_OPART = 1236 * MiB;
constexpr size_t WS_ASTAT = 1302 * MiB;
constexpr size_t WS_LNS = 1305 * MiB;
constexpr size_t WS_END = 1306 * MiB;
static_assert(WS_WIN + (size_t)DEPTH * PWPAD * DM * 2 <= WS_WO && WS_WO + (size_t)DEPTH * DM * DM * 2 <= WS_WFI && WS_WFI + (size_t)DEPTH * 2 * DFF * DM * 2 <= WS_WFO && WS_WFO + (size_t)DEPTH * DM * DFF * 2 <= WS_X, "ws map (weights)");
static_assert(WS_X + (size_t)MROWS * DM * 4 <= WS_H && WS_H + (size_t)MROWS * DM * 2 <= WS_P && WS_P + (size_t)MROWS * PW * 2 <= WS_AB && WS_AB + (size_t)MROWS * 64 <= WS_Y && WS_Y + (size_t)MROWS * YW * 2 <= WS_DQ && WS_DQ + (size_t)MROWS * 1536 * 2 <= WS_DNW, "ws map (activations)");
static_assert(WS_DNW + (size_t)DN_PU * 16384 <= WS_DNKC && WS_DNQK + (size_t)DN_PU * 8192 <= WS_DNGL && WS_ODN + (size_t)2 * MROWS * 512 * 4 <= WS_ORET && WS_ORET + (size_t)2 * MROWS * 512 * 4 <= WS_RQKD && WS_RQKD + (size_t)RET_PU * 32768 <= WS_RKDT && WS_RKDT + (size_t)RET_PU * 32768 <= WS_END, "ws map (mixers)");
constexpr int CW_BAR = 4096;
constexpr int CW_ATTQ = 16384;

constexpr int RING_BYTES = 143360;
constexpr int MISC_OFF = RING_BYTES + 320;
constexpr int LDS_BYTES = 147456;
constexpr int NWAVES = 8;

#define GAS __attribute__((address_space(1)))
#define LAS __attribute__((address_space(3)))
typedef unsigned short bf16_t;
typedef short bf16x8 __attribute__((ext_vector_type(8)));
typedef short s16x4 __attribute__((ext_vector_type(4)));
typedef float f32x4 __attribute__((ext_vector_type(4)));
typedef float f32x2 __attribute__((ext_vector_type(2)));
typedef unsigned u32x4 __attribute__((ext_vector_type(4)));
typedef unsigned u32x2 __attribute__((ext_vector_type(2)));
#define LDS_WAIT() asm volatile("s_waitcnt lgkmcnt(0)" ::: "memory")
#define VM_WAIT() asm volatile("s_waitcnt vmcnt(0)" ::: "memory")
typedef float f32x2_cv __attribute__((ext_vector_type(2))); typedef __bf16 bf16x2_cv __attribute__((ext_vector_type(2)));
__device__ __forceinline__ unsigned pk2(float lo, float hi) { const bf16x2_cv r = __builtin_convertvector((f32x2_cv){lo, hi}, bf16x2_cv); return __builtin_bit_cast(unsigned, r); }
__device__ __forceinline__ unsigned f2bf(float f) { return pk2(f, 0.f) & 0xffffu; }
__device__ __forceinline__ float bf2f(unsigned short b) { return __builtin_bit_cast(float, ((unsigned)b) << 16); }
__device__ __forceinline__ float bflo(unsigned w) { return __builtin_bit_cast(float, w << 16); }
__device__ __forceinline__ float bfhi(unsigned w) { return __builtin_bit_cast(float, w & 0xffff0000u); }
__device__ __forceinline__ int opaque_tid() { int t = (int)threadIdx.x; asm volatile("" : "+v"(t)); return t; }
__device__ __forceinline__ unsigned char* opaque_ptr(unsigned char* p) { unsigned long long v = (unsigned long long)p; asm volatile("" : "+s"(v)); return (unsigned char*)(GAS unsigned char*)v; }
__device__ __forceinline__ float wave_sum(float v) {
#pragma unroll
    for (int o = 1; o < 64; o <<= 1) v += __shfl_xor(v, o);
    return v;
}
__device__ __forceinline__ float sum16(float v) { v += __shfl_xor(v, 1); v += __shfl_xor(v, 2); v += __shfl_xor(v, 4); v += __shfl_xor(v, 8); return v; }
__device__ __forceinline__ float silu_f(float x) { return x * __builtin_amdgcn_rcpf(1.f + __expf(-x)); }
__device__ __forceinline__ f32x4 mfma16(bf16x8 a, bf16x8 b, f32x4 c) { return __builtin_amdgcn_mfma_f32_16x16x32_bf16(a, b, c, 0, 0, 0); }
__device__ __forceinline__ bf16x8 ldsfrag(const LAS unsigned char* p) { return *(const LAS bf16x8*)p; }

#define XB_TMO      128
#define XB_XCNT(j)  (256  + 64 * (j))
#define XB_XSUB(j)  (1280 + 64 * (j))
#define XB_XGEN(j)  (2304 + 64 * (j))
#define XB_TOP      3328
#define XB_TOPGEN   3392
#define XCD_BAR_WORDS 3456
#define XB_SPIN_CAP (1u << 18)
__device__ __forceinline__ unsigned xb_ld(unsigned* p)              { return __hip_atomic_load(p, __ATOMIC_RELAXED, __HIP_MEMORY_SCOPE_AGENT); }
__device__ __forceinline__ unsigned xb_add(unsigned* p, unsigned v) { return __hip_atomic_fetch_add(p, v, __ATOMIC_RELAXED, __HIP_MEMORY_SCOPE_AGENT); }
__device__ __forceinline__ unsigned xb_xcc_id() { return (unsigned)__builtin_amdgcn_s_getreg((3 << 11) | 20) & 0xFu; }
#define XB_SPIN(cond, bar) do { unsigned _sp = 0; while (cond) { __builtin_amdgcn_s_sleep(1); \
    if ((++_sp & 255u) == 0u) { if (xb_ld(&(bar)[XB_TMO])) break; if (_sp > XB_SPIN_CAP) { atomicAdd(&(bar)[XB_TMO], 1u); break; } } } } while (0)
struct XcdBarrier { unsigned* bar; unsigned x; volatile LAS unsigned* st; };
__device__ __forceinline__ XcdBarrier xcd_barrier_post(unsigned* bar, volatile LAS unsigned* st) {
    XcdBarrier b; b.bar = bar; b.x = xb_xcc_id(); b.st = st;
    if (threadIdx.x == 0) (void)xb_add(&bar[XB_XCNT(b.x)], 1u);
    return b;
}
__device__ __forceinline__ void xcd_barrier_complete(unsigned* bar, unsigned x, unsigned& nloc, unsigned& nx) {
    const unsigned G = gridDim.x * gridDim.y * gridDim.z;
    unsigned sum, cnt, mine, sp = 0u;
    for (;;) {
        sum = 0u; cnt = 0u; mine = 0u;
#pragma unroll
        for (unsigned j = 0; j < 16; ++j) { const unsigned c = xb_ld(&bar[XB_XCNT(j)]); sum += c; cnt += (c > 0u) ? 1u : 0u; mine = (j == x) ? c : mine; }
        if (sum == G) break;
        __builtin_amdgcn_s_sleep(1);
        if ((++sp & 255u) == 0u) { if (xb_ld(&bar[XB_TMO])) break; if (sp > XB_SPIN_CAP) { atomicAdd(&bar[XB_TMO], 1u); break; } }
    }
    nloc = mine > 0u ? mine : 1u; nx = cnt > 0u ? cnt : 1u;
}
__device__ __forceinline__ void xcd_barrier(const XcdBarrier& b) {
    asm volatile("s_waitcnt vmcnt(0)" ::: "memory");
    __syncthreads();
    if (threadIdx.x == 0) {
        unsigned* bar = b.bar;
        __builtin_amdgcn_s_waitcnt(0);
        unsigned nloc = b.st[0], nx = b.st[1];
        if (nloc == 0u) { xcd_barrier_complete(bar, b.x, nloc, nx); b.st[0] = nloc; b.st[1] = nx; }
        const unsigned old = xb_add(&bar[XB_XSUB(b.x)], 1u);
        const unsigned gen = old / nloc;
        if (old + 1u == (gen + 1u) * nloc) {
            __builtin_amdgcn_fence(__ATOMIC_RELEASE, "agent");
            asm volatile("s_waitcnt vmcnt(0)" ::: "memory");
            const unsigned og = xb_add(&bar[XB_TOP], 1u);
            const unsigned tg = og / nx;
            if (og + 1u == (tg + 1u) * nx) xb_add(&bar[XB_TOPGEN], 1u);
            else XB_SPIN(xb_ld(&bar[XB_TOPGEN]) == tg, bar);
            __builtin_amdgcn_fence(__ATOMIC_ACQUIRE, "agent");
            xb_add(&bar[XB_XGEN(b.x)], 1u);
            asm volatile("s_waitcnt vmcnt(0)" ::: "memory");
        } else {
            XB_SPIN(xb_ld(&bar[XB_XGEN(b.x)]) == gen, bar);
            __builtin_amdgcn_fence(__ATOMIC_ACQUIRE, "agent");
            asm volatile("s_waitcnt vmcnt(0)" ::: "memory");
        }
    }
    __syncthreads();
}
namespace pg8 {
#define PG8_LAS __attribute__((address_space(3)))
typedef unsigned short bf16_t;
typedef short bf16x8 __attribute__((ext_vector_type(8)));
typedef float f32x4 __attribute__((ext_vector_type(4)));
typedef unsigned u32x4 __attribute__((ext_vector_type(4)));
constexpr int BM = 256, BK = 64, HALF = 128, HTB = HALF * BK * 2  , STAGE_BYTES = 8 * HTB, NXCD = 8, WGM = 8;

__host__ __device__ __forceinline__ int lds_byte(int r, int c) { const int st = (r >> 4) * 2 + (c >> 5), rr = r & 15, cc = c & 31, ob = rr * 64 + cc * 2; return st * 1024 + (ob ^ (((ob >> 9) & 1) << 5)); }
__host__ __device__ __forceinline__ void stage_rc(int b, int& R, int& C) { const int st = b / 1024, sb = b % 1024, swz = sb ^ (((sb >> 9) & 1) << 5); R = (st >> 1) * 16 + swz / 64; C = (st & 1) * 32 + (swz % 64) / 2; }
__host__ __device__ __forceinline__ int perm32(int rho) { const int n = rho >> 4, i = rho & 15; return 8 * (i >> 2) + 4 * n + (i & 3); }

struct Unit { int pm, pn; };
struct Gemm { const bf16_t* A; const bf16_t* Bt; int M, N, K; };

struct StaticOrder {
    int nM, nN, nwg, G, c;
    __host__ __device__ void init(int M, int N, int G_, int c_) { nM = M / BM; nN = N / BM; nwg = nM * nN; G = G_; c = c_; }
    __host__ __device__ bool next(int i, Unit& u) const {
        const long L = (long)i * G + c; if (L >= nwg) return false;
        int wgid = (int)L; { const int q = nwg / NXCD, r = nwg % NXCD, xcd = wgid % NXCD, off = wgid / NXCD; wgid = (xcd < r ? xcd * (q + 1) : r * (q + 1) + (xcd - r) * q) + off; }
        const int nig = WGM * nN, gid = wgid / nig, fm = gid * WGM, gsz = (nM - fm) < WGM ? (nM - fm) : WGM;
        u.pm = fm + ((wgid % nig) % gsz); u.pn = (wgid % nig) / gsz; return true;
    }
    __device__ __forceinline__ void a_ready(const Unit&) const {}
    __device__ __forceinline__ void done(const Unit&) const {}
};

__device__ __forceinline__ unsigned cvt_pk_bf16(float lo, float hi) { return ::pk2(lo, hi); }
typedef float f32x2 __attribute__((ext_vector_type(2)));
struct RowOrder {
    int nM, nN, nwg, G, c, skip;
    __device__ __forceinline__ void init(int nN_, int G_, int c_, int skip_) { skip = skip_; nM = skip_ ? 64 : 66; nN = nN_; nwg = nM * nN; G = G_; c = c_; }
    __device__ __forceinline__ bool next(int i, Unit& u) const {
        const long L = (long)i * G + c; if (L >= nwg) return false;
        int wgid = (int)L; { const int q = nwg / NXCD, r = nwg % NXCD, xcd = wgid % NXCD, off = wgid / NXCD; wgid = (xcd < r ? xcd * (q + 1) : r * (q + 1) + (xcd - r) * q) + off; }
        const int nig = WGM * nN, gid = wgid / nig, fm = gid * WGM, gsz = (nM - fm) < WGM ? (nM - fm) : WGM;
        int pm = fm + ((wgid % nig) % gsz); u.pn = (wgid % nig) / gsz;
        if (skip) pm = pm + 1 + (pm >= 32 ? 1 : 0);
        u.pm = pm; return true;
    }
    __device__ __forceinline__ void a_ready(const Unit&) const {}
    __device__ __forceinline__ void done(const Unit&) const {}
};
struct EpiProj {
    static constexpr bool PERM = true, AFTER_DRAIN = false;
    bf16_t* P; float* AB;
    __device__ __forceinline__ void operator()(const f32x4 (&acc)[2][2][4][2], const Unit& u, int wr, int wc, int fr, int fq) const {
        const int row0 = u.pm * BM + wr * 64 + fr;
        if (u.pn < 22) {
            const int col0 = u.pn * BM + wc * 32 + 8 * fq;
#pragma unroll
            for (int ai = 0; ai < 2; ++ai)
#pragma unroll
                for (int m = 0; m < 4; ++m) { bf16_t* rowp = P + (size_t)(row0 + ai * HALF + m * 16) * 5632 + col0;
#pragma unroll
                    for (int bj = 0; bj < 2; ++bj) { const f32x4 v0 = acc[ai][bj][m][0], v1 = acc[ai][bj][m][1];
                        u32x4 w; w.x = cvt_pk_bf16(v0[0], v0[1]); w.y = cvt_pk_bf16(v0[2], v0[3]); w.z = cvt_pk_bf16(v1[0], v1[1]); w.w = cvt_pk_bf16(v1[2], v1[3]);
                        *(u32x4*)(rowp + bj * HALF) = w; } }
        } else if (wc == 0 && fq < 2) {
#pragma unroll
            for (int ai = 0; ai < 2; ++ai)
#pragma unroll
                for (int m = 0; m < 4; ++m) { float* rp = AB + (size_t)(row0 + ai * HALF + m * 16) * 16 + 8 * fq;
                    *(f32x4*)rp = acc[ai][0][m][0]; *(f32x4*)(rp + 4) = acc[ai][0][m][1]; }
        }
    }
};
struct EpiResid {
    static constexpr bool PERM = false, AFTER_DRAIN = false;
    float* X; const float* gate; float alpha; const float* stats; const float* lnw; const float* lnb; int ln;
    __device__ __forceinline__ void operator()(const f32x4 (&acc)[2][2][4][2], const Unit& u, int wr, int wc, int fr, int fq) const {
        const int s = (u.pm % 33 == 0) ? 2 : u.pm / 33; const float* g = gate + (size_t)s * 12288;
        const int row0 = u.pm * BM + wr * 64 + fr, col0 = u.pn * BM + wc * 32 + 4 * fq;
        f32x2 st[2][4];
#pragma unroll
        for (int ai = 0; ai < 2; ++ai)
#pragma unroll
            for (int m = 0; m < 4; ++m) st[ai][m] = ln ? *(const f32x2*)(stats + (size_t)(row0 + ai * HALF + m * 16) * 2) : (f32x2){0.f, 1.f};
#pragma unroll
        for (int bj = 0; bj < 2; ++bj)
#pragma unroll
            for (int n = 0; n < 2; ++n) { const int cc = col0 + bj * HALF + n * 16; const f32x4 gv = *(const f32x4*)(g + cc);
                const f32x4 w4 = ln ? *(const f32x4*)(lnw + cc) : (f32x4){1.f, 1.f, 1.f, 1.f}, b4 = ln ? *(const f32x4*)(lnb + cc) : (f32x4){0.f, 0.f, 0.f, 0.f};
#pragma unroll
                for (int ai = 0; ai < 2; ++ai) { f32x4 xr[4];
#pragma unroll
                    for (int m = 0; m < 4; ++m) xr[m] = *(const f32x4*)(X + (size_t)(row0 + ai * HALF + m * 16) * 2048 + cc);
                    asm volatile("" ::: "memory");
#pragma unroll
                    for (int m = 0; m < 4; ++m) { const f32x4 xl = (xr[m] - st[ai][m].x) * st[ai][m].y * w4 + b4;
                        *(f32x4*)(X + (size_t)(row0 + ai * HALF + m * 16) * 2048 + cc) = xl * alpha + gv * acc[ai][bj][m][n]; }
                    asm volatile("" ::: "memory"); } }
    }
};
__device__ __forceinline__ float silu_mul(float g, float u) { return g * u * __builtin_amdgcn_rcpf(1.f + __expf(-g)); }
struct EpiSwiglu {
    static constexpr bool PERM = true, AFTER_DRAIN = false;
    bf16_t* G;
    __device__ __forceinline__ void operator()(const f32x4 (&acc)[2][2][4][2], const Unit& u, int wr, int wc, int fr, int fq) const {
        const int row0 = u.pm * BM + wr * 64 + fr, col0 = u.pn * HALF + wc * 32 + 8 * fq;
#pragma unroll
        for (int ai = 0; ai < 2; ++ai)
#pragma unroll
            for (int m = 0; m < 4; ++m) { bf16_t* rowp = G + (size_t)(row0 + ai * HALF + m * 16) * 5632 + col0;
                const f32x4 g0 = acc[ai][0][m][0], g1 = acc[ai][0][m][1], u0 = acc[ai][1][m][0], u1 = acc[ai][1][m][1];
                u32x4 w; w.x = cvt_pk_bf16(silu_mul(g0[0], u0[0]), silu_mul(g0[1], u0[1])); w.y = cvt_pk_bf16(silu_mul(g0[2], u0[2]), silu_mul(g0[3], u0[3]));
                w.z = cvt_pk_bf16(silu_mul(g1[0], u1[0]), silu_mul(g1[1], u1[1])); w.w = cvt_pk_bf16(silu_mul(g1[2], u1[2]), silu_mul(g1[3], u1[3]));
                *(u32x4*)rowp = w; }
    }
};
template <class Epi, class Sched, bool ALIGN_EPI = false, bool SP2 = false>
__device__ __forceinline__ void gemm_phase(PG8_LAS unsigned char* lds, const Gemm g, const Sched& S, const Epi& E) {
    const int tid = opaque_tid(), wid = __builtin_amdgcn_readfirstlane(tid >> 6), lane = tid & 63, wr = wid >> 2, wc = wid & 3, fr = lane & 15, fq = lane >> 4;
    const int K = g.K, nt = K / BK;
    unsigned voffA[2], voffB[2];
#pragma unroll
    for (int i = 0; i < 2; ++i) { int R, C; stage_rc(tid * 16 + i * 8192, R, C); const int Rb = Epi::PERM ? ((R & ~31) + perm32(R & 31)) : R;
        voffA[i] = (unsigned)(R * K + C) * 2u; voffB[i] = (unsigned)(Rb * K + C) * 2u; }
    const size_t kstep = (size_t)(BK * 2);
    const size_t hstep = (size_t)HALF * K * 2;
    const size_t tstep = 2 * hstep;
    const unsigned ldsw = (unsigned)wid * 1024u;
    const int aoff = lds_byte(wr * 64 + fr, fq * 8), boff = lds_byte(wc * 32 + fr, fq * 8);
#define PG8_SA(b, h) (((b) * 2 + (h)) * HTB)
#define PG8_SB(b, h) ((4 + (b) * 2 + (h)) * HTB)
#define PG8_STAGE(bufoff, gbase, voff) do { _Pragma("unroll") for (int _i = 0; _i < 2; ++_i) \
        __builtin_amdgcn_global_load_lds((const unsigned*)((const char*)(gbase) + (voff)[_i]), (PG8_LAS unsigned*)(lds + (bufoff) + ldsw + _i * 8192), 16, 0, 0); } while (0)
#define PG8_LDA(dst, b, h) do { _Pragma("unroll") for (int m = 0; m < 4; ++m) _Pragma("unroll") for (int k = 0; k < 2; ++k) dst[m][k] = *(const PG8_LAS bf16x8*)(lds + PG8_SA(b, h) + aoff + m * 2048 + k * 1024); } while (0)
#define PG8_LDB(dst, b, h) do { _Pragma("unroll") for (int n = 0; n < 2; ++n) _Pragma("unroll") for (int k = 0; k < 2; ++k) dst[n][k] = *(const PG8_LAS bf16x8*)(lds + PG8_SB(b, h) + boff + n * 2048 + k * 1024); } while (0)
#define PG8_MMA(ai, bj, At, Bt) do { __builtin_amdgcn_s_setprio(1); _Pragma("unroll") for (int m = 0; m < 4; ++m) _Pragma("unroll") for (int n = 0; n < 2; ++n) _Pragma("unroll") for (int k = 0; k < 2; ++k) \
        acc[ai][bj][m][n] = __builtin_amdgcn_mfma_f32_16x16x32_bf16(Bt[n][k], At[m][k], acc[ai][bj][m][n], 0, 0, 0); __builtin_amdgcn_s_setprio(0); } while (0)
#define PG8_WAIT_V(n) asm volatile("s_waitcnt vmcnt(" #n ")" ::: "memory")
#define PG8_WAIT_L(n) asm volatile("s_waitcnt lgkmcnt(" #n ")" ::: "memory")
#define PG8_BAR __builtin_amdgcn_s_barrier()
#define PG8_SCHED __builtin_amdgcn_sched_barrier(0)
    Unit cur, nxt; int ui = 0;
    if (!S.next(0, cur)) return;
    f32x4 acc[2][2][4][2];
#pragma unroll
    for (int a = 0; a < 2; ++a)
#pragma unroll
        for (int b = 0; b < 2; ++b)
#pragma unroll
            for (int m = 0; m < 4; ++m)
#pragma unroll
                for (int n = 0; n < 2; ++n) acc[a][b][m][n] = (f32x4){0.f, 0.f, 0.f, 0.f};
    bf16x8 At[4][2], B0[2][2], B1[2][2];
    const char* cA = (const char*)g.A + (size_t)cur.pm * tstep; const char* cB = (const char*)g.Bt + (size_t)cur.pn * tstep;
    S.a_ready(cur);
    if constexpr (SP2) {
        PG8_STAGE(PG8_SB(0, 0), cB, voffB); PG8_STAGE(PG8_SB(0, 1), cB + hstep, voffB); PG8_STAGE(PG8_SA(0, 0), cA, voffA); PG8_STAGE(PG8_SA(0, 1), cA + hstep, voffA);
        if (wr == 1) PG8_BAR;
        PG8_WAIT_V(2); PG8_BAR;
        PG8_STAGE(PG8_SB(1, 0), cB + kstep, voffB); PG8_STAGE(PG8_SA(1, 0), cA + kstep, voffA); PG8_STAGE(PG8_SB(1, 1), cB + hstep + kstep, voffB);
        PG8_WAIT_V(6); PG8_BAR;
    } else {
        PG8_STAGE(PG8_SB(0, 0), cB, voffB); PG8_STAGE(PG8_SA(0, 0), cA, voffA); PG8_STAGE(PG8_SB(0, 1), cB + hstep, voffB); PG8_STAGE(PG8_SA(0, 1), cA + hstep, voffA);
        if (wr == 1) PG8_BAR;
        PG8_WAIT_V(4); PG8_BAR;
        PG8_STAGE(PG8_SB(1, 0), cB + kstep, voffB); PG8_STAGE(PG8_SA(1, 0), cA + kstep, voffA); PG8_STAGE(PG8_SB(1, 1), cB + hstep + kstep, voffB);
        PG8_WAIT_V(6); PG8_BAR;
    }
    for (;;) {
        const bool has_next = S.next(ui + 1, nxt);
        const char* nA = has_next ? (const char*)g.A + (size_t)nxt.pm * tstep : cA; const char* nB = has_next ? (const char*)g.Bt + (size_t)nxt.pn * tstep : cB;
        for (int t = 0; t < nt; t += 2) {
            const bool last = (t == nt - 2);
            const char* a1 = cA + (size_t)(t + 1) * kstep;
            const char* a2 = last ? nA : cA + (size_t)(t + 2) * kstep; const char* b2 = last ? nB : cB + (size_t)(t + 2) * kstep;
            const char* a3 = a2 + kstep; const char* b3 = b2 + kstep;
            if (last && has_next) S.a_ready(nxt);
            if constexpr (SP2) {
            PG8_LDB(B0, 0, 0); PG8_LDB(B1, 0, 1); PG8_SCHED; PG8_LDA(At, 0, 0); PG8_STAGE(PG8_SA(1, 1), a1 + hstep, voffA);
            PG8_WAIT_V(8); PG8_WAIT_L(0); PG8_BAR; PG8_MMA(0, 0, At, B0); PG8_MMA(0, 1, At, B1); PG8_BAR; PG8_SCHED;
            PG8_LDA(At, 0, 1); PG8_STAGE(PG8_SB(0, 0), b2, voffB); PG8_STAGE(PG8_SB(0, 1), b2 + hstep, voffB); PG8_STAGE(PG8_SA(0, 0), a2, voffA);
            PG8_WAIT_V(8); PG8_WAIT_L(0); PG8_BAR; PG8_MMA(1, 0, At, B0); PG8_MMA(1, 1, At, B1); PG8_BAR; PG8_SCHED;
            PG8_LDB(B0, 1, 0); PG8_LDB(B1, 1, 1); PG8_SCHED; PG8_LDA(At, 1, 0); PG8_STAGE(PG8_SA(0, 1), a2 + hstep, voffA);
            PG8_WAIT_V(8); PG8_WAIT_L(0); PG8_BAR; PG8_MMA(0, 0, At, B0); PG8_MMA(0, 1, At, B1); PG8_BAR; PG8_SCHED;
            PG8_LDA(At, 1, 1); PG8_STAGE(PG8_SB(1, 0), b3, voffB); PG8_STAGE(PG8_SB(1, 1), b3 + hstep, voffB); PG8_STAGE(PG8_SA(1, 0), a3, voffA);
            PG8_WAIT_V(8); PG8_WAIT_L(0); PG8_BAR; PG8_MMA(1, 0, At, B0); PG8_MMA(1, 1, At, B1); PG8_BAR; PG8_SCHED;
            } else {
            PG8_LDB(B0, 0, 0); PG8_SCHED; PG8_LDA(At, 0, 0); PG8_STAGE(PG8_SA(1, 1), a1 + hstep, voffA);
            PG8_WAIT_L(8); PG8_BAR; PG8_WAIT_L(0); PG8_MMA(0, 0, At, B0); PG8_BAR; PG8_SCHED;
            PG8_LDB(B1, 0, 1); PG8_STAGE(PG8_SB(0, 0), b2, voffB);
            PG8_BAR; PG8_WAIT_L(0); PG8_MMA(0, 1, At, B1); PG8_BAR;
            PG8_LDA(At, 0, 1); PG8_STAGE(PG8_SA(0, 0), a2, voffA);
            PG8_BAR; PG8_WAIT_L(0); PG8_MMA(1, 0, At, B0); PG8_BAR; PG8_SCHED;
            PG8_STAGE(PG8_SB(0, 1), b2 + hstep, voffB);
            PG8_WAIT_V(6); PG8_BAR; PG8_MMA(1, 1, At, B1); PG8_BAR;
            PG8_LDB(B0, 1, 0); PG8_SCHED; PG8_LDA(At, 1, 0); PG8_STAGE(PG8_SA(0, 1), a2 + hstep, voffA);
            PG8_WAIT_L(8); PG8_BAR; PG8_WAIT_L(0); PG8_MMA(0, 0, At, B0); PG8_BAR; PG8_SCHED;
            PG8_LDB(B1, 1, 1); PG8_STAGE(PG8_SB(1, 0), b3, voffB);
            PG8_BAR; PG8_WAIT_L(0); PG8_MMA(0, 1, At, B1); PG8_BAR;
            PG8_LDA(At, 1, 1); PG8_STAGE(PG8_SA(1, 0), a3, voffA);
            PG8_BAR; PG8_WAIT_L(0); PG8_MMA(1, 0, At, B0); PG8_BAR; PG8_SCHED;
            PG8_STAGE(PG8_SB(1, 1), b3 + hstep, voffB);
            PG8_WAIT_V(6); PG8_BAR; PG8_MMA(1, 1, At, B1); PG8_BAR;
            }
        }
        if constexpr (ALIGN_EPI) { if (wr == 0) PG8_BAR; }
        if constexpr (!Epi::AFTER_DRAIN) { E(acc, cur, wr, wc, fr, fq); S.done(cur); }
        if (!has_next) break;
#pragma unroll
        for (int a = 0; a < 2; ++a)
#pragma unroll
            for (int b = 0; b < 2; ++b)
#pragma unroll
                for (int m = 0; m < 4; ++m)
#pragma unroll
                    for (int n = 0; n < 2; ++n) acc[a][b][m][n] = (f32x4){0.f, 0.f, 0.f, 0.f};
        cur = nxt; cA = nA; cB = nB; ++ui;
        if constexpr (ALIGN_EPI) { if (wr == 1) PG8_BAR; }
    }
    PG8_WAIT_V(0);
    if constexpr (!ALIGN_EPI) { if (wr == 0) PG8_BAR; }
    PG8_BAR;
    if constexpr (Epi::AFTER_DRAIN) { E.fused(acc, cur, wr, wc, fr, fq, lds, wid, lane); S.done(cur); }
#undef PG8_SA
#undef PG8_SB
#undef PG8_STAGE
#undef PG8_LDA
#undef PG8_LDB
#undef PG8_MMA
#undef PG8_WAIT_V
#undef PG8_WAIT_L
#undef PG8_BAR
#undef PG8_SCHED
}
}
namespace att {
using bf16 = __hip_bfloat16;
constexpr int D = 128, NW = 8, QBLK = 32, KVBLK = 64;
constexpr float SCALE = 0.088388347648318440f;
constexpr float THR = 8.f;
constexpr int SDEPTH = 2;
constexpr int LDQ = PW, LDK = PW, LDO = YW;
constexpr size_t SHM_V = KVBLK * D * 2, SHM_K = KVBLK * D * 2, SHM_ATTN = 3 * SHM_V + 3 * SHM_K + NW * 64 * 4;
using bf16x8 = __attribute__((ext_vector_type(8))) short;
using s16x4  = __attribute__((ext_vector_type(4))) short;
using f32x16 = __attribute__((ext_vector_type(16))) float;
using f32x8  = __attribute__((ext_vector_type(8))) float;
using u32x4  = __attribute__((ext_vector_type(4))) unsigned;
#define KSWZ(row, colB) ((row) * 256 + ((colB) ^ (((row) & 7) << 4)))
#define SBAR() __builtin_amdgcn_sched_barrier(0)
__device__ __forceinline__ int crow(int r, int hi) { return (r & 3) + 8 * (r >> 2) + 4 * hi; }
__device__ __forceinline__ unsigned cvtpk(float lo, float hi) {
  unsigned r; asm volatile("v_cvt_pk_bf16_f32 %0, %1, %2" : "=v"(r) : "v"(lo), "v"(hi)); return r;
}
template <typename TIn> struct Stage;
template <> struct Stage<bf16>  { using T = bf16x8;
  __device__ static __forceinline__ T ld8(const bf16* p) { return *reinterpret_cast<const bf16x8*>(p); }
  __device__ static __forceinline__ bf16x8 tobf(T x) { return x; } };
template <> struct Stage<float> { using T = f32x8;
  __device__ static __forceinline__ T ld8(const float* p) { return *reinterpret_cast<const f32x8*>(p); }
  __device__ static __forceinline__ bf16x8 tobf(T x) {
    u32x4 w = {cvtpk(x[0], x[1]), cvtpk(x[2], x[3]), cvtpk(x[4], x[5]), cvtpk(x[6], x[7])}; return *reinterpret_cast<bf16x8*>(&w); } };

template <bool FIXM = false> __device__ __forceinline__ void smax(const f32x16& p0, const f32x16& p1, float& m_reg, float& mn, float& alpha) {
  if constexpr (FIXM) { mn = m_reg; alpha = 1.f; return; }
  float pmax = p0[0]; for (int r = 1; r < 16; ++r) pmax = fmaxf(pmax, p0[r]); for (int r = 0; r < 16; ++r) pmax = fmaxf(pmax, p1[r]);
  { auto rr = __builtin_amdgcn_permlane32_swap(__float_as_uint(pmax), __float_as_uint(pmax), false, false);
    pmax = fmaxf(__uint_as_float(rr[0]), __uint_as_float(rr[1])); }
  if (__builtin_expect(__all(pmax - m_reg <= THR * 1.4426950408889634f), 1)) { mn = m_reg; alpha = 1.f; }
  else { mn = fmaxf(m_reg, pmax); alpha = __builtin_amdgcn_exp2f(m_reg - mn); m_reg = mn; }
}
template <bool FIXM = false> __device__ __forceinline__ void sexp(f32x16& p0, f32x16& p1, float mn) {
  if constexpr (!FIXM) { for (int r = 0; r < 16; ++r) p0[r] -= mn; for (int r = 0; r < 16; ++r) p1[r] -= mn; }
  for (int r = 0; r < 16; ++r) p0[r] = __builtin_amdgcn_exp2f(p0[r]);
  asm volatile("" : "+v"(p0), "+v"(p1));
}
template <bool FIXM = false> __device__ __forceinline__ void partialSM(f32x16& p0, f32x16& p1, float& m_reg, float& mn, float& alpha) { smax<FIXM>(p0, p1, m_reg, mn, alpha); sexp<FIXM>(p0, p1, mn); }
__device__ __forceinline__ void finishSM(f32x16& p0, f32x16& p1, float alpha, float& l_reg, bf16x8& pa0, bf16x8& pa1, bf16x8& pa2, bf16x8& pa3) {
  for (int r = 0; r < 16; ++r) p1[r] = __builtin_amdgcn_exp2f(p1[r]);
  float ps = 0; for (int r = 0; r < 16; ++r) ps += p0[r]; for (int r = 0; r < 16; ++r) ps += p1[r];
  { auto rr = __builtin_amdgcn_permlane32_swap(__float_as_uint(ps), __float_as_uint(ps), false, false);
    ps = __uint_as_float(rr[0]) + __uint_as_float(rr[1]); }
  l_reg = l_reg * alpha + ps;
#define PK4(P, BASE, OUT) do { unsigned a0 = cvtpk(P[BASE + 0], P[BASE + 1]), a1 = cvtpk(P[BASE + 2], P[BASE + 3]);   \
    unsigned b0 = cvtpk(P[BASE + 4], P[BASE + 5]), b1 = cvtpk(P[BASE + 6], P[BASE + 7]);                              \
    auto r0 = __builtin_amdgcn_permlane32_swap(a0, b0, false, false); auto r1 = __builtin_amdgcn_permlane32_swap(a1, b1, false, false); \
    u32x4 w = {r0[0], r1[0], r0[1], r1[1]}; OUT = *reinterpret_cast<bf16x8*>(&w); } while (0)
  PK4(p0, 0, pa0); PK4(p0, 8, pa1); PK4(p1, 0, pa2); PK4(p1, 8, pa3);
#undef PK4
}
template <int OFF> __device__ __forceinline__ bf16x8 k_rd(int addr) { bf16x8 r; asm volatile("ds_read_b128 %0, %1 offset:%2" : "=&v"(r) : "v"(addr), "i"(OFF) : "memory"); return r; }
#define K_WAIT(N, X, Y) asm volatile("s_waitcnt lgkmcnt(" #N ")" : "+v"(X), "+v"(Y) :: "memory")
__device__ __forceinline__ void qkt(f32x16& p0, f32x16& p1, int kb, const bf16x8* qr, const int (&ka)[4]) {
  p0 = f32x16{}; p1 = f32x16{};
  const int a0 = kb + ka[0], a1 = kb + ka[1], a2 = kb + ka[2], a3 = kb + ka[3];
  bf16x8 x0 = k_rd<0>(a0), y0 = k_rd<8192>(a0), x1 = k_rd<0>(a1), y1 = k_rd<8192>(a1);
#define K_STEP(D0, X, Y, N, NEXT) do { K_WAIT(N, X, Y); p0 = __builtin_amdgcn_mfma_f32_32x32x16_bf16(X, qr[D0], p0, 0, 0, 0); p1 = __builtin_amdgcn_mfma_f32_32x32x16_bf16(Y, qr[D0], p1, 0, 0, 0); NEXT; } while (0)
  K_STEP(0, x0, y0, 2, (x0 = k_rd<0>(a2), y0 = k_rd<8192>(a2)));
  K_STEP(1, x1, y1, 2, (x1 = k_rd<0>(a3), y1 = k_rd<8192>(a3)));
  K_STEP(2, x0, y0, 2, (x0 = k_rd<128>(a0), y0 = k_rd<8320>(a0)));
  K_STEP(3, x1, y1, 2, (x1 = k_rd<128>(a1), y1 = k_rd<8320>(a1)));
  K_STEP(4, x0, y0, 2, (x0 = k_rd<128>(a2), y0 = k_rd<8320>(a2)));
  K_STEP(5, x1, y1, 2, (x1 = k_rd<128>(a3), y1 = k_rd<8320>(a3)));
  K_STEP(6, x0, y0, 2, (void)0);
  K_STEP(7, x1, y1, 0, (void)0);
#undef K_STEP
}
#undef K_WAIT
__device__ __forceinline__ int v_st(int k, int c) { const int kk = (k & ~0xC) | ((k & 4) << 1) | ((k & 8) >> 1); return ((kk >> 3) * 4 + (c >> 5)) * 512 + ((kk & 7) * 32 + (c & 31)) * 2; }
__device__ __forceinline__ int v_rd_base(int lane) { return ((lane & 3) << 3) | (((lane >> 2) & 3) << 6) | (((lane >> 4) & 1) << 5) | (((lane >> 5) & 1) << 8); }
constexpr int v_rd_off(int d0, int ks, int half) { return d0 * 512 + ks * 4096 + half * 2048; }
template <int OFF> __device__ __forceinline__ s16x4 tr_read(int vb) {
  s16x4 r; asm volatile("ds_read_b64_tr_b16 %0, %1 offset:%2" : "=&v"(r) : "v"(vb), "i"(OFF) : "memory"); return r;
}
#define PK(L, H) (bf16x8){L[0], L[1], L[2], L[3], H[0], H[1], H[2], H[3]}
template <int D0> __device__ __forceinline__ void pv_two(f32x16& oa, f32x16& ob, int vb, bf16x8 pa0, bf16x8 pa1, bf16x8 pa2, bf16x8 pa3) {
  const s16x4 l0 = tr_read<v_rd_off(D0, 0, 0)>(vb), h0 = tr_read<v_rd_off(D0, 0, 1)>(vb), l1 = tr_read<v_rd_off(D0, 1, 0)>(vb), h1 = tr_read<v_rd_off(D0, 1, 1)>(vb);
  const s16x4 l2 = tr_read<v_rd_off(D0, 2, 0)>(vb), h2 = tr_read<v_rd_off(D0, 2, 1)>(vb), l3 = tr_read<v_rd_off(D0, 3, 0)>(vb), h3 = tr_read<v_rd_off(D0, 3, 1)>(vb);
  const s16x4 m0 = tr_read<v_rd_off(D0 + 1, 0, 0)>(vb), g0 = tr_read<v_rd_off(D0 + 1, 0, 1)>(vb), m1 = tr_read<v_rd_off(D0 + 1, 1, 0)>(vb), g1 = tr_read<v_rd_off(D0 + 1, 1, 1)>(vb);
  const s16x4 m2 = tr_read<v_rd_off(D0 + 1, 2, 0)>(vb), g2 = tr_read<v_rd_off(D0 + 1, 2, 1)>(vb), m3 = tr_read<v_rd_off(D0 + 1, 3, 0)>(vb), g3 = tr_read<v_rd_off(D0 + 1, 3, 1)>(vb);
  asm volatile("s_waitcnt lgkmcnt(0)" ::: "memory"); SBAR();
  oa = __builtin_amdgcn_mfma_f32_32x32x16_bf16(pa0, PK(l0, h0), oa, 0, 0, 0);
  ob = __builtin_amdgcn_mfma_f32_32x32x16_bf16(pa0, PK(m0, g0), ob, 0, 0, 0);
  oa = __builtin_amdgcn_mfma_f32_32x32x16_bf16(pa1, PK(l1, h1), oa, 0, 0, 0);
  ob = __builtin_amdgcn_mfma_f32_32x32x16_bf16(pa1, PK(m1, g1), ob, 0, 0, 0);
  oa = __builtin_amdgcn_mfma_f32_32x32x16_bf16(pa2, PK(l2, h2), oa, 0, 0, 0);
  ob = __builtin_amdgcn_mfma_f32_32x32x16_bf16(pa2, PK(m2, g2), ob, 0, 0, 0);
  oa = __builtin_amdgcn_mfma_f32_32x32x16_bf16(pa3, PK(l3, h3), oa, 0, 0, 0);
  ob = __builtin_amdgcn_mfma_f32_32x32x16_bf16(pa3, PK(m3, g3), ob, 0, 0, 0);
}
#undef PK
__device__ __forceinline__ void pv_d0(f32x16* o, int vb, bf16x8 pa0, bf16x8 pa1, bf16x8 pa2, bf16x8 pa3) {
  pv_two<0>(o[0], o[1], vb, pa0, pa1, pa2, pa3); pv_two<2>(o[2], o[3], vb, pa0, pa1, pa2, pa3);
}

template <typename TQ, int LDO_T, bool FIXM>
__device__ __forceinline__ void attn_dense_body(const TQ* __restrict__ Qb, const bf16* __restrict__ Kh, const bf16* __restrict__ Vh,
                                                unsigned short* __restrict__ Ob, float* __restrict__ stat, int seq, char* lds, float mfix) {
  using St = Stage<bf16>; using SQ = Stage<TQ>;
  const int tid = opaque_tid(), wid = tid >> 6, lane = tid & 63, r32 = lane & 31, hi = lane >> 5;
  bf16* V_lds = (bf16*)lds; bf16* K_lds = (bf16*)(lds + 3 * SHM_V);
  float* ws = (float*)(lds + 3 * SHM_V + 3 * SHM_K) + wid * 64; float* li_l = ws; float* al_l = ws + 32;
  float m_reg = FIXM ? mfix : -1e30f, l_reg = 0; f32x16 o[4] = {}; bf16x8 qr[8];
  const TQ* Qw = Qb + (long)(wid * QBLK + r32) * LDQ + hi * 8;
#pragma unroll
  for (int d0 = 0; d0 < 8; ++d0) qr[d0] = SQ::tobf(SQ::ld8(Qw + d0 * 16));
  const int sr = tid >> 4, sc = (tid & 15) * 8, vst0 = v_st(sr, sc), vst1 = v_st(32 + sr, sc);
  const int vb0 = (int)(uintptr_t)V_lds + v_rd_base(lane);
  const int kb0 = (int)(uintptr_t)K_lds; const int ka[4] = {KSWZ(r32, (0 * 16 + hi * 8) * 2), KSWZ(r32, (1 * 16 + hi * 8) * 2), KSWZ(r32, (2 * 16 + hi * 8) * 2), KSWZ(r32, (3 * 16 + hi * 8) * 2)};
  struct { typename St::T vs0, vs1, ks0, ks1; } sr_[SDEPTH];
#define SLOAD(i, k0) do { sr_[i].vs0 = St::ld8(&Vh[(long)((k0) + sr) * LDK + sc]); sr_[i].vs1 = St::ld8(&Vh[(long)((k0) + 32 + sr) * LDK + sc]); \
    sr_[i].ks0 = St::ld8(&Kh[(long)((k0) + sr) * LDK + sc]); sr_[i].ks1 = St::ld8(&Kh[(long)((k0) + 32 + sr) * LDK + sc]); } while (0)
#define SWRITE(b, i) do { *(bf16x8*)((char*)V_lds + (b) * (int)SHM_V + vst0) = St::tobf(sr_[i].vs0);          \
    *(bf16x8*)((char*)V_lds + (b) * (int)SHM_V + vst1) = St::tobf(sr_[i].vs1); int kc = sc * 2;               \
    *(bf16x8*)((char*)K_lds + (b) * (int)SHM_K + KSWZ(sr, kc)) = St::tobf(sr_[i].ks0);                       \
    *(bf16x8*)((char*)K_lds + (b) * (int)SHM_K + KSWZ(32 + sr, kc)) = St::tobf(sr_[i].ks1); } while (0)
#define SWAIT() do { if constexpr (SDEPTH == 2) asm volatile("s_waitcnt vmcnt(4)" ::: "memory"); else asm volatile("s_waitcnt vmcnt(0)" ::: "memory"); } while (0)
#define RESC(a) do { if constexpr (!FIXM) if (__any((a) < 1.f)) { if (hi == 0) al_l[r32] = (a); asm volatile("s_waitcnt lgkmcnt(0)" ::: "memory"); \
    for (int d = 0; d < 4; ++d) for (int r = 0; r < 16; ++r) o[d][r] *= al_l[crow(r, hi)]; } } while (0)
#define KBUF(b) ((bf16*)((char*)K_lds + (b) * (int)SHM_K))
  f32x16 pA0, pA1, pB0, pB1; float mnA, mnB, alA, alB; bf16x8 pa0, pa1, pa2, pa3; const int NT = seq / KVBLK;
  constexpr int SE = 0, SO = SDEPTH - 1;
  SLOAD(SE, 0); asm volatile("s_waitcnt vmcnt(0)" ::: "memory"); SWRITE(0, SE); __syncthreads();
  qkt(pA0, pA1, kb0, qr, ka); partialSM<FIXM>(pA0, pA1, m_reg, mnA, alA);
  SLOAD(SO, KVBLK); if constexpr (SDEPTH == 2) { if (2 < NT) SLOAD(SE, 2 * KVBLK); }
  SWAIT(); SWRITE(1, SO); __syncthreads();
  int iV = 0, iK = 1, iW = 2;
  for (int j = 1; j + 1 < NT; j += 2) {
    SBAR(); qkt(pB0, pB1, kb0 + iK * (int)SHM_K, qr, ka);
    finishSM(pA0, pA1, alA, l_reg, pa0, pa1, pa2, pa3); SBAR();
    SLOAD(SO, (j + SDEPTH) * KVBLK); SBAR();
    pv_two<0>(o[0], o[1], vb0 + iV * (int)SHM_V, pa0, pa1, pa2, pa3); smax<FIXM>(pB0, pB1, m_reg, mnB, alB);
    pv_two<2>(o[2], o[3], vb0 + iV * (int)SHM_V, pa0, pa1, pa2, pa3); sexp<FIXM>(pB0, pB1, mnB);
    SWAIT(); SWRITE(iW, SE);
    RESC(alB); __syncthreads();
    { const int t_ = iV; iV = iK; iK = iW; iW = t_; }
    SBAR(); qkt(pA0, pA1, kb0 + iK * (int)SHM_K, qr, ka);
    finishSM(pB0, pB1, alB, l_reg, pa0, pa1, pa2, pa3); SBAR();
    if (SDEPTH == 1 || j + 3 < NT) SLOAD(SE, (j + 1 + SDEPTH) * KVBLK); SBAR();
    pv_two<0>(o[0], o[1], vb0 + iV * (int)SHM_V, pa0, pa1, pa2, pa3); smax<FIXM>(pA0, pA1, m_reg, mnA, alA);
    pv_two<2>(o[2], o[3], vb0 + iV * (int)SHM_V, pa0, pa1, pa2, pa3); sexp<FIXM>(pA0, pA1, mnA);
    SWAIT(); SWRITE(iW, SO);
    RESC(alA); __syncthreads();
    { const int t_ = iV; iV = iK; iK = iW; iW = t_; }
  }
  SBAR(); qkt(pB0, pB1, kb0 + iK * (int)SHM_K, qr, ka);
  finishSM(pA0, pA1, alA, l_reg, pa0, pa1, pa2, pa3); SBAR();
  pv_d0(o, vb0 + iV * (int)SHM_V, pa0, pa1, pa2, pa3); partialSM<FIXM>(pB0, pB1, m_reg, mnB, alB);
  RESC(alB);
  finishSM(pB0, pB1, alB, l_reg, pa0, pa1, pa2, pa3); SBAR();
  pv_d0(o, vb0 + iK * (int)SHM_V, pa0, pa1, pa2, pa3);
#undef KBUF
  if (hi == 0) li_l[r32] = l_reg; asm volatile("s_waitcnt lgkmcnt(0)" ::: "memory");
  float rli[16];
#pragma unroll
  for (int r = 0; r < 16; ++r) rli[r] = __builtin_amdgcn_rcpf(li_l[crow(r, hi)]);
  if (stat != nullptr && hi == 0) { stat[(wid * QBLK + r32) * 16] = m_reg; stat[(wid * QBLK + r32) * 16 + 1] = l_reg; }
  unsigned short* Ow = Ob + (long)(wid * QBLK) * LDO_T;
#pragma unroll
  for (int r = 0; r < 16; ++r) { int orow = crow(r, hi);
    for (int d0 = 0; d0 < 4; ++d0) Ow[(long)orow * LDO_T + d0 * 32 + r32] = (unsigned short)f2bf(o[d0][r] * rli[r]); }
#undef SLOAD
#undef SWRITE
#undef SWAIT
#undef RESC
}
}
struct Frame {
    LAS unsigned char* lds; unsigned char* ldsg;
    volatile LAS unsigned* MISC;
    unsigned* ctl; unsigned char* ws;
    int tid, lane, wave, G, vcu;
};
__device__ __forceinline__ const float* inp(const Frame& F, int k) {
    const unsigned lo = __builtin_amdgcn_readfirstlane(F.MISC[16 + 2 * k]), hi = __builtin_amdgcn_readfirstlane(F.MISC[17 + 2 * k]);
    return (const float*)(const GAS float*)(((unsigned long long)hi << 32) | (unsigned long long)lo);
}
enum { I_x = 0, I_c, I_ctx, I_c_ctx, I_w_ada, I_b_ada, I_w_in, I_ret_decay, I_dn_conv_w, I_dn_a_log, I_dn_dt_bias, I_dn_norm_w, I_att_qn_w, I_att_kn_w, I_w_o, I_ln1_w, I_ln1_b, I_w_ffi, I_w_ffo, I_ln2_w, I_ln2_b, I_out };

struct TrItem { const float* src; bf16_t* dst; int ldw, K, ncols; };
__device__ __forceinline__ TrItem tr_decode(const Frame& F, int it) {
    constexpr int I_IN = 32 * 177, I_O = 32 * 64, I_FI = 32 * 352, I_FO = 88 * 64, I_L = I_IN + I_O + I_FI + I_FO;
    bf16_t* Win_t = (bf16_t*)(F.ws + WS_WIN); bf16_t* Wo_t = (bf16_t*)(F.ws + WS_WO); bf16_t* Wfi_t = (bf16_t*)(F.ws + WS_WFI); bf16_t* Wfo_t = (bf16_t*)(F.ws + WS_WFO);
    const int l = it / I_L; int r = it - l * I_L; TrItem t;
    if (r < I_IN) { const int kb = r / 177, nb = r - kb * 177; int dst = 32 * nb, src = 32 * nb, nc = 32;
        if (nb >= 128) src += 16; if (nb == 176) { dst = 5632; src = 4096; nc = 16; }
        t.src = inp(F, I_w_in) + (size_t)l * DM * PROJ_SRC + (size_t)(64 * kb) * PROJ_SRC + src; t.ldw = PROJ_SRC; t.K = DM; t.ncols = nc; t.dst = Win_t + (size_t)l * PWPAD * DM + (size_t)dst * DM + 64 * kb; return t; }
    r -= I_IN;
    if (r < I_O) { const int kb = r >> 6, nb = r & 63;
        t.src = inp(F, I_w_o) + (size_t)l * DM * DM + (size_t)(64 * kb) * DM + 32 * nb; t.ldw = DM; t.K = DM; t.ncols = 32; t.dst = Wo_t + (size_t)l * DM * DM + (size_t)(32 * nb) * DM + 64 * kb; return t; }
    r -= I_O;
    if (r < I_FI) { const int kb = r / 352, nb = r - kb * 352, pn = nb >> 3, q = nb & 7; const int src = q < 4 ? 128 * pn + 32 * q : DFF + 128 * pn + 32 * (q - 4);
        t.src = inp(F, I_w_ffi) + (size_t)l * DM * 2 * DFF + (size_t)(64 * kb) * 2 * DFF + src; t.ldw = 2 * DFF; t.K = DM; t.ncols = 32; t.dst = Wfi_t + (size_t)l * 2 * DFF * DM + (size_t)(32 * nb) * DM + 64 * kb; return t; }
    r -= I_FI;
    { const int kb = r >> 6, nb = r & 63;
        t.src = inp(F, I_w_ffo) + (size_t)l * DFF * DM + (size_t)(64 * kb) * DM + 32 * nb; t.ldw = DM; t.K = DFF; t.ncols = 32; t.dst = Wfo_t + (size_t)l * DM * DFF + (size_t)(32 * nb) * DFF + 64 * kb; return t; }
}
#define TR_LOAD(v, t) do { const int kr_ = lane >> 3, c4_ = (lane & 7) * 4; const bool ok_ = c4_ < (t).ncols; \
        _Pragma("unroll") for (int i_ = 0; i_ < 8; ++i_) v[i_] = ok_ ? *(const f32x4*)((t).src + (size_t)(8 * i_ + kr_) * (t).ldw + c4_) : (f32x4){0.f, 0.f, 0.f, 0.f}; } while (0)
#define TR_PROC(v, t) do { const int kr_ = lane >> 3, c4_ = (lane & 7) * 4; \
        _Pragma("unroll") for (int i_ = 0; i_ < 8; ++i_) { LAS float* s_ = scr + (8 * i_ + kr_) * 33 + c4_; s_[0] = v[i_][0]; s_[1] = v[i_][1]; s_[2] = v[i_][2]; s_[3] = v[i_][3]; } \
        LDS_WAIT(); const int c8_ = lane & 7; \
        _Pragma("unroll") for (int j_ = 0; j_ < 4; ++j_) { const int n_ = (lane >> 3) + 8 * j_; const LAS float* s_ = scr + (8 * c8_) * 33 + n_; \
            u32x4 o_; o_.x = pk2(s_[0 * 33], s_[1 * 33]); o_.y = pk2(s_[2 * 33], s_[3 * 33]); o_.z = pk2(s_[4 * 33], s_[5 * 33]); o_.w = pk2(s_[6 * 33], s_[7 * 33]); \
            if (n_ < (t).ncols) *(u32x4*)((t).dst + (size_t)n_ * (t).K + 8 * c8_) = o_; } \
        LDS_WAIT(); } while (0)
__device__ __forceinline__ void prologue_phase(Frame& F) {
    LAS float* scr = (LAS float*)(F.lds + F.wave * 8448);
    const int gw = F.vcu * NWAVES + F.wave, NGW = F.G * NWAVES, lane = F.lane;
    bf16_t* Win_t = (bf16_t*)(F.ws + WS_WIN);
    constexpr int NIT = DEPTH * (32 * 177 + 32 * 64 + 32 * 352 + 88 * 64);
    { f32x4 va[8], vb[8]; TrItem ta, tb;
      int it = gw; if (it < NIT) { ta = tr_decode(F, it); TR_LOAD(va, ta); }
      while (it < NIT) {
          int in = it + NGW; if (in < NIT) { tb = tr_decode(F, in); TR_LOAD(vb, tb); }
          TR_PROC(va, ta); it = in; if (it >= NIT) break;
          in = it + NGW; if (in < NIT) { ta = tr_decode(F, in); TR_LOAD(va, ta); }
          TR_PROC(vb, tb); it = in;
      } }
    { constexpr int PER_L = (PWPAD - PROJ_SRC) * DM / 8;
      for (int i = (F.vcu * NWAVES * 64) + F.tid; i < DEPTH * PER_L; i += F.G * NWAVES * 64) { const int l = i / PER_L, j = i - l * PER_L;
          *(u32x4*)(Win_t + (size_t)l * PWPAD * DM + (size_t)PROJ_SRC * DM + (size_t)j * 8) = (u32x4){0u, 0u, 0u, 0u}; } }
    LAS float* cond = (LAS float*)(F.lds + 73728);
    LAS float* red = (LAS float*)(F.lds + 98304);
    __syncthreads();
    for (int i = F.tid; i < 3 * DM; i += NWAVES * 64) { const int s = i / DM, k = i - s * DM; const float v = s < 2 ? inp(F, I_c)[s * DM + k] : inp(F, I_c_ctx)[k]; cond[i] = v / (1.f + expf(-v)); }
    __syncthreads();
    float* MOD = (float*)(F.ws + WS_MOD);
    for (int item = F.vcu; item < DEPTH * 96; item += F.G) {
        const int l = item / 96, cb = item - l * 96;
        const float* W = inp(F, I_w_ada) + (size_t)l * DM * 12288 + cb * 128 + 2 * lane;
        float a00 = 0.f, a01 = 0.f, a10 = 0.f, a11 = 0.f, a20 = 0.f, a21 = 0.f;
        const int kbeg = F.wave * 256;
#pragma unroll 16
        for (int k = kbeg; k < kbeg + 256; ++k) { const f32x2 w = *(const f32x2*)(W + (size_t)k * 12288); const float c0 = cond[k], c1 = cond[DM + k], c2 = cond[2 * DM + k];
            a00 += c0 * w.x; a01 += c0 * w.y; a10 += c1 * w.x; a11 += c1 * w.y; a20 += c2 * w.x; a21 += c2 * w.y; }
        red[(F.wave * 3 + 0) * 128 + 2 * lane] = a00; red[(F.wave * 3 + 0) * 128 + 2 * lane + 1] = a01;
        red[(F.wave * 3 + 1) * 128 + 2 * lane] = a10; red[(F.wave * 3 + 1) * 128 + 2 * lane + 1] = a11;
        red[(F.wave * 3 + 2) * 128 + 2 * lane] = a20; red[(F.wave * 3 + 2) * 128 + 2 * lane + 1] = a21;
        __syncthreads();
        if (F.tid < 384) { const int s = F.tid >> 7, cc = F.tid & 127; float sum = inp(F, I_b_ada)[l * 12288 + cb * 128 + cc];
#pragma unroll
            for (int w = 0; w < 8; ++w) sum += red[(w * 3 + s) * 128 + cc];
            MOD[(size_t)(l * 3 + s) * 12288 + cb * 128 + cc] = sum; }
        __syncthreads();
    }
}

template <int MODE> __device__ __forceinline__ void ln_mod_phase(Frame& F, int l, bool skip_ctx) {
    float* X = (float*)(F.ws + WS_X); bf16_t* H = (bf16_t*)(F.ws + WS_H); const float* MOD = (const float*)(F.ws + WS_MOD); float* LNS = (float*)(F.ws + WS_LNS);
    const int gw = F.vcu * NWAVES + F.wave, NGW = F.G * NWAVES, lane = F.lane;
    const int lm = MODE == 0 ? 0 : (MODE == 1 ? l : l + 1), ish = MODE == 1 ? 3 : 0, isc = MODE == 1 ? 4 : 1;
    f32x4 lw[8], lb[8];
    if (MODE != 0) { const float* pw = (MODE == 1 ? inp(F, I_ln1_w) : inp(F, I_ln2_w)) + l * DM; const float* pb = (MODE == 1 ? inp(F, I_ln1_b) : inp(F, I_ln2_b)) + l * DM;
#pragma unroll
        for (int j = 0; j < 8; ++j) { lw[j] = *(const f32x4*)(pw + 4 * lane + 256 * j); lb[j] = *(const f32x4*)(pb + 4 * lane + 256 * j); } }
    const float* xin = MODE == 0 ? inp(F, I_x) : nullptr; const float* cin = MODE == 0 ? inp(F, I_ctx) : nullptr; float* outp = MODE == 3 ? (float*)inp(F, I_out) : nullptr;
#define LN_ROW(seg, i) ((seg) == 0 ? ((i) >> 8) * TOK + ((i) & 255) : ((seg) - 1) * TOK + CTXL + (i))
#define LN_SRC(seg, i) (MODE == 0 ? ((seg) == 0 ? cin + (size_t)(i) * DM : xin + (size_t)(((seg) - 1) * SEQ + (i)) * DM) : X + (size_t)LN_ROW(seg, i) * DM)
#define LN_LOAD(v, seg, i) do { const float* s_ = LN_SRC(seg, i); _Pragma("unroll") for (int j = 0; j < 8; ++j) v[j] = *(const f32x4*)(s_ + 4 * lane + 256 * j); } while (0)
#define LN_PROC(v, seg, i) do { \
        if (MODE != 0) { float sm = 0.f; \
            _Pragma("unroll") for (int j = 0; j < 8; ++j) sm += (v[j][0] + v[j][1]) + (v[j][2] + v[j][3]); \
            const float mean = wave_sum(sm) * (1.f / DM); float sq = 0.f; \
            _Pragma("unroll") for (int j = 0; j < 8; ++j) { v[j] = v[j] - mean; sq += (v[j][0] * v[j][0] + v[j][1] * v[j][1]) + (v[j][2] * v[j][2] + v[j][3] * v[j][3]); } \
            const float rstd = rsqrtf(wave_sum(sq) * (1.f / DM) + EPS); \
            if (MODE != 3 && lane == 0) *(f32x2*)(LNS + (size_t)LN_ROW(seg, i) * 2) = (f32x2){mean, rstd};     \
            _Pragma("unroll") for (int j = 0; j < 8; ++j) v[j] = v[j] * rstd * lw[j] + lb[j]; } \
        if (MODE == 3) { float* o_ = outp + (size_t)(((seg) - 1) * SEQ + (i)) * DM; \
            _Pragma("unroll") for (int j = 0; j < 8; ++j) __builtin_nontemporal_store(v[j], (f32x4*)(o_ + 4 * lane + 256 * j)); } \
        else { const size_t r_ = (size_t)LN_ROW(seg, i); \
            _Pragma("unroll") for (int j = 0; j < 8; ++j) { if (MODE == 0) *(f32x4*)(X + r_ * DM + 4 * lane + 256 * j) = v[j]; const f32x4 hh = v[j] * (sc[j] + 1.f) + sh[j]; \
                u32x2 w_; w_.x = pk2(hh[0], hh[1]); w_.y = pk2(hh[2], hh[3]); *(u32x2*)(H + r_ * DM + 4 * lane + 256 * j) = w_; } } } while (0)
    for (int seg = ((skip_ctx || MODE == 3) ? 1 : 0); seg < 3; ++seg) {
        const int n = seg == 0 ? NBATCH * CTXL : SEQ, s = seg == 0 ? 2 : seg - 1;
        f32x4 sh[8], sc[8];
        if (MODE != 3) { const float* msh = MOD + (size_t)(lm * 3 + s) * 12288 + ish * DM; const float* msc = MOD + (size_t)(lm * 3 + s) * 12288 + isc * DM;
#pragma unroll
            for (int j = 0; j < 8; ++j) { sh[j] = *(const f32x4*)(msh + 4 * lane + 256 * j); sc[j] = *(const f32x4*)(msc + 4 * lane + 256 * j); } }
        f32x4 va[8], vb[8];
        int i = gw; if (i < n) LN_LOAD(va, seg, i);
        while (i < n) {
            int in = i + NGW; if (in < n) LN_LOAD(vb, seg, in);
            LN_PROC(va, seg, i); i = in; if (i >= n) break;
            in = i + NGW; if (in < n) LN_LOAD(va, seg, in);
            LN_PROC(vb, seg, i); i = in;
        }
    }
#undef LN_ROW
#undef LN_SRC
#undef LN_LOAD
#undef LN_PROC
}

__device__ __forceinline__ void ctx_gemm_resid(Frame& F, const bf16_t* A, const bf16_t* Bt, int K, float* X, const float* gate_ctx, float alpha, const float* stats, const float* lnw, const float* lnb, int ln) {
    LAS unsigned char* L = F.lds; const int tid = F.tid, lane = F.lane, wave = F.wave, rr = lane & 15, kg = lane >> 4;
    const int srow = tid >> 3, sc = tid & 7;
    for (int tile = F.vcu; tile < 256; tile += F.G) {
        const int rt = tile >> 5, ct = tile & 31; const size_t row0 = (size_t)(rt >> 2) * TOK + (rt & 3) * 64; const int col0 = ct * 64;
        const bf16_t* ap = A + (row0 + srow) * K + sc * 8; const bf16_t* bp = Bt + (size_t)(col0 + srow) * K + sc * 8;
        f32x4 acc[2]; acc[0] = (f32x4){0.f, 0.f, 0.f, 0.f}; acc[1] = acc[0];
        u32x4 ra0, ra1, ra2, ra3, ra4, ra5, ra6, ra7, rb0, rb1, rb2, rb3, rb4, rb5, rb6, rb7; const int nk = K / 64;
#define CG_LD(i, RA, RB) do { RA = *(const u32x4*)(ap + (i) * 64); RB = *(const u32x4*)(bp + (i) * 64); } while (0)
        CG_LD(0, ra0, rb0); CG_LD(1, ra1, rb1); CG_LD(2, ra2, rb2); CG_LD(3, ra3, rb3); CG_LD(4, ra4, rb4); CG_LD(5, ra5, rb5); CG_LD(6, ra6, rb6); CG_LD(7, ra7, rb7);
#define CG_STEP(kt, RA, RB) do { LAS unsigned char* As_ = L + ((kt) & 1) * 18432; LAS unsigned char* Bs_ = As_ + 9216; \
            *(LAS u32x4*)(As_ + srow * 144 + sc * 16) = RA; *(LAS u32x4*)(Bs_ + srow * 144 + sc * 16) = RB; \
            __syncthreads(); \
            if ((kt) + 8 < nk) CG_LD((kt) + 8, RA, RB); \
            _Pragma("unroll") for (int ks = 0; ks < 2; ++ks) { const bf16x8 af = ldsfrag(As_ + (16 * (wave & 3) + rr) * 144 + (32 * ks + 8 * kg) * 2); \
                _Pragma("unroll") for (int j = 0; j < 2; ++j) acc[j] = mfma16(ldsfrag(Bs_ + (32 * (wave >> 2) + 16 * j + rr) * 144 + (32 * ks + 8 * kg) * 2), af, acc[j]); } } while (0)
        for (int kt = 0; kt < nk; kt += 8) { CG_STEP(kt, ra0, rb0); CG_STEP(kt + 1, ra1, rb1); CG_STEP(kt + 2, ra2, rb2); CG_STEP(kt + 3, ra3, rb3); CG_STEP(kt + 4, ra4, rb4); CG_STEP(kt + 5, ra5, rb5); CG_STEP(kt + 6, ra6, rb6); CG_STEP(kt + 7, ra7, rb7); }
#undef CG_STEP
#undef CG_LD
        const size_t row = row0 + 16 * (wave & 3) + rr;
#pragma unroll
        for (int j = 0; j < 2; ++j) { const int col = col0 + 32 * (wave >> 2) + 16 * j + 4 * kg; float* xp = X + row * DM + col;
            const f32x4 g = *(const f32x4*)(gate_ctx + col); f32x4 x = *(const f32x4*)xp;
            if (ln) { const f32x2 st = *(const f32x2*)(stats + row * 2); x = (x - st.x) * st.y * *(const f32x4*)(lnw + col) + *(const f32x4*)(lnb + col); }
            x = x * alpha + g * acc[j]; *(f32x4*)xp = x; }
        __syncthreads();
    }
}

__device__ __forceinline__ void rowprep_phase(Frame& F, int l) {
    bf16_t* P = (bf16_t*)(F.ws + WS_P); float* AB = (float*)(F.ws + WS_AB); bf16_t* DQ = (bf16_t*)(F.ws + WS_DQ);
    const int lane = F.lane, gw = F.vcu * NWAVES + F.wave, NGW = F.G * NWAVES;
    LAS float* csl = (LAS float*)(F.lds + F.wave * 512);
    const float* cw = inp(F, I_dn_conv_w) + (size_t)l * 5 * 1536;
    const float inv = powf(10000.f, -(float)(lane & 31) * (1.f / 32.f));
    const float nega = lane < 8 ? -expf(inp(F, I_dn_a_log)[l * 8 + lane]) : 0.f, dtb = lane < 8 ? inp(F, I_dn_dt_bias)[l * 8 + lane] : 0.f;
    const int hs = lane >> 3, c8 = (lane & 7) * 8;
    f32x4 qn1a, qn1b, qn2a, qn2b, kn1a, kn1b, kn2a, kn2b;
    { const float* qn = inp(F, I_att_qn_w) + l * 128; const float* kn = inp(F, I_att_kn_w) + l * 128;
      qn1a = *(const f32x4*)(qn + c8); qn1b = *(const f32x4*)(qn + c8 + 4); qn2a = *(const f32x4*)(qn + 64 + c8); qn2b = *(const f32x4*)(qn + 64 + c8 + 4);
      kn1a = *(const f32x4*)(kn + c8); kn1b = *(const f32x4*)(kn + c8 + 4); kn2a = *(const f32x4*)(kn + 64 + c8); kn2b = *(const f32x4*)(kn + 64 + c8 + 4); }
#define RP_UNPACK(V_, lo, hi) do { lo = (f32x4){bflo(V_.x), bfhi(V_.x), bflo(V_.y), bfhi(V_.y)}; hi = (f32x4){bflo(V_.z), bfhi(V_.z), bflo(V_.w), bfhi(V_.w)}; } while (0)
#define RP_PACK(lo, hi) (u32x4){pk2(lo[0], lo[1]), pk2(lo[2], lo[3]), pk2(hi[0], hi[1]), pk2(hi[2], hi[3])}
#define RP_GLOAD(base, act, r1_, r2_) do { const bf16_t* p1_ = p + (base) + hs * 128 + c8; r1_ = (u32x4){0u, 0u, 0u, 0u}; r2_ = r1_; if (act) { r1_ = *(const u32x4*)p1_; r2_ = *(const u32x4*)(p1_ + 64); } } while (0)
#define RP_GROUP(base, NORM, w1a, w1b, w2a, w2b, scl, act, r1_, r2_) do { bf16_t* p1_ = p + (base) + hs * 128 + c8; \
        f32x4 x1a, x1b, x2a, x2b; RP_UNPACK(r1_, x1a, x1b); RP_UNPACK(r2_, x2a, x2b); \
        if (NORM) { f32x4 q_ = x1a * x1a + x1b * x1b + x2a * x2a + x2b * x2b; float ss_ = (q_[0] + q_[1]) + (q_[2] + q_[3]); ss_ += __shfl_xor(ss_, 1); ss_ += __shfl_xor(ss_, 2); ss_ += __shfl_xor(ss_, 4); \
            const float ri_ = rsqrtf(ss_ * (1.f / 128.f) + EPS); x1a = x1a * ri_ * w1a; x1b = x1b * ri_ * w1b; x2a = x2a * ri_ * w2a; x2b = x2b * ri_ * w2b; } \
        const f32x4 y1a = (x1a * ca - x2a * sa) * (scl), y1b = (x1b * cb - x2b * sb) * (scl), y2a = (x1a * sa + x2a * ca) * (scl), y2b = (x1b * sb + x2b * cb) * (scl); \
        if (act) { *(u32x4*)p1_ = RP_PACK(y1a, y1b); *(u32x4*)(p1_ + 64) = RP_PACK(y2a, y2b); } } while (0)
    for (int r = gw; r < MROWS; r += NGW) {
        const int b = r / TOK, tp = r - b * TOK; const bool is_ctx = tp < CTXL;
        { float cs = 1.f, sn = 0.f;
          if (!is_ctx) { const int t = tp - CTXL; const float pos = (lane < 32) ? (float)(t >> 6) : (float)(t & 63); sn = __sinf(pos * inv); cs = __cosf(pos * inv); }
          csl[lane] = cs; csl[64 + lane] = sn; LDS_WAIT(); }
        const f32x4 ca = *(const LAS f32x4*)(csl + c8), cb = *(const LAS f32x4*)(csl + c8 + 4), sa = *(const LAS f32x4*)(csl + 64 + c8), sb = *(const LAS f32x4*)(csl + 64 + c8 + 4);
        bf16_t* p = P + (size_t)r * PW;
        u32x4 gq1, gq2, gk1, gk2, gr1, gr2, cv[3][5]; float abv = 0.f, bbv = 0.f;
        RP_GLOAD(C_AQ, true, gq1, gq2); RP_GLOAD(C_AK, (hs < 2), gk1, gk2); RP_GLOAD(C_RQ, true, gr1, gr2);
#pragma unroll
        for (int j = 0; j < 3; ++j)
#pragma unroll
            for (int k = 0; k < 5; ++k) { const int rr = tp + k - 2; const bool valid = is_ctx ? (rr >= 0 && rr < CTXL) : (rr >= CTXL && rr < TOK);
                cv[j][k] = (u32x4){0u, 0u, 0u, 0u}; if (valid) cv[j][k] = *(const u32x4*)(P + (size_t)(r + k - 2) * PW + C_DQKV + 8 * (lane + 64 * j)); }
        if (lane < 8) { abv = AB[(size_t)r * 16 + lane]; bbv = AB[(size_t)r * 16 + 8 + lane]; }
        asm volatile("" ::: "memory");
        RP_GROUP(C_AQ, true, qn1a, qn1b, qn2a, qn2b, (0.088388347648318440f * 1.4426950408889634f), true, gq1, gq2);
        RP_GROUP(C_AK, true, kn1a, kn1b, kn2a, kn2b, 1.f, (hs < 2), gk1, gk2);
        RP_GROUP(C_RQ, false, qn1a, qn1b, qn2a, qn2b, (hs < 4 ? 1.f : 0.088388347648318440f), true, gr1, gr2);
        LDS_WAIT();
#pragma unroll
        for (int j = 0; j < 3; ++j) {
            const int c0 = 8 * (lane + 64 * j); float a[8];
#pragma unroll
            for (int e = 0; e < 8; ++e) a[e] = 0.f;
#pragma unroll
            for (int k = 0; k < 5; ++k) { const int rr = tp + k - 2; const bool valid = is_ctx ? (rr >= 0 && rr < CTXL) : (rr >= CTXL && rr < TOK);
                if (valid) { const u32x4 xv = cv[j][k]; const f32x4 w0 = *(const f32x4*)(cw + k * 1536 + c0), w1 = *(const f32x4*)(cw + k * 1536 + c0 + 4);
                    a[0] += w0[0] * bflo(xv.x); a[1] += w0[1] * bfhi(xv.x); a[2] += w0[2] * bflo(xv.y); a[3] += w0[3] * bfhi(xv.y);
                    a[4] += w1[0] * bflo(xv.z); a[5] += w1[1] * bfhi(xv.z); a[6] += w1[2] * bflo(xv.w); a[7] += w1[3] * bfhi(xv.w); } }
            float ss = 0.f;
#pragma unroll
            for (int e = 0; e < 8; ++e) { a[e] = silu_f(a[e]); ss += a[e] * a[e]; }
            if (j < 2) { const float sc = rsqrtf(sum16(ss) + EPS) * (j == 0 ? 0.088388347648318440f : 1.f);
#pragma unroll
                for (int e = 0; e < 8; ++e) a[e] *= sc; }
            u32x4 o; o.x = pk2(a[0], a[1]); o.y = pk2(a[2], a[3]); o.z = pk2(a[4], a[5]); o.w = pk2(a[6], a[7]);
            *(u32x4*)(DQ + (size_t)r * 1536 + c0) = o;
        }
        if (lane < 8) { const float av = abv, bv = bbv; const float xx = av + dtb; const float sp = xx > 20.f ? xx : log1pf(expf(xx));
            AB[(size_t)r * 16 + lane] = nega * sp; AB[(size_t)r * 16 + 8 + lane] = 1.f / (1.f + expf(-bv)); }
    }
#undef RP_UNPACK
#undef RP_PACK
#undef RP_GROUP
#undef RP_GLOAD
}

constexpr int DP_QS = 0, DP_KS = 17408, DP_KT = 36864, DP_VT = 55296, DP_AS = 73728, DP_GC = 108544;
__device__ __forceinline__ void dnprep_unit(Frame& F, int unit) {
    const bf16_t* DQ = (const bf16_t*)(F.ws + WS_DQ); const float* GB = (const float*)(F.ws + WS_AB);
    bf16_t* DNW = (bf16_t*)(F.ws + WS_DNW); bf16_t* DNKC = (bf16_t*)(F.ws + WS_DNKC); bf16_t* DNQG = (bf16_t*)(F.ws + WS_DNQG); bf16_t* DNKGT = (bf16_t*)(F.ws + WS_DNKGT); bf16_t* DNQK = (bf16_t*)(F.ws + WS_DNQK); float* DNGL = (float*)(F.ws + WS_DNGL);
    LAS unsigned char* L = F.lds; LAS float* gcs = (LAS float*)(L + DP_GC); LAS float* bes = gcs + 128; LAS float* AS = (LAS float*)(L + DP_AS);
    const int tid = opaque_tid(), lane = tid & 63, wave = __builtin_amdgcn_readfirstlane(tid >> 6), rr = lane & 15, kg = lane >> 4;
    const int h = unit & 3, cg = (unit >> 2) % DN_NCH, b = (unit >> 2) / DN_NCH, rbase = b * TOK + 64 * cg;
    const size_t pu0 = (size_t)((b * DN_NCH + cg) * 4 + h) * 2;
    if (wave < 2) { const int dir = wave, tok = dir ? 63 - lane : lane; const size_t row = rbase + tok;
        float s = GB[row * 16 + dir * 4 + h]; const float be = GB[row * 16 + 8 + dir * 4 + h];
#pragma unroll
        for (int o = 1; o < 64; o <<= 1) { const float t = __shfl_up(s, o); if (lane >= o) s += t; }
        gcs[dir * 64 + lane] = s; bes[dir * 64 + lane] = be; }
    { const int row = tid >> 3, seg = tid & 7; const bf16_t* src = DQ + (size_t)(rbase + row) * 1536 + h * 128 + seg * 16;
      const u32x4 q0 = *(const u32x4*)src, q1 = *(const u32x4*)(src + 8), k0 = *(const u32x4*)(src + 512), k1 = *(const u32x4*)(src + 520), v0 = *(const u32x4*)(src + 1024), v1 = *(const u32x4*)(src + 1032);
      *(LAS u32x4*)(L + DP_QS + row * 272 + seg * 32) = q0; *(LAS u32x4*)(L + DP_QS + row * 272 + seg * 32 + 16) = q1;
      *(LAS u32x4*)(L + DP_KS + row * 272 + seg * 32) = k0; *(LAS u32x4*)(L + DP_KS + row * 272 + seg * 32 + 16) = k1;
      const unsigned kw[8] = {k0.x, k0.y, k0.z, k0.w, k1.x, k1.y, k1.z, k1.w}, vw[8] = {v0.x, v0.y, v0.z, v0.w, v1.x, v1.y, v1.z, v1.w};
#pragma unroll
      for (int e = 0; e < 8; ++e) { const int d = seg * 16 + 2 * e;
          *(LAS bf16_t*)(L + DP_KT + (d * 72 + row) * 2) = (bf16_t)(kw[e] & 0xffffu); *(LAS bf16_t*)(L + DP_KT + ((d + 1) * 72 + row) * 2) = (bf16_t)(kw[e] >> 16);
          *(LAS bf16_t*)(L + DP_VT + (d * 72 + row) * 2) = (bf16_t)(vw[e] & 0xffffu); *(LAS bf16_t*)(L + DP_VT + ((d + 1) * 72 + row) * 2) = (bf16_t)(vw[e] >> 16); } }
    __syncthreads();
#pragma unroll
    for (int jj = 0; jj < 2; ++jj) {
        const int it = wave >> 1, jt = 2 * (wave & 1) + jj; f32x4 kk = {0.f, 0.f, 0.f, 0.f}, qk = {0.f, 0.f, 0.f, 0.f};
#pragma unroll
        for (int ks = 0; ks < 4; ++ks) { const bf16x8 aK = ldsfrag(L + DP_KS + (16 * jt + rr) * 272 + (32 * ks + 8 * kg) * 2), bK = ldsfrag(L + DP_KS + (16 * it + rr) * 272 + (32 * ks + 8 * kg) * 2), bQ = ldsfrag(L + DP_QS + (16 * it + rr) * 272 + (32 * ks + 8 * kg) * 2);
            kk = mfma16(aK, bK, kk); qk = mfma16(aK, bQ, qk); }
        const int i = 16 * it + rr, jb = 16 * jt + 4 * kg;
        { const float gi = gcs[i], bi = bes[i]; float av[4], qv[4];
#pragma unroll
          for (int r = 0; r < 4; ++r) { const int j = jb + r; const float e = (j <= i) ? __expf(gi - gcs[j]) : 0.f; av[r] = (j < i) ? bi * kk[r] * e : 0.f; qv[r] = qk[r] * e; }
          *(LAS f32x4*)(AS + i * 68 + jb) = (f32x4){av[0], av[1], av[2], av[3]};
          u32x2 w; w.x = pk2(qv[0], qv[1]); w.y = pk2(qv[2], qv[3]); *(u32x2*)(DNQK + (pu0 + 0) * 4096 + i * 64 + jb) = w; }
        { const int i1 = 63 - i; const float gi = gcs[64 + i1], bi = bes[64 + i1]; float av[4], qv[4];
#pragma unroll
          for (int r = 0; r < 4; ++r) { const int j1 = 63 - (jb + r); const float e = (j1 <= i1) ? __expf(gi - gcs[64 + j1]) : 0.f; av[r] = (j1 < i1) ? bi * kk[r] * e : 0.f; qv[r] = qk[r] * e; }
          const int jl = 60 - jb;
          *(LAS f32x4*)(AS + 64 * 68 + i1 * 68 + jl) = (f32x4){av[3], av[2], av[1], av[0]};
          u32x2 w; w.x = pk2(qv[3], qv[2]); w.y = pk2(qv[1], qv[0]); *(u32x2*)(DNQK + (pu0 + 1) * 4096 + i1 * 64 + jl) = w; }
    }
    { const int row = tid >> 3, seg = tid & 7;
#pragma unroll
      for (int dir = 0; dir < 2; ++dir) { const int tok = dir ? 63 - row : row; const float e = __expf(gcs[dir * 64 + row]);
          const u32x4 a0 = *(const LAS u32x4*)(L + DP_QS + tok * 272 + seg * 32), a1 = *(const LAS u32x4*)(L + DP_QS + tok * 272 + seg * 32 + 16);
          u32x4 o0, o1; o0.x = pk2(bflo(a0.x) * e, bfhi(a0.x) * e); o0.y = pk2(bflo(a0.y) * e, bfhi(a0.y) * e); o0.z = pk2(bflo(a0.z) * e, bfhi(a0.z) * e); o0.w = pk2(bflo(a0.w) * e, bfhi(a0.w) * e);
          o1.x = pk2(bflo(a1.x) * e, bfhi(a1.x) * e); o1.y = pk2(bflo(a1.y) * e, bfhi(a1.y) * e); o1.z = pk2(bflo(a1.z) * e, bfhi(a1.z) * e); o1.w = pk2(bflo(a1.w) * e, bfhi(a1.w) * e);
          bf16_t* dst = DNQG + (pu0 + dir) * 8192 + row * 128 + seg * 16; *(u32x4*)dst = o0; *(u32x4*)(dst + 8) = o1; } }
    { const int d = tid >> 2, sg = tid & 3;
#pragma unroll
      for (int dir = 0; dir < 2; ++dir) { const float gl = gcs[dir * 64 + 63]; unsigned ow[8];
#pragma unroll
          for (int e = 0; e < 8; ++e) { const int i0 = 16 * sg + 2 * e, i1 = i0 + 1; const int t0 = dir ? 63 - i0 : i0, t1 = dir ? 63 - i1 : i1;
              const float v0 = bf2f(*(const LAS bf16_t*)(L + DP_KT + (d * 72 + t0) * 2)) * __expf(gl - gcs[dir * 64 + i0]), v1 = bf2f(*(const LAS bf16_t*)(L + DP_KT + (d * 72 + t1) * 2)) * __expf(gl - gcs[dir * 64 + i1]);
              ow[e] = pk2(v0, v1); }
          bf16_t* dst = DNKGT + (pu0 + dir) * 8192 + d * 64 + 16 * sg; *(u32x4*)dst = (u32x4){ow[0], ow[1], ow[2], ow[3]}; *(u32x4*)(dst + 8) = (u32x4){ow[4], ow[5], ow[6], ow[7]}; } }
    if (tid < 2) DNGL[pu0 + tid] = __expf(gcs[tid * 64 + 63]);
    __syncthreads();
    if (wave < 2) { const int dir = wave; const LAS float* A = AS + dir * 64 * 68; f32x2 tp[32]; const int lane3 = opaque_tid() & 63;
#pragma unroll
        for (int i0 = 0; i0 < 64; i0 += 4) { f32x2 ac[4];
#pragma unroll
            for (int r = 0; r < 4; ++r) ac[r] = (f32x2){(i0 + r == lane3) ? 1.f : 0.f, 0.f};
#pragma unroll
            for (int j4 = 0; j4 < i0 / 4; ++j4) {
#pragma unroll
                for (int r = 0; r < 4; ++r) { const f32x4 v = *(const LAS f32x4*)(A + (i0 + r) * 68 + 4 * j4);
                    ac[r] -= (f32x2){v[0], v[1]} * tp[2 * j4]; ac[r] -= (f32x2){v[2], v[3]} * tp[2 * j4 + 1]; }
                asm volatile("" : "+v"(ac[0]), "+v"(ac[1]), "+v"(ac[2]), "+v"(ac[3]) :: "memory"); }
            const f32x4 v1 = *(const LAS f32x4*)(A + (i0 + 1) * 68 + i0), v2 = *(const LAS f32x4*)(A + (i0 + 2) * 68 + i0), v3 = *(const LAS f32x4*)(A + (i0 + 3) * 68 + i0);
            const float t0 = ac[0].x + ac[0].y;
            const float t1 = (ac[1].x + ac[1].y) - v1[0] * t0;
            const float t2 = (ac[2].x + ac[2].y) - v2[0] * t0 - v2[1] * t1;
            const float t3 = (ac[3].x + ac[3].y) - v3[0] * t0 - v3[1] * t1 - v3[2] * t2;
            tp[i0 / 2] = (f32x2){t0, t1}; tp[i0 / 2 + 1] = (f32x2){t2, t3}; }
        const float be = bes[dir * 64 + lane3], bg = be * __expf(gcs[dir * 64 + lane3]); const int tau = dir ? 63 - lane3 : lane3;
        LAS bf16_t* TP = (LAS bf16_t*)(L + (dir * 2 + 0) * 9216); LAS bf16_t* TPP = (LAS bf16_t*)(L + (dir * 2 + 1) * 9216);
#pragma unroll
        for (int k = 0; k < 32; ++k) { TP[(2 * k) * 72 + tau] = (bf16_t)f2bf(tp[k].x * be); TPP[(2 * k) * 72 + tau] = (bf16_t)f2bf(tp[k].x * bg); TP[(2 * k + 1) * 72 + tau] = (bf16_t)f2bf(tp[k].y * be); TPP[(2 * k + 1) * 72 + tau] = (bf16_t)f2bf(tp[k].y * bg); } }
    __syncthreads();
    { const int tid4 = opaque_tid(), lane4 = tid4 & 63, wave4 = __builtin_amdgcn_readfirstlane(tid4 >> 6), rr4 = lane4 & 15, kg4 = lane4 >> 4;
#pragma unroll
    for (int mat = 0; mat < 2; ++mat) { const LAS unsigned char* As_ = L + (mat ? DP_KT : DP_VT); bf16x8 a[2];
#pragma unroll
        for (int ks = 0; ks < 2; ++ks) a[ks] = ldsfrag(As_ + (16 * wave4 + rr4) * 144 + (32 * ks + 8 * kg4) * 2);
#pragma unroll
        for (int dir = 0; dir < 2; ++dir) { const LAS unsigned char* Bs_ = L + (dir * 2 + mat) * 9216; bf16_t* OUT = (mat ? DNKC : DNW) + (pu0 + dir) * 8192;
#pragma unroll
            for (int it = 0; it < 4; ++it) { f32x4 c = {0.f, 0.f, 0.f, 0.f};
#pragma unroll
                for (int ks = 0; ks < 2; ++ks) c = mfma16(a[ks], ldsfrag(Bs_ + (16 * it + rr4) * 144 + (32 * ks + 8 * kg4) * 2), c);
                u32x2 w; w.x = pk2(c[0], c[1]); w.y = pk2(c[2], c[3]); *(u32x2*)(OUT + (16 * it + rr4) * 128 + 16 * wave4 + 4 * kg4) = w; } } } }
    __syncthreads();
}

constexpr int DS_KC = 0, DS_QG = 17408, DS_KGT = 34816, DS_QK = 53248, DS_W = 62464, DS_SB = 79872, DS_VT = 114688;
__device__ __forceinline__ void dnscan_unit(Frame& F, int unit) {
    const bf16_t* DNW = (const bf16_t*)(F.ws + WS_DNW); const bf16_t* DNKC = (const bf16_t*)(F.ws + WS_DNKC); const bf16_t* DNQG = (const bf16_t*)(F.ws + WS_DNQG); const bf16_t* DNKGT = (const bf16_t*)(F.ws + WS_DNKGT); const bf16_t* DNQK = (const bf16_t*)(F.ws + WS_DNQK); const float* DNGL = (const float*)(F.ws + WS_DNGL);
    bf16_t* ODN = (bf16_t*)(F.ws + WS_ODN);
    LAS unsigned char* L = F.lds;
    const int tid = F.tid, lane = F.lane, wave = F.wave, rr = lane & 15, kg = lane >> 4;
    const int dir = unit & 1, h = (unit >> 1) & 3, b = unit >> 3;
    const int mt = wave >> 1, ng = wave & 1;
    f32x4 s[2][4];
#pragma unroll
    for (int di = 0; di < 2; ++di)
#pragma unroll
        for (int j = 0; j < 4; ++j) s[di][j] = (f32x4){0.f, 0.f, 0.f, 0.f};
    for (int i = tid; i < 34816 / 4; i += NWAVES * 64) ((LAS unsigned*)(L + DS_SB))[i] = 0u;
#define DS_CG(t) (dir ? ((t) < 4 ? 3 - (t) : 135 - (t)) : (t))
#define DS_DECL(S) u32x4 rKC##S[2], rQG##S[2], rKGT##S[2], rQK##S, rW##S[2]; float rGL##S = 0.f
#define DS_LOAD(t, S) do { const size_t pu_ = (size_t)((b * DN_NCH + DS_CG(t)) * 4 + h) * 2 + dir; \
        _Pragma("unroll") for (int q_ = 0; q_ < 2; ++q_) { const int id_ = tid + 512 * q_; \
            rKC##S[q_] = *(const u32x4*)(DNKC + pu_ * 8192 + (id_ >> 4) * 128 + (id_ & 15) * 8); rQG##S[q_] = *(const u32x4*)(DNQG + pu_ * 8192 + (id_ >> 4) * 128 + (id_ & 15) * 8); \
            rW##S[q_] = *(const u32x4*)(DNW + pu_ * 8192 + (id_ >> 4) * 128 + (id_ & 15) * 8); \
            rKGT##S[q_] = *(const u32x4*)(DNKGT + pu_ * 8192 + (id_ >> 3) * 64 + (id_ & 7) * 8); } \
        rQK##S = *(const u32x4*)(DNQK + pu_ * 4096 + (tid >> 3) * 64 + (tid & 7) * 8); \
        rGL##S = DNGL[pu_]; } while (0)
#define DS_STORE(S) do { _Pragma("unroll") for (int q_ = 0; q_ < 2; ++q_) { const int id_ = tid + 512 * q_; \
            *(LAS u32x4*)(L + DS_KC + (id_ >> 4) * 272 + (id_ & 15) * 16) = rKC##S[q_]; *(LAS u32x4*)(L + DS_QG + (id_ >> 4) * 272 + (id_ & 15) * 16) = rQG##S[q_]; \
            *(LAS u32x4*)(L + DS_W + (id_ >> 4) * 272 + (id_ & 15) * 16) = rW##S[q_]; \
            *(LAS u32x4*)(L + DS_KGT + (id_ >> 3) * 144 + (id_ & 7) * 16) = rKGT##S[q_]; } \
        *(LAS u32x4*)(L + DS_QK + (tid >> 3) * 144 + (tid & 7) * 16) = rQK##S; gl = rGL##S; } while (0)
#define DS_STEP(t) do { const int cg = DS_CG(t); \
        f32x4 av[4], ao[4]; \
        _Pragma("unroll") for (int j = 0; j < 4; ++j) { av[j] = (f32x4){0.f, 0.f, 0.f, 0.f}; ao[j] = av[j]; } \
        _Pragma("unroll") for (int ks = 0; ks < 4; ++ks) { const bf16x8 akc = ldsfrag(L + DS_KC + (16 * mt + rr) * 272 + (32 * ks + 8 * kg) * 2), aqg = ldsfrag(L + DS_QG + (16 * mt + rr) * 272 + (32 * ks + 8 * kg) * 2); \
            _Pragma("unroll") for (int j = 0; j < 4; ++j) { const bf16x8 bs = ldsfrag(L + DS_SB + (64 * ng + 16 * j + rr) * 272 + (32 * ks + 8 * kg) * 2); av[j] = mfma16(akc, bs, av[j]); ao[j] = mfma16(aqg, bs, ao[j]); } } \
        _Pragma("unroll") for (int j = 0; j < 4; ++j) { float vn[4]; \
            _Pragma("unroll") for (int r = 0; r < 4; ++r) vn[r] = bf2f(*(const LAS bf16_t*)(L + DS_W + (16 * mt + 4 * kg + r) * 272 + (64 * ng + 16 * j + rr) * 2)) - av[j][r]; \
            u32x2 w; w.x = pk2(vn[0], vn[1]); w.y = pk2(vn[2], vn[3]); *(LAS u32x2*)(L + DS_VT + (64 * ng + 16 * j + rr) * 144 + (16 * mt + 4 * kg) * 2) = w; } \
        __syncthreads(); \
        bf16x8 bV[4][2]; \
        _Pragma("unroll") for (int ks = 0; ks < 2; ++ks) { const bf16x8 aqk = ldsfrag(L + DS_QK + (16 * mt + rr) * 144 + (32 * ks + 8 * kg) * 2); \
            _Pragma("unroll") for (int j = 0; j < 4; ++j) { bV[j][ks] = ldsfrag(L + DS_VT + (64 * ng + 16 * j + rr) * 144 + (32 * ks + 8 * kg) * 2); ao[j] = mfma16(aqk, bV[j][ks], ao[j]); } } \
        _Pragma("unroll") for (int j = 0; j < 4; ++j) \
            _Pragma("unroll") for (int r = 0; r < 4; ++r) { const int i = 16 * mt + 4 * kg + r, tok = dir ? 63 - i : i; \
                ODN[((size_t)dir * MROWS + (size_t)(b * TOK + 64 * cg + tok)) * 512 + h * 128 + 64 * ng + 16 * j + rr] = (bf16_t)f2bf(ao[j][r]); } \
        _Pragma("unroll") for (int di = 0; di < 2; ++di) \
            _Pragma("unroll") for (int j = 0; j < 4; ++j) s[di][j] = s[di][j] * gl; \
        _Pragma("unroll") for (int ks = 0; ks < 2; ++ks) \
            _Pragma("unroll") for (int di = 0; di < 2; ++di) { const bf16x8 akg = ldsfrag(L + DS_KGT + (32 * mt + 16 * di + rr) * 144 + (32 * ks + 8 * kg) * 2); \
                _Pragma("unroll") for (int j = 0; j < 4; ++j) s[di][j] = mfma16(akg, bV[j][ks], s[di][j]); } \
        __syncthreads(); \
        _Pragma("unroll") for (int di = 0; di < 2; ++di) \
            _Pragma("unroll") for (int j = 0; j < 4; ++j) { u32x2 w; w.x = pk2(s[di][j][0], s[di][j][1]); w.y = pk2(s[di][j][2], s[di][j][3]); \
                *(LAS u32x2*)(L + DS_SB + (64 * ng + 16 * j + rr) * 272 + (32 * mt + 16 * di + 4 * kg) * 2) = w; } } while (0)
    DS_DECL(A); DS_DECL(B); float gl = 0.f;
    DS_LOAD(0, A); DS_LOAD(1, B); DS_STORE(A);
    __syncthreads();
    for (int t = 0; t < DN_NCH; t += 2) {
        if (t + 2 < DN_NCH) DS_LOAD(t + 2, A);
        DS_STEP(t);
        DS_STORE(B);
        __syncthreads();
        if (t + 3 < DN_NCH) DS_LOAD(t + 3, B);
        DS_STEP(t + 1);
        if (t + 2 < DN_NCH) DS_STORE(A);
        __syncthreads();
    }
#undef DS_CG
#undef DS_DECL
#undef DS_LOAD
#undef DS_STORE
#undef DS_STEP
}

__device__ __forceinline__ float log_sigmoid_f(float x) { return -log1pf(expf(-x)); }
constexpr int RP_QS = 0, RP_KS = 34816, RP_DK = 69632;
__device__ __forceinline__ void retprep_unit(Frame& F, int l, int unit) {
    const bf16_t* P = (const bf16_t*)(F.ws + WS_P); bf16_t* RQKD = (bf16_t*)(F.ws + WS_RQKD); bf16_t* RKDT = (bf16_t*)(F.ws + WS_RKDT);
    LAS unsigned char* L = F.lds;
    const int tid = F.tid, lane = F.lane, wave = F.wave, rr = lane & 15, kg = lane >> 4;
    const int h = unit & 3, c = (unit >> 2) % RET_NCH, b = (unit >> 2) / RET_NCH, rbase = b * TOK + 128 * c;
    const size_t pu0 = (size_t)((b * RET_NCH + c) * 4 + h) * 2;
    const float lg0 = log_sigmoid_f(inp(F, I_ret_decay)[l * 8 + h]), lg1 = log_sigmoid_f(inp(F, I_ret_decay)[l * 8 + 4 + h]);
    { const int row = tid >> 2, seg = tid & 3; const bf16_t* src = P + (size_t)(rbase + row) * PW + h * 128 + seg * 32;
#pragma unroll
      for (int q = 0; q < 4; ++q) { *(LAS u32x4*)(L + RP_QS + row * 272 + seg * 64 + q * 16) = *(const u32x4*)(src + C_RQ + q * 8); *(LAS u32x4*)(L + RP_KS + row * 272 + seg * 64 + q * 16) = *(const u32x4*)(src + C_RK + q * 8); } }
    if (tid < 256) ((LAS float*)(L + RP_DK))[tid] = __expf((float)(127 - (tid & 127)) * (tid < 128 ? lg0 : lg1));
    else ((LAS float*)(L + RP_DK + 1024))[tid - 256] = __expf((float)((tid - 256) & 127) * (tid < 384 ? lg0 : lg1));
    __syncthreads();
    { bf16x8 bQ[4];
#pragma unroll
      for (int ks = 0; ks < 4; ++ks) bQ[ks] = ldsfrag(L + RP_QS + (16 * wave + rr) * 272 + (32 * ks + 8 * kg) * 2);
      const int i = 16 * wave + rr;
      for (int jt = 0; jt < 8; ++jt) { f32x4 cc = {0.f, 0.f, 0.f, 0.f};
#pragma unroll
          for (int ks = 0; ks < 4; ++ks) cc = mfma16(ldsfrag(L + RP_KS + (16 * jt + rr) * 272 + (32 * ks + 8 * kg) * 2), bQ[ks], cc);
          const int jb = 16 * jt + 4 * kg; float v0[4], v1[4];
          const LAS float* E0 = (const LAS float*)(L + RP_DK + 1024) + (i - jb - 3); const LAS float* E1 = (const LAS float*)(L + RP_DK + 1536) + (jb - i);
          const float e0[4] = {E0[3], E0[2], E0[1], E0[0]}, e1[4] = {E1[0], E1[1], E1[2], E1[3]};
#pragma unroll
          for (int r = 0; r < 4; ++r) { const int j = jb + r; v0[r] = (j <= i) ? cc[r] * e0[r] : 0.f; v1[r] = (j >= i) ? cc[r] * e1[r] : 0.f; }
          u32x2 w; w.x = pk2(v0[0], v0[1]); w.y = pk2(v0[2], v0[3]); *(u32x2*)(RQKD + (pu0 + 0) * 16384 + i * 128 + jb) = w;
          w.x = pk2(v1[3], v1[2]); w.y = pk2(v1[1], v1[0]); *(u32x2*)(RQKD + (pu0 + 1) * 16384 + (127 - i) * 128 + (124 - jb)) = w; } }
    { const int d = tid >> 2, sg = tid & 3;
#pragma unroll
      for (int dir = 0; dir < 2; ++dir) { const float lg = dir ? lg1 : lg0;
#pragma unroll
          for (int q = 0; q < 4; ++q) { unsigned ow[4];
              const f32x4 dk0 = *(const LAS f32x4*)(L + RP_DK + (dir * 128 + 32 * sg + 8 * q) * 4), dk1 = *(const LAS f32x4*)(L + RP_DK + (dir * 128 + 32 * sg + 8 * q + 4) * 4);
#pragma unroll
              for (int e = 0; e < 4; ++e) { const int j0 = 32 * sg + 8 * q + 2 * e, j1 = j0 + 1; const int t0 = dir ? 127 - j0 : j0, t1 = dir ? 127 - j1 : j1;
                  const float a0 = bf2f(*(const LAS bf16_t*)(L + RP_KS + t0 * 272 + d * 2)) * (e < 2 ? dk0[2 * e] : dk1[2 * e - 4]), a1 = bf2f(*(const LAS bf16_t*)(L + RP_KS + t1 * 272 + d * 2)) * (e < 2 ? dk0[2 * e + 1] : dk1[2 * e - 3]);
                  ow[e] = pk2(a0, a1); }
              *(u32x4*)(RKDT + (pu0 + dir) * 16384 + d * 128 + 32 * sg + 8 * q) = (u32x4){ow[0], ow[1], ow[2], ow[3]}; } } }
    __syncthreads();
}

constexpr int RS_VS = 0, RS_SB = 36864;
__device__ __forceinline__ s16x4 rs_tr_read(unsigned addr) { s16x4 r; asm volatile("ds_read_b64_tr_b16 %0, %1" : "=&v"(r) : "v"(addr) : "memory"); return r; }
__device__ __forceinline__ bf16x8 rs_scale_frag(bf16x8 f, float sc) { u32x4 w = __builtin_bit_cast(u32x4, f);
    w.x = pk2(bflo(w.x) * sc, bfhi(w.x) * sc); w.y = pk2(bflo(w.y) * sc, bfhi(w.y) * sc); w.z = pk2(bflo(w.z) * sc, bfhi(w.z) * sc); w.w = pk2(bflo(w.w) * sc, bfhi(w.w) * sc); return __builtin_bit_cast(bf16x8, w); }
__device__ __forceinline__ void retscan_unit(Frame& F, int l, int unit) {
    const bf16_t* P = (const bf16_t*)(F.ws + WS_P); const bf16_t* RQKD = (const bf16_t*)(F.ws + WS_RQKD); const bf16_t* RKDT = (const bf16_t*)(F.ws + WS_RKDT); bf16_t* ORET = (bf16_t*)(F.ws + WS_ORET);
    LAS unsigned char* L = F.lds;
    const int tid = F.tid, lane = F.lane, wave = F.wave, rr = lane & 15, kg = lane >> 4;
    const int dir = unit & 1, h = (unit >> 1) & 3, b = unit >> 3;
    const float lg = log_sigmoid_f(inp(F, I_ret_decay)[l * 8 + dir * 4 + h]), gC = __expf(128.f * lg);
    const int irow = 16 * wave + rr;
    const unsigned vtr = (unsigned)(uintptr_t)L + (unsigned)(RS_VS + (8 * kg + (rr >> 2)) * 288 + (4 * (rr & 3)) * 2);
    f32x4 s[8];
#pragma unroll
    for (int j = 0; j < 8; ++j) s[j] = (f32x4){0.f, 0.f, 0.f, 0.f};
    for (int i = tid; i < 34816 / 4; i += NWAVES * 64) ((LAS unsigned*)(L + RS_SB))[i] = 0u;
#define RS_C(t) (dir ? ((t) < 2 ? 1 - (t) : 67 - (t)) : (t))
    bf16x8 fQ[4], fD[4], fK[4]; u32x4 rV[4];
#define RS_FLOAD(t) do { const int c_ = RS_C(t); const size_t pu_ = (size_t)((b * RET_NCH + c_) * 4 + h) * 2 + dir; const size_t rb_ = (size_t)b * TOK + 128 * c_; \
        const bf16_t* q_ = P + (rb_ + (dir ? 127 - irow : irow)) * PW + C_RQ + h * 128 + 8 * kg; const bf16_t* d_ = RQKD + pu_ * 16384 + irow * 128 + 8 * kg; const bf16_t* k_ = RKDT + pu_ * 16384 + irow * 128 + 8 * kg; \
        _Pragma("unroll") for (int ks = 0; ks < 4; ++ks) { fQ[ks] = *(const bf16x8*)(q_ + 32 * ks); fD[ks] = *(const bf16x8*)(d_ + 32 * ks); fK[ks] = *(const bf16x8*)(k_ + 32 * ks); } } while (0)
#define RS_VLOAD(t) do { const size_t rb_ = (size_t)b * TOK + 128 * RS_C(t); \
        _Pragma("unroll") for (int q4 = 0; q4 < 4; ++q4) { const int id_ = tid + 512 * q4, row_ = id_ >> 4; rV[q4] = *(const u32x4*)(P + (rb_ + (dir ? 127 - row_ : row_)) * PW + C_RV + h * 128 + (id_ & 15) * 8); } } while (0)
#define RS_VSTORE() do { _Pragma("unroll") for (int q4 = 0; q4 < 4; ++q4) { const int id_ = tid + 512 * q4; *(LAS u32x4*)(L + RS_VS + (id_ >> 4) * 288 + (id_ & 15) * 16) = rV[q4]; } } while (0)
    float rsc[4];
#pragma unroll
    for (int r = 0; r < 4; ++r) rsc[r] = __expf((float)(16 * wave + 4 * kg + r + 1) * lg);
    RS_FLOAD(0); RS_VLOAD(0); RS_VSTORE(); if (1 < RET_NCH) RS_VLOAD(1);
    __syncthreads();
    for (int t = 0; t < RET_NCH; ++t) {
        const int c = RS_C(t);
#pragma unroll
        for (int nt = 0; nt < 8; ++nt) { bf16x8 bS[4]; s16x4 vl[4], vh[4];
#pragma unroll
            for (int ks = 0; ks < 4; ++ks) { bS[ks] = ldsfrag(L + RS_SB + (16 * nt + rr) * 272 + (32 * ks + 8 * kg) * 2);
                vl[ks] = rs_tr_read(vtr + (unsigned)((32 * ks) * 288 + 32 * nt)); vh[ks] = rs_tr_read(vtr + (unsigned)((32 * ks + 4) * 288 + 32 * nt)); }
            asm volatile("s_waitcnt lgkmcnt(0)" ::: "memory"); __builtin_amdgcn_sched_barrier(0);
            f32x4 o1 = {0.f, 0.f, 0.f, 0.f}, o2 = {0.f, 0.f, 0.f, 0.f}; s[nt] = s[nt] * gC;
#pragma unroll
            for (int ks = 0; ks < 4; ++ks) { const bf16x8 bv = (bf16x8){vl[ks][0], vl[ks][1], vl[ks][2], vl[ks][3], vh[ks][0], vh[ks][1], vh[ks][2], vh[ks][3]};
                o1 = mfma16(fQ[ks], bS[ks], o1); o2 = mfma16(fD[ks], bv, o2); s[nt] = mfma16(fK[ks], bv, s[nt]); }
#pragma unroll
            for (int r = 0; r < 4; ++r) { const int i = 16 * wave + 4 * kg + r, tok = dir ? 127 - i : i;
                ORET[((size_t)dir * MROWS + (size_t)(b * TOK + 128 * c + tok)) * 512 + h * 128 + 16 * nt + rr] = (bf16_t)f2bf(o1[r] * rsc[r] + o2[r]); } }
        if (t + 1 < RET_NCH) RS_FLOAD(t + 1);
        __syncthreads();
#pragma unroll
        for (int nt = 0; nt < 8; ++nt) { u32x2 w; w.x = pk2(s[nt][0], s[nt][1]); w.y = pk2(s[nt][2], s[nt][3]); *(LAS u32x2*)(L + RS_SB + (16 * nt + rr) * 272 + (16 * wave + 4 * kg) * 2) = w; }
        if (t + 1 < RET_NCH) RS_VSTORE();
        __syncthreads();
        if (t + 2 < RET_NCH) RS_VLOAD(t + 2);
    }
#undef RS_C
#undef RS_FLOAD
#undef RS_VLOAD
#undef RS_VSTORE
}

constexpr int ATT_SPLIT = 2304;
__device__ __forceinline__ void attention_phase(Frame& F, int l, bool keep_ctx) {
    const bf16_t* P = (const bf16_t*)(F.ws + WS_P); bf16_t* Y = (bf16_t*)(F.ws + WS_Y); bf16_t* OPART = (bf16_t*)(F.ws + WS_OPART); float* ASTAT = (float*)(F.ws + WS_ASTAT);
    unsigned* qhead = F.ctl + CW_ATTQ + 64 * l; volatile LAS unsigned* slot = F.MISC + 4;
    const unsigned nunits = 1024u + (keep_ctx ? 16u : 0u);
    float mraw; { const float* qn = inp(F, I_att_qn_w) + l * 128; const float* kn = inp(F, I_att_kn_w) + l * 128; float a = fmaxf(fabsf(qn[F.lane]), fabsf(qn[64 + F.lane])), b = fmaxf(fabsf(kn[F.lane]), fabsf(kn[64 + F.lane]));
#pragma unroll
      for (int o = 32; o > 0; o >>= 1) { a = fmaxf(a, __shfl_xor(a, o)); b = fmaxf(b, __shfl_xor(b, o)); }
      mraw = __int_as_float(__builtin_amdgcn_readfirstlane(__float_as_int(128.f * 1.01f * a * b))); }
    const bool fixm = mraw * att::SCALE <= 40.f;
    for (;;) {
        __syncthreads();
        if (F.tid == 0) *slot = __hip_atomic_fetch_add(qhead, 1u, __ATOMIC_RELAXED, __HIP_MEMORY_SCOPE_AGENT);
        __syncthreads();
        const unsigned idx = *slot;
        if (idx >= nunits) break;
        if (idx < 1024u) { const int qb = idx & 31, g = (idx >> 5) & 3, kvh = (idx >> 7) & 1, b = (idx >> 8) & 1, part = 1 - (int)(idx >> 9), hq = kvh * 4 + g;
            const size_t qrow0 = (size_t)b * TOK + CTXL + 256 * qb, krow0 = (size_t)b * TOK + (size_t)part * ATT_SPLIT; const int nkeys = part ? TOK - ATT_SPLIT : ATT_SPLIT;
            if (fixm) att::attn_dense_body<att::bf16, 1024, true>((const att::bf16*)(P + qrow0 * PW + C_AQ + hq * 128), (const att::bf16*)(P + krow0 * PW + C_AK + kvh * 128), (const att::bf16*)(P + krow0 * PW + C_AV + kvh * 128),
                                                  OPART + ((size_t)part * MROWS + qrow0) * 1024 + hq * 128, ASTAT + (((size_t)part * MROWS + qrow0) * 8 + hq) * 2, nkeys, (char*)F.ldsg, 0.f);
            else att::attn_dense_body<att::bf16, 1024, false>((const att::bf16*)(P + qrow0 * PW + C_AQ + hq * 128), (const att::bf16*)(P + krow0 * PW + C_AK + kvh * 128), (const att::bf16*)(P + krow0 * PW + C_AV + kvh * 128),
                                                  OPART + ((size_t)part * MROWS + qrow0) * 1024 + hq * 128, ASTAT + (((size_t)part * MROWS + qrow0) * 8 + hq) * 2, nkeys, (char*)F.ldsg, 0.f); }
        else { const int j = idx - 1024, hq = j & 7, b = j >> 3, kvh = hq >> 2; const size_t qrow0 = (size_t)b * TOK;
            att::attn_dense_body<att::bf16, YW, false>((const att::bf16*)(P + qrow0 * PW + C_AQ + hq * 128), (const att::bf16*)(P + qrow0 * PW + C_AK + kvh * 128), (const att::bf16*)(P + qrow0 * PW + C_AV + kvh * 128),
                                                Y + qrow0 * YW + 1024 + hq * 128, nullptr, CTXL, (char*)F.ldsg, 0.f); }
    }
}

__device__ __forceinline__ void mixepi_phase(Frame& F, int l, bool keep_ctx) {
    const bf16_t* P = (const bf16_t*)(F.ws + WS_P); bf16_t* Y = (bf16_t*)(F.ws + WS_Y); const bf16_t* ORET = (const bf16_t*)(F.ws + WS_ORET); const bf16_t* ODN = (const bf16_t*)(F.ws + WS_ODN);
    const bf16_t* OPART = (const bf16_t*)(F.ws + WS_OPART); const float* ASTAT = (const float*)(F.ws + WS_ASTAT);
    const int lane = F.lane, gw = F.vcu * NWAVES + F.wave, NGW = F.G * NWAVES, c0 = 8 * lane;
    const f32x4 nw0 = *(const f32x4*)(inp(F, I_dn_norm_w) + l * 128 + (c0 & 127)), nw1 = *(const f32x4*)(inp(F, I_dn_norm_w) + l * 128 + (c0 & 127) + 4);
    struct RowIn { u32x4 fa[2], fb[2], gz[2], o1[2], o2[2]; f32x2 s1[2], s2[2]; };
#define MX_VALID(r) ((r) < MROWS && (keep_ctx || ((r) % TOK) >= CTXL))
#define MX_NEXT(r) do { r += NGW; } while ((r) < MROWS && !MX_VALID(r))
#define MX_LOAD(S, r) do { const size_t r_ = (size_t)(r); const bool lat_ = ((r) % TOK) >= CTXL; \
        S.fa[0] = *(const u32x4*)(ORET + r_ * 512 + c0); S.fb[0] = *(const u32x4*)(ORET + ((size_t)MROWS + r_) * 512 + c0); S.gz[0] = *(const u32x4*)(P + r_ * PW + C_RG + c0); \
        S.fa[1] = *(const u32x4*)(ODN + r_ * 512 + c0); S.fb[1] = *(const u32x4*)(ODN + ((size_t)MROWS + r_) * 512 + c0); S.gz[1] = *(const u32x4*)(P + r_ * PW + C_DZ + c0); \
        if (lat_) { _Pragma("unroll") for (int q = 0; q < 2; ++q) { const int ch = lane + 64 * q, hq = ch >> 4; \
            S.s1[q] = *(const f32x2*)(ASTAT + (r_ * 8 + hq) * 2); S.s2[q] = *(const f32x2*)(ASTAT + (((size_t)MROWS + r_) * 8 + hq) * 2); \
            S.o1[q] = *(const u32x4*)(OPART + r_ * 1024 + ch * 8); S.o2[q] = *(const u32x4*)(OPART + ((size_t)MROWS + r_) * 1024 + ch * 8); } } } while (0)
#define MX_PROC(S, r) do { const size_t r_ = (size_t)(r); const bool lat_ = ((r) % TOK) >= CTXL; \
        _Pragma("unroll") for (int grp = 0; grp < 2; ++grp) { const u32x4 fa = S.fa[grp], fb = S.fb[grp], gz = S.gz[grp]; \
            f32x4 o0 = (f32x4){bflo(fa.x) + bflo(fb.x), bfhi(fa.x) + bfhi(fb.x), bflo(fa.y) + bflo(fb.y), bfhi(fa.y) + bfhi(fb.y)}, o1 = (f32x4){bflo(fa.z) + bflo(fb.z), bfhi(fa.z) + bfhi(fb.z), bflo(fa.w) + bflo(fb.w), bfhi(fa.w) + bfhi(fb.w)}; \
            float ss = (o0[0] * o0[0] + o0[1] * o0[1]) + (o0[2] * o0[2] + o0[3] * o0[3]) + (o1[0] * o1[0] + o1[1] * o1[1]) + (o1[2] * o1[2] + o1[3] * o1[3]); \
            const float ri = rsqrtf(sum16(ss) * (1.f / 128.f) + EPS); \
            o0 = o0 * ri; o1 = o1 * ri; if (grp) { o0 = o0 * nw0; o1 = o1 * nw1; } \
            u32x4 w; w.x = pk2(o0[0] * silu_f(bflo(gz.x)), o0[1] * silu_f(bfhi(gz.x))); w.y = pk2(o0[2] * silu_f(bflo(gz.y)), o0[3] * silu_f(bfhi(gz.y))); \
            w.z = pk2(o1[0] * silu_f(bflo(gz.z)), o1[1] * silu_f(bfhi(gz.z))); w.w = pk2(o1[2] * silu_f(bflo(gz.w)), o1[3] * silu_f(bfhi(gz.w))); \
            *(u32x4*)(Y + r_ * YW + grp * 512 + c0) = w; } \
        if (lat_) { constexpr float C = 1.f;     \
            _Pragma("unroll") for (int q = 0; q < 2; ++q) { const int ch = lane + 64 * q; const f32x2 s1 = S.s1[q], s2 = S.s2[q]; const u32x4 o1 = S.o1[q], o2 = S.o2[q]; \
                const float m = fmaxf(s1.x, s2.x), a1 = s1.y * __builtin_amdgcn_exp2f((s1.x - m) * C), a2 = s2.y * __builtin_amdgcn_exp2f((s2.x - m) * C), inv = 1.f / (a1 + a2), w1 = a1 * inv, w2 = a2 * inv; \
                u32x4 w; w.x = pk2(w1 * bflo(o1.x) + w2 * bflo(o2.x), w1 * bfhi(o1.x) + w2 * bfhi(o2.x)); w.y = pk2(w1 * bflo(o1.y) + w2 * bflo(o2.y), w1 * bfhi(o1.y) + w2 * bfhi(o2.y)); \
                w.z = pk2(w1 * bflo(o1.z) + w2 * bflo(o2.z), w1 * bfhi(o1.z) + w2 * bfhi(o2.z)); w.w = pk2(w1 * bflo(o1.w) + w2 * bflo(o2.w), w1 * bfhi(o1.w) + w2 * bfhi(o2.w)); \
                *(u32x4*)(Y + r_ * YW + 1024 + ch * 8) = w; } } } while (0)
    RowIn A, B;
    int r = gw; if (!MX_VALID(r) && r < MROWS) MX_NEXT(r);
    if (r < MROWS) MX_LOAD(A, r);
    while (r < MROWS) {
        int rn = r; MX_NEXT(rn); if (rn < MROWS) MX_LOAD(B, rn);
        MX_PROC(A, r); r = rn; if (r >= MROWS) break;
        rn = r; MX_NEXT(rn); if (rn < MROWS) MX_LOAD(A, rn);
        MX_PROC(B, r); r = rn;
    }
#undef MX_VALID
#undef MX_NEXT
#undef MX_LOAD
#undef MX_PROC
}
constexpr int NSTEPS = 2 + 10 * DEPTH;
#ifndef PH_MASK
#define PH_MASK 0xFFFFF
#endif
#define PH(k) (((PH_MASK) >> (k)) & 1)
struct Args { const float* in[21]; float* out; unsigned char* ws; int s_lo, s_hi; };
__global__ void __launch_bounds__(NWAVES * 64, 2) fwd(Args a) {
    extern __shared__ __attribute__((aligned(16))) unsigned char lds_raw[];
    Frame F;
    F.lds = (LAS unsigned char*)lds_raw; F.ldsg = lds_raw;
    F.MISC = (volatile LAS unsigned*)(F.lds + MISC_OFF);
    F.tid = threadIdx.x; F.lane = F.tid & 63; F.wave = __builtin_amdgcn_readfirstlane(F.tid >> 6);
    F.G = gridDim.x; { const int bx = blockIdx.x; F.vcu = (F.G % 8 == 0) ? (bx % 8) * (F.G / 8) + bx / 8 : bx; }
    F.ws = a.ws; F.ctl = (unsigned*)(a.ws + WS_CTL);
    for (int u = F.tid; u < (LDS_BYTES - RING_BYTES) / 4; u += NWAVES * 64) ((LAS unsigned*)(F.lds + RING_BYTES))[u] = 0u;
    __syncthreads();
    if (F.tid == 0) {
#define PUTP(k, p) do { const unsigned long long v_ = (unsigned long long)(p); F.MISC[16 + 2 * (k)] = (unsigned)v_; F.MISC[17 + 2 * (k)] = (unsigned)(v_ >> 32); } while (0)
        PUTP(0, a.in[0]); PUTP(1, a.in[1]); PUTP(2, a.in[2]); PUTP(3, a.in[3]); PUTP(4, a.in[4]); PUTP(5, a.in[5]); PUTP(6, a.in[6]); PUTP(7, a.in[7]); PUTP(8, a.in[8]); PUTP(9, a.in[9]); PUTP(10, a.in[10]);
        PUTP(11, a.in[11]); PUTP(12, a.in[12]); PUTP(13, a.in[13]); PUTP(14, a.in[14]); PUTP(15, a.in[15]); PUTP(16, a.in[16]); PUTP(17, a.in[17]); PUTP(18, a.in[18]); PUTP(19, a.in[19]); PUTP(20, a.in[20]); PUTP(21, a.out);
#undef PUTP
    }
    __syncthreads();
    XcdBarrier bar; bar.bar = F.ctl + CW_BAR; bar.x = 0; bar.st = nullptr;
    if (MK_ONE_LAUNCH) bar = xcd_barrier_post(F.ctl + CW_BAR, F.MISC + 8);
    const int lo = a.s_lo, hi = a.s_hi;
#define IN(k) (lo <= (k) && (k) < hi)
#define ENTER() do { F.tid = opaque_tid(); F.lane = F.tid & 63; F.wave = __builtin_amdgcn_readfirstlane(F.tid >> 6); F.ws = opaque_ptr(a.ws); F.ctl = (unsigned*)F.ws; } while (0)
#define SEAM(k) do { if (MK_ONE_LAUNCH && IN(k) && IN((k) + 1)) xcd_barrier(bar); } while (0)
#define Hb ((bf16_t*)(F.ws + WS_H))
#define Pb ((bf16_t*)(F.ws + WS_P))
#define Yb ((bf16_t*)(F.ws + WS_Y))
#define Xf ((float*)(F.ws + WS_X))
#define ABf ((float*)(F.ws + WS_AB))
#define MOD ((const float*)(F.ws + WS_MOD))

#ifdef PROBE_MASK
#define PROBE_T0() const unsigned long long t0_ = __builtin_amdgcn_s_memrealtime()
#define PROBE_DELAY(cls) do { if (((PROBE_MASK) >> (cls)) & 1) { const unsigned long long t1_ = __builtin_amdgcn_s_memrealtime(), d_ = t1_ - t0_; while (__builtin_amdgcn_s_memrealtime() - t1_ < d_) __builtin_amdgcn_s_sleep(8); } } while (0)
#else
#define PROBE_T0() do { } while (0)
#define PROBE_DELAY(cls) do { } while (0)
#endif
#define STEP(k, cls, ...) do { if (IN(k)) { PROBE_T0(); { __VA_ARGS__ } SEAM(k); PROBE_DELAY(cls); } } while (0)

    STEP(0, 0, if (PH(0)) { ENTER(); prologue_phase(F); });
    STEP(1, 0, if (PH(1)) { ENTER(); ln_mod_phase<0>(F, 0, false); });
    for (int l = 0; l < DEPTH; ++l) {
        const int sb = 2 + 10 * l; if (sb + 10 <= lo || sb >= hi) continue;
        const bool keep_ctx = l < DEPTH - 1; const int skip = keep_ctx ? 0 : 1;
        STEP(sb + 0, 1, if (PH(2)) { ENTER();
            pg8::Gemm g{Hb, (const bf16_t*)(F.ws + WS_WIN) + (size_t)l * PWPAD * DM, MROWS, PWPAD, DM}; pg8::RowOrder S; S.init(PWPAD / 256, F.G, (int)blockIdx.x, 0);
            pg8::EpiProj E{Pb, ABf};
            pg8::gemm_phase<pg8::EpiProj, pg8::RowOrder, true, true>(F.lds, g, S, E); });
        STEP(sb + 1, 2, if (PH(3)) { ENTER(); rowprep_phase(F, l); });
        STEP(sb + 2, 3,
            if (PH(4)) { ENTER(); for (int u = F.vcu; u < NBATCH * DN_NCH * 4; u += F.G) dnprep_unit(F, u); }
            if (PH(13)) { ENTER(); const int nfive = (NBATCH * DN_NCH * 4) % F.G;
                if (F.vcu >= nfive) for (int u = F.vcu - nfive; u < NBATCH * RET_NCH * 4; u += F.G - nfive) retprep_unit(F, l, u); });
        STEP(sb + 3, 4,
            if (PH(5)) { ENTER(); for (int u = (int)blockIdx.x; u < 16; u += F.G) dnscan_unit(F, u); }
            if (PH(14)) { ENTER(); for (int u = (int)blockIdx.x - 16; u < 16; u += F.G) { if (u >= 0) retscan_unit(F, l, u); } }
            if (PH(6)) { ENTER(); attention_phase(F, l, keep_ctx); });
        STEP(sb + 4, 5, if (PH(7)) { ENTER(); mixepi_phase(F, l, keep_ctx); });
        STEP(sb + 5, 6, if (PH(8)) { ENTER();
            pg8::Gemm g{Yb, (const bf16_t*)(F.ws + WS_WO) + (size_t)l * DM * DM, MROWS, DM, DM}; pg8::RowOrder S; S.init(DM / 256, F.G, (int)blockIdx.x, 1);
            const float* lnw_ = inp(F, I_ln2_w) + (l > 0 ? l - 1 : 0) * DM; const float* lnb_ = inp(F, I_ln2_b) + (l > 0 ? l - 1 : 0) * DM; const float* lns_ = (const float*)(F.ws + WS_LNS);
            pg8::EpiResid E{Xf, MOD + (size_t)(l * 3) * 12288 + 2 * DM, ALPHA, lns_, lnw_, lnb_, l > 0 ? 1 : 0};
            pg8::gemm_phase<pg8::EpiResid, pg8::RowOrder, false, true>(F.lds, g, S, E);
            if (keep_ctx) { ENTER(); ctx_gemm_resid(F, Yb, (const bf16_t*)(F.ws + WS_WO) + (size_t)l * DM * DM, DM, Xf, MOD + (size_t)(l * 3 + 2) * 12288 + 2 * DM, ALPHA, (const float*)(F.ws + WS_LNS), inp(F, I_ln2_w) + (l > 0 ? l - 1 : 0) * DM, inp(F, I_ln2_b) + (l > 0 ? l - 1 : 0) * DM, l > 0 ? 1 : 0); } });
        STEP(sb + 6, 7, if (PH(9)) { ENTER(); ln_mod_phase<1>(F, l, !keep_ctx); });
        STEP(sb + 7, 8, if (PH(10)) { ENTER();
            pg8::Gemm g{Hb, (const bf16_t*)(F.ws + WS_WFI) + (size_t)l * 2 * DFF * DM, MROWS, 2 * DFF, DM}; pg8::RowOrder S; S.init(2 * DFF / 256, F.G, (int)blockIdx.x, skip);
            pg8::EpiSwiglu E{Pb};
            pg8::gemm_phase<pg8::EpiSwiglu, pg8::RowOrder, true, true>(F.lds, g, S, E); });
        STEP(sb + 8, 9, if (PH(11)) { ENTER();
            pg8::Gemm g{Pb, (const bf16_t*)(F.ws + WS_WFO) + (size_t)l * DM * DFF, MROWS, DM, DFF}; pg8::RowOrder S; S.init(DM / 256, F.G, (int)blockIdx.x, 1);
            const float* lnw_ = inp(F, I_ln1_w) + l * DM; const float* lnb_ = inp(F, I_ln1_b) + l * DM; const float* lns_ = (const float*)(F.ws + WS_LNS);
            pg8::EpiResid E{Xf, MOD + (size_t)(l * 3) * 12288 + 5 * DM, ALPHA, lns_, lnw_, lnb_, 1};
            pg8::gemm_phase<pg8::EpiResid, pg8::RowOrder, false, true>(F.lds, g, S, E);
            if (keep_ctx) { ENTER(); ctx_gemm_resid(F, Pb, (const bf16_t*)(F.ws + WS_WFO) + (size_t)l * DM * DFF, DFF, Xf, MOD + (size_t)(l * 3 + 2) * 12288 + 5 * DM, ALPHA, (const float*)(F.ws + WS_LNS), inp(F, I_ln1_w) + l * DM, inp(F, I_ln1_b) + l * DM, 1); } });
        STEP(sb + 9, 10, if (PH(12)) { ENTER(); if (keep_ctx) ln_mod_phase<2>(F, l, false); else ln_mod_phase<3>(F, l, true); });
    }
#undef STEP
#undef PROBE_T0
#undef PROBE_DELAY
#undef IN
#undef SEAM
#undef ENTER
#undef Hb
#undef Pb
#undef Yb
#undef Xf
#undef ABf
#undef MOD
}

extern "C" void kernel_launch(void* const* d_in, const int* in_sizes, int n_in, void* d_out, int out_size, void* d_ws, size_t ws_size, hipStream_t stream) {
    static int grid = 0;
    if (grid == 0) {
        if (n_in != 21 || in_sizes[0] != NBATCH * SEQ * DM || out_size != NBATCH * SEQ * DM || ws_size < WS_END) {
            fprintf(stderr, "kernel_launch: shape mismatch: n_in %d in0 %d out %d ws %zu (need >= %zu)\n", n_in, n_in > 0 ? in_sizes[0] : -1, out_size, ws_size, (size_t)WS_END); grid = -1; return; }
        int dev = 0, cus = 0, per_cu = 0;
        if (hipGetDevice(&dev) != hipSuccess || hipDeviceGetAttribute(&cus, hipDeviceAttributeMultiprocessorCount, dev) != hipSuccess) { fprintf(stderr, "kernel_launch: device query failed\n"); grid = -1; return; }
        if (hipFuncSetAttribute((const void*)fwd, hipFuncAttributeMaxDynamicSharedMemorySize, LDS_BYTES) != hipSuccess) { fprintf(stderr, "kernel_launch: hipFuncSetAttribute failed\n"); grid = -1; return; }
        if (hipOccupancyMaxActiveBlocksPerMultiprocessor(&per_cu, (const void*)fwd, NWAVES * 64, LDS_BYTES) != hipSuccess || per_cu < 1)
            fprintf(stderr, "kernel_launch: note: occupancy query reports %d workgroups per CU\n", per_cu);
        (void)hipGetLastError();
        grid = cus;
    }
    if (grid < 0) return;
    if (hipMemsetAsync((char*)d_ws + WS_CTL, 0, CTL_ZERO_BYTES, stream) != hipSuccess) { fprintf(stderr, "kernel_launch: memset failed\n"); return; }
    Args a{};
    for (int i = 0; i < 21; ++i) a.in[i] = (const float*)d_in[i];
    a.out = (float*)d_out; a.ws = (unsigned char*)d_ws;
#if MK_ONE_LAUNCH
    a.s_lo = 0; a.s_hi = NSTEPS;
    hipLaunchKernelGGL(fwd, dim3(grid), dim3(NWAVES * 64), LDS_BYTES, stream, a);
#else
    for (int s = 0; s < NSTEPS; ++s) { a.s_lo = s; a.s_hi = s + 1; hipLaunchKernelGGL(fwd, dim3(grid), dim3(NWAVES * 64), LDS_BYTES, stream, a); }
#endif
    const hipError_t le = hipPeekAtLastError();
    if (le != hipSuccess) fprintf(stderr, "kernel_launch: launch failed: %s\n", hipGetErrorName(le));
}
```
